# Optimizing an MI355X kernel written in HIP

```python
import jax, jax.numpy as jnp
from jax import lax
import numpy as np

D_MODEL = 1024
BATCH = 8
SEQ = 2048
DEPTH = 2
DEC_BATCH = 32
DEC_SEQ = 32
PAST_LEN = 2048

CHUNK = 64
GLA_HEADS = 4
GLA_DK = 64
GLA_DV = 128
GLA_QK = GLA_HEADS * GLA_DK
GLA_WIDTH = GLA_HEADS * GLA_DV
GLA_RANK = 16
GLA_TAU = 16.0
RG_WIDTH = D_MODEL - GLA_WIDTH
RG_BLOCKS = 8
RG_BLOCK = RG_WIDTH // RG_BLOCKS
RG_C = 8.0
CONV_W = 4
D_FF = 4 * D_MODEL
EPS = 1e-6
OFF_Q = 0
OFF_K = OFF_Q + GLA_QK
OFF_V = OFF_K + GLA_QK
OFF_G = OFF_V + GLA_WIDTH
OFF_LR = OFF_G + GLA_WIDTH
OFF_XR = OFF_LR + GLA_RANK
OFF_GR = OFF_XR + RG_WIDTH
D_IN = OFF_GR + RG_WIDTH

kernel_name = 'hymba_gla_rglru_streaming_step'


def rmsnorm(x, g):
    xf = x.astype(jnp.float32)
    y = xf * lax.rsqrt(jnp.mean(xf * xf, axis=-1, keepdims=True) + EPS) * g.astype(jnp.float32)
    return y.astype(x.dtype)


def gla_mix(q, k, v, log_a, S0):
    B, T = q.shape[0], q.shape[1]
    C = min(CHUNK, T)
    n = T // C

    def to_chunks(t):
        return t.reshape(B, n, C, GLA_HEADS, t.shape[-1]).transpose(1, 0, 3, 2, 4)

    causal = jnp.tril(jnp.ones((C, C), dtype=bool))[None, None, :, :, None]

    def step(S, inp):
        qc, kc, vc, lc = inp
        b = jnp.cumsum(lc, axis=2)
        o_inter = jnp.einsum('bhcd,bhde->bhce', qc * jnp.exp(b), S)
        diff = jnp.where(causal, b[:, :, :, None, :] - b[:, :, None, :, :], -jnp.inf)
        att = jnp.einsum('bhid,bhjd,bhijd->bhij', qc, kc, jnp.exp(diff))
        o = o_inter + jnp.einsum('bhij,bhje->bhie', att, vc)
        b_last = b[:, :, -1:, :]
        S_new = jnp.exp(b_last[:, :, 0, :])[..., None] * S + jnp.einsum(
            'bhcd,bhce->bhde', kc * jnp.exp(b_last - b), vc)
        return S_new, o

    S, o = lax.scan(step, S0, (to_chunks(q), to_chunks(k), to_chunks(v), to_chunks(log_a)))
    o = o.transpose(1, 0, 3, 2, 4).reshape(B, T, GLA_HEADS, GLA_DV)
    return o, S


def causal_conv(x, buf, w, b):
    T = x.shape[1]
    xp = jnp.concatenate([buf, x], axis=1)
    y = b + xp[:, 0:T] * w[0]
    for j in range(1, CONV_W):
        y = y + xp[:, j:j + T] * w[j]
    return y, xp[:, -(CONV_W - 1):]


def rg_lru(x, h0, wa, ba, wx, bx, lam):
    B, T = x.shape[0], x.shape[1]
    xb = x.reshape(B, T, RG_BLOCKS, RG_BLOCK)
    r = jax.nn.sigmoid(jnp.einsum('btgi,gij->btgj', xb, wa).reshape(B, T, RG_WIDTH) + ba)
    i = jax.nn.sigmoid(jnp.einsum('btgi,gij->btgj', xb, wx).reshape(B, T, RG_WIDTH) + bx)
    log_a = -RG_C * r * jax.nn.softplus(-lam)
    a = jnp.exp(log_a)
    u = jnp.sqrt(-jnp.expm1(2.0 * log_a)) * (i * x)
    u = u.at[:, 0].add(a[:, 0] * h0)

    def combine(left, right):
        a1, b1 = left
        a2, b2 = right
        return a1 * a2, a2 * b1 + b2

    _, h = lax.associative_scan(combine, (a, u), axis=1)
    return h, h[:, -1]


def layer(x, S0, h0, buf, g_pre_mix, w_in, w_lr2, b_lr, gla_norm, conv_w, conv_b,
          rg_wa, rg_ba, rg_wx, rg_bx, rg_lambda, w_out, g_post_mix, g_pre_ff, w_ff1, w_ff2,
          g_post_ff):
    B, T = x.shape[0], x.shape[1]
    f32 = jnp.float32
    z = rmsnorm(x, g_pre_mix) @ w_in
    q = z[..., OFF_Q:OFF_K].astype(f32).reshape(B, T, GLA_HEADS, GLA_DK) * (GLA_DK ** -0.5)
    k = z[..., OFF_K:OFF_V].astype(f32).reshape(B, T, GLA_HEADS, GLA_DK)
    v = z[..., OFF_V:OFF_G].astype(f32).reshape(B, T, GLA_HEADS, GLA_DV)
    g = z[..., OFF_G:OFF_LR].astype(f32)
    lr = z[..., OFF_LR:OFF_XR].astype(f32)
    xr = z[..., OFF_XR:OFF_GR].astype(f32)
    gr = z[..., OFF_GR:D_IN].astype(f32)

    log_a = (jax.nn.log_sigmoid(lr @ w_lr2.astype(f32) + b_lr.astype(f32)) / GLA_TAU).reshape(
        B, T, GLA_HEADS, GLA_DK)
    o, S = gla_mix(q, k, v, log_a, S0.astype(f32))
    o = o * lax.rsqrt(jnp.mean(o * o, axis=-1, keepdims=True) + EPS) * gla_norm.astype(f32)
    o = o.reshape(B, T, GLA_WIDTH) * jax.nn.silu(g)

    xc, buf_new = causal_conv(xr, buf.astype(f32), conv_w.astype(f32), conv_b.astype(f32))
    hr, h_last = rg_lru(xc, h0.astype(f32), rg_wa.astype(f32), rg_ba.astype(f32),
                        rg_wx.astype(f32), rg_bx.astype(f32), rg_lambda.astype(f32))
    yr = hr * jax.nn.gelu(gr)

    mix = jnp.concatenate([o, yr], axis=-1).astype(x.dtype) @ w_out
    x = x + rmsnorm(mix, g_post_mix)
    f = jnp.square(jax.nn.relu(rmsnorm(x, g_pre_ff) @ w_ff1)) @ w_ff2
    x = x + rmsnorm(f, g_post_ff)
    return x, S, h_last, buf_new


def setup_inputs(seed: int = 0) -> dict:
    key = jax.random.key(seed)
    ks = jax.random.split(key, 32)
    nrm = lambda i, shape, s: jax.random.normal(ks[i], shape, jnp.float32) * s
    a0 = jax.random.uniform(ks[20], (DEPTH, RG_WIDTH), jnp.float32, 0.9, 0.999)
    s0 = a0 ** (1.0 / RG_C)
    rg_lambda = jnp.log(s0) - jnp.log1p(-s0)
    return {
        'x_prompt': nrm(0, (BATCH, SEQ, D_MODEL), 1.0),
        'x_sample': nrm(1, (DEC_BATCH, DEC_SEQ, D_MODEL), 1.0),
        'state_gla': nrm(2, (DEPTH, DEC_BATCH, GLA_HEADS, GLA_DK, GLA_DV), 0.5),
        'state_rglru': nrm(3, (DEPTH, DEC_BATCH, RG_WIDTH), 0.5),
        'state_conv': nrm(4, (DEPTH, DEC_BATCH, CONV_W - 1, RG_WIDTH), 1.0),
        'g_pre_mix': 1.0 + nrm(5, (DEPTH, D_MODEL), 0.02),
        'w_in': nrm(6, (DEPTH, D_MODEL, D_IN), D_MODEL ** -0.5),
        'w_lr2': nrm(7, (DEPTH, GLA_RANK, GLA_QK), GLA_RANK ** -0.5),
        'b_lr': nrm(8, (DEPTH, GLA_QK), 0.1),
        'gla_norm': 1.0 + nrm(9, (DEPTH, GLA_DV), 0.02),
        'conv_w': nrm(10, (DEPTH, CONV_W, RG_WIDTH), CONV_W ** -0.5),
        'conv_b': nrm(11, (DEPTH, RG_WIDTH), 0.02),
        'rg_wa': nrm(12, (DEPTH, RG_BLOCKS, RG_BLOCK, RG_BLOCK), RG_BLOCK ** -0.5),
        'rg_ba': nrm(13, (DEPTH, RG_WIDTH), 0.1),
        'rg_wx': nrm(14, (DEPTH, RG_BLOCKS, RG_BLOCK, RG_BLOCK), RG_BLOCK ** -0.5),
        'rg_bx': nrm(15, (DEPTH, RG_WIDTH), 0.1),
        'rg_lambda': rg_lambda,
        'w_out': nrm(16, (DEPTH, D_MODEL, D_MODEL), D_MODEL ** -0.5),
        'g_post_mix': 1.0 + nrm(17, (DEPTH, D_MODEL), 0.02),
        'g_pre_ff': 1.0 + nrm(18, (DEPTH, D_MODEL), 0.02),
        'w_ff1': nrm(19, (DEPTH, D_MODEL, D_FF), D_MODEL ** -0.5),
        'w_ff2': nrm(21, (DEPTH, D_FF, D_MODEL), D_FF ** -0.5),
        'g_post_ff': 1.0 + nrm(22, (DEPTH, D_MODEL), 0.02),
    }


def reference(x_prompt, x_sample, state_gla, state_rglru, state_conv, g_pre_mix, w_in, w_lr2,
              b_lr, gla_norm, conv_w, conv_b, rg_wa, rg_ba, rg_wx, rg_bx, rg_lambda, w_out,
              g_post_mix, g_pre_ff, w_ff1, w_ff2, g_post_ff):
    f32 = jnp.float32
    xp = x_prompt
    xs = x_sample
    gla_p, rg_p, cv_p, gla_s, rg_s, cv_s = [], [], [], [], [], []
    for l in range(DEPTH):
        params = (g_pre_mix[l], w_in[l], w_lr2[l], b_lr[l], gla_norm[l], conv_w[l], conv_b[l],
                  rg_wa[l], rg_ba[l], rg_wx[l], rg_bx[l], rg_lambda[l], w_out[l], g_post_mix[l],
                  g_pre_ff[l], w_ff1[l], w_ff2[l], g_post_ff[l])
        xp, S, h, buf = layer(xp,
                              jnp.zeros((BATCH, GLA_HEADS, GLA_DK, GLA_DV), f32),
                              jnp.zeros((BATCH, RG_WIDTH), f32),
                              jnp.zeros((BATCH, CONV_W - 1, RG_WIDTH), f32),
                              *params)
        gla_p.append(S)
        rg_p.append(h)
        cv_p.append(buf)
        xs, S2, h2, buf2 = layer(xs, state_gla[l], state_rglru[l], state_conv[l], *params)
        gla_s.append(S2)
        rg_s.append(h2)
        cv_s.append(buf2)
    gla_prompt = jnp.stack(gla_p)
    rglru_prompt = jnp.stack(rg_p)
    conv_prompt = jnp.stack(cv_p)
    gla_sample = jnp.stack(gla_s)
    rglru_sample = jnp.stack(rg_s)
    conv_sample = jnp.stack(cv_s)
    return (xp, xs, gla_prompt, rglru_prompt, conv_prompt, gla_sample, rglru_sample, conv_sample)
```

```cpp
#include <hip/hip_runtime.h>
#include <hip/hip_cooperative_groups.h>
#include <cstdio>
#include <cstdint>
namespace cg = cooperative_groups;
__device__ __forceinline__ int opaque_tid() { int t = threadIdx.x; asm volatile("" : "+v"(t)); return t; }
namespace pg8 {
#define PG8_LAS __attribute__((address_space(3)))
typedef unsigned short bf16_t;
typedef short bf16x8 __attribute__((ext_vector_type(8)));
typedef float f32x4 __attribute__((ext_vector_type(4)));
typedef unsigned u32x4 __attribute__((ext_vector_type(4)));
constexpr int BM = 256, BK = 64, HALF = 128, HTB = HALF * BK * 2  , STAGE_BYTES = 8 * HTB, NXCD = 8, WGM = 8;

__host__ __device__ __forceinline__ int lds_byte(int r, int c) { const int st = (r >> 4) * 2 + (c >> 5), rr = r & 15, cc = c & 31, ob = rr * 64 + cc * 2; return st * 1024 + (ob ^ (((ob >> 9) & 1) << 5)); }
__host__ __device__ __forceinline__ void stage_rc(int b, int& R, int& C) { const int st = b / 1024, sb = b % 1024, swz = sb ^ (((sb >> 9) & 1) << 5); R = (st >> 1) * 16 + swz / 64; C = (st & 1) * 32 + (swz % 64) / 2; }
__host__ __device__ __forceinline__ int perm32(int rho) { const int n = rho >> 4, i = rho & 15; return 8 * (i >> 2) + 4 * n + (i & 3); }

struct Unit { int pm, pn; };
struct Gemm { const bf16_t* A; const bf16_t* Bt; int M, N, K; };

struct StaticOrder {
    int nM, nN, nwg, G, c;
    __host__ __device__ void init(int M, int N, int G_, int c_) { nM = M / BM; nN = N / BM; nwg = nM * nN; G = G_; c = c_; }
    __host__ __device__ bool next(int i, Unit& u) const {
        const long L = (long)i * G + c; if (L >= nwg) return false;
        int wgid = (int)L; { const int q = nwg / NXCD, r = nwg % NXCD, xcd = wgid % NXCD, off = wgid / NXCD; wgid = (xcd < r ? xcd * (q + 1) : r * (q + 1) + (xcd - r) * q) + off; }
        const int nig = WGM * nN, gid = wgid / nig, fm = gid * WGM, gsz = (nM - fm) < WGM ? (nM - fm) : WGM;
        u.pm = fm + ((wgid % nig) % gsz); u.pn = (wgid % nig) / gsz; return true;
    }
    __device__ __forceinline__ void a_ready(const Unit&) const {}
    __device__ __forceinline__ void done(const Unit&) const {}
};

__device__ __forceinline__ unsigned cvt_pk_bf16(float lo, float hi) { unsigned r; asm volatile("v_cvt_pk_bf16_f32 %0, %1, %2" : "=v"(r) : "v"(lo), "v"(hi)); return r; }
template <int ACT> struct EpiBf16 {
    static constexpr bool PERM = true, AFTER_DRAIN = false;
    bf16_t* O; int ldc;
    __device__ __forceinline__ void operator()(const f32x4 (&acc)[2][2][4][2], const Unit& u, int wr, int wc, int fr, int fq) const {
        const int row0 = u.pm * BM + wr * 64 + fr; const int col0 = u.pn * BM + wc * 32 + 8 * fq;
#pragma unroll
        for (int ai = 0; ai < 2; ++ai)
#pragma unroll
            for (int m = 0; m < 4; ++m) { bf16_t* rowp = O + (size_t)(row0 + ai * HALF + m * 16) * ldc + col0;
#pragma unroll
                for (int bj = 0; bj < 2; ++bj) { f32x4 v0 = acc[ai][bj][m][0], v1 = acc[ai][bj][m][1];
                    if (ACT == 2) {
#pragma unroll
                        for (int e = 0; e < 4; ++e) { float a = fmaxf(v0[e], 0.f), b = fmaxf(v1[e], 0.f); v0[e] = a * a; v1[e] = b * b; }
                    }
                    u32x4 w; w.x = cvt_pk_bf16(v0[0], v0[1]); w.y = cvt_pk_bf16(v0[2], v0[3]); w.z = cvt_pk_bf16(v1[0], v1[1]); w.w = cvt_pk_bf16(v1[2], v1[3]);
                    *(u32x4*)(rowp + bj * HALF) = w; } }
    }
};

template <class Epi, class Sched, bool ALIGN_EPI = false, bool SP2 = false>
__device__ __forceinline__ void gemm_phase(PG8_LAS unsigned char* lds, const Gemm g, const Sched& S, const Epi& E) {
    const int tid = opaque_tid(), wid = __builtin_amdgcn_readfirstlane(tid >> 6), lane = tid & 63, wr = wid >> 2, wc = wid & 3, fr = lane & 15, fq = lane >> 4;
    const int K = g.K, nt = K / BK;
    unsigned voffA[2], voffB[2];
#pragma unroll
    for (int i = 0; i < 2; ++i) { int R, C; stage_rc(tid * 16 + i * 8192, R, C); const int Rb = Epi::PERM ? ((R & ~31) + perm32(R & 31)) : R;
        voffA[i] = (unsigned)(R * K + C) * 2u; voffB[i] = (unsigned)(Rb * K + C) * 2u; }
    const size_t kstep = (size_t)(BK * 2);
    const size_t hstep = (size_t)HALF * K * 2;
    const size_t tstep = 2 * hstep;
    const unsigned ldsw = (unsigned)wid * 1024u;
    const int aoff = lds_byte(wr * 64 + fr, fq * 8), boff = lds_byte(wc * 32 + fr, fq * 8);
#define PG8_SA(b, h) (((b) * 2 + (h)) * HTB)
#define PG8_SB(b, h) ((4 + (b) * 2 + (h)) * HTB)
#define PG8_STAGE(bufoff, gbase, voff) do { _Pragma("unroll") for (int _i = 0; _i < 2; ++_i) \
        __builtin_amdgcn_global_load_lds((const unsigned*)((const char*)(gbase) + (voff)[_i]), (PG8_LAS unsigned*)(lds + (bufoff) + ldsw + _i * 8192), 16, 0, 0); } while (0)
#define PG8_LDA(dst, b, h) do { _Pragma("unroll") for (int m = 0; m < 4; ++m) _Pragma("unroll") for (int k = 0; k < 2; ++k) dst[m][k] = *(const PG8_LAS bf16x8*)(lds + PG8_SA(b, h) + aoff + m * 2048 + k * 1024); } while (0)
#define PG8_LDB(dst, b, h) do { _Pragma("unroll") for (int n = 0; n < 2; ++n) _Pragma("unroll") for (int k = 0; k < 2; ++k) dst[n][k] = *(const PG8_LAS bf16x8*)(lds + PG8_SB(b, h) + boff + n * 2048 + k * 1024); } while (0)
#define PG8_MMA(ai, bj, At, Bt) do { __builtin_amdgcn_s_setprio(1); _Pragma("unroll") for (int m = 0; m < 4; ++m) _Pragma("unroll") for (int n = 0; n < 2; ++n) _Pragma("unroll") for (int k = 0; k < 2; ++k) \
        acc[ai][bj][m][n] = __builtin_amdgcn_mfma_f32_16x16x32_bf16(Bt[n][k], At[m][k], acc[ai][bj][m][n], 0, 0, 0); __builtin_amdgcn_s_setprio(0); } while (0)
#define PG8_WAIT_V(n) asm volatile("s_waitcnt vmcnt(" #n ")" ::: "memory")
#define PG8_WAIT_L(n) asm volatile("s_waitcnt lgkmcnt(" #n ")" ::: "memory")
#define PG8_BAR __builtin_amdgcn_s_barrier()
#define PG8_SCHED __builtin_amdgcn_sched_barrier(0)
    Unit cur, nxt; int ui = 0;
    if (!S.next(0, cur)) return;
    f32x4 acc[2][2][4][2];
#pragma unroll
    for (int a = 0; a < 2; ++a)
#pragma unroll
        for (int b = 0; b < 2; ++b)
#pragma unroll
            for (int m = 0; m < 4; ++m)
#pragma unroll
                for (int n = 0; n < 2; ++n) acc[a][b][m][n] = (f32x4){0.f, 0.f, 0.f, 0.f};
    bf16x8 At[4][2], B0[2][2], B1[2][2];
    const char* cA = (const char*)g.A + (size_t)cur.pm * tstep; const char* cB = (const char*)g.Bt + (size_t)cur.pn * tstep;
    S.a_ready(cur);
    if constexpr (SP2) {
        PG8_STAGE(PG8_SB(0, 0), cB, voffB); PG8_STAGE(PG8_SB(0, 1), cB + hstep, voffB); PG8_STAGE(PG8_SA(0, 0), cA, voffA); PG8_STAGE(PG8_SA(0, 1), cA + hstep, voffA);
        if (wr == 1) PG8_BAR;
        PG8_WAIT_V(2); PG8_BAR;
        PG8_STAGE(PG8_SB(1, 0), cB + kstep, voffB); PG8_STAGE(PG8_SA(1, 0), cA + kstep, voffA); PG8_STAGE(PG8_SB(1, 1), cB + hstep + kstep, voffB);
        PG8_WAIT_V(6); PG8_BAR;
    } else {
        PG8_STAGE(PG8_SB(0, 0), cB, voffB); PG8_STAGE(PG8_SA(0, 0), cA, voffA); PG8_STAGE(PG8_SB(0, 1), cB + hstep, voffB); PG8_STAGE(PG8_SA(0, 1), cA + hstep, voffA);
        if (wr == 1) PG8_BAR;
        PG8_WAIT_V(4); PG8_BAR;
        PG8_STAGE(PG8_SB(1, 0), cB + kstep, voffB); PG8_STAGE(PG8_SA(1, 0), cA + kstep, voffA); PG8_STAGE(PG8_SB(1, 1), cB + hstep + kstep, voffB);
        PG8_WAIT_V(6); PG8_BAR;
    }
    for (;;) {
        const bool has_next = S.next(ui + 1, nxt);
        const char* nA = has_next ? (const char*)g.A + (size_t)nxt.pm * tstep : cA; const char* nB = has_next ? (const char*)g.Bt + (size_t)nxt.pn * tstep : cB;
        for (int t = 0; t < nt; t += 2) {
            const bool last = (t == nt - 2);
            const char* a1 = cA + (size_t)(t + 1) * kstep;
            const char* a2 = last ? nA : cA + (size_t)(t + 2) * kstep; const char* b2 = last ? nB : cB + (size_t)(t + 2) * kstep;
            const char* a3 = a2 + kstep; const char* b3 = b2 + kstep;
            if (last && has_next) S.a_ready(nxt);
            if constexpr (SP2) {
            PG8_LDB(B0, 0, 0); PG8_LDB(B1, 0, 1); PG8_SCHED; PG8_LDA(At, 0, 0); PG8_STAGE(PG8_SA(1, 1), a1 + hstep, voffA);
            PG8_WAIT_V(8); PG8_WAIT_L(0); PG8_BAR; PG8_MMA(0, 0, At, B0); PG8_MMA(0, 1, At, B1); PG8_BAR; PG8_SCHED;
            PG8_LDA(At, 0, 1); PG8_STAGE(PG8_SB(0, 0), b2, voffB); PG8_STAGE(PG8_SB(0, 1), b2 + hstep, voffB); PG8_STAGE(PG8_SA(0, 0), a2, voffA);
            PG8_WAIT_V(8); PG8_WAIT_L(0); PG8_BAR; PG8_MMA(1, 0, At, B0); PG8_MMA(1, 1, At, B1); PG8_BAR; PG8_SCHED;
            PG8_LDB(B0, 1, 0); PG8_LDB(B1, 1, 1); PG8_SCHED; PG8_LDA(At, 1, 0); PG8_STAGE(PG8_SA(0, 1), a2 + hstep, voffA);
            PG8_WAIT_V(8); PG8_WAIT_L(0); PG8_BAR; PG8_MMA(0, 0, At, B0); PG8_MMA(0, 1, At, B1); PG8_BAR; PG8_SCHED;
            PG8_LDA(At, 1, 1); PG8_STAGE(PG8_SB(1, 0), b3, voffB); PG8_STAGE(PG8_SB(1, 1), b3 + hstep, voffB); PG8_STAGE(PG8_SA(1, 0), a3, voffA);
            PG8_WAIT_V(8); PG8_WAIT_L(0); PG8_BAR; PG8_MMA(1, 0, At, B0); PG8_MMA(1, 1, At, B1); PG8_BAR; PG8_SCHED;
            } else {
            PG8_LDB(B0, 0, 0); PG8_SCHED; PG8_LDA(At, 0, 0); PG8_STAGE(PG8_SA(1, 1), a1 + hstep, voffA);
            PG8_WAIT_L(8); PG8_BAR; PG8_WAIT_L(0); PG8_MMA(0, 0, At, B0); PG8_BAR; PG8_SCHED;
            PG8_LDB(B1, 0, 1); PG8_STAGE(PG8_SB(0, 0), b2, voffB);
            PG8_BAR; PG8_WAIT_L(0); PG8_MMA(0, 1, At, B1); PG8_BAR;
            PG8_LDA(At, 0, 1); PG8_STAGE(PG8_SA(0, 0), a2, voffA);
            PG8_BAR; PG8_WAIT_L(0); PG8_MMA(1, 0, At, B0); PG8_BAR; PG8_SCHED;
            PG8_STAGE(PG8_SB(0, 1), b2 + hstep, voffB);
            PG8_WAIT_V(6); PG8_BAR; PG8_MMA(1, 1, At, B1); PG8_BAR;
            PG8_LDB(B0, 1, 0); PG8_SCHED; PG8_LDA(At, 1, 0); PG8_STAGE(PG8_SA(0, 1), a2 + hstep, voffA);
            PG8_WAIT_L(8); PG8_BAR; PG8_WAIT_L(0); PG8_MMA(0, 0, At, B0); PG8_BAR; PG8_SCHED;
            PG8_LDB(B1, 1, 1); PG8_STAGE(PG8_SB(1, 0), b3, voffB);
            PG8_BAR; PG8_WAIT_L(0); PG8_MMA(0, 1, At, B1); PG8_BAR;
            PG8_LDA(At, 1, 1); PG8_STAGE(PG8_SA(1, 0), a3, voffA);
            PG8_BAR; PG8_WAIT_L(0); PG8_MMA(1, 0, At, B0); PG8_BAR; PG8_SCHED;
            PG8_STAGE(PG8_SB(1, 1), b3 + hstep, voffB);
            PG8_WAIT_V(6); PG8_BAR; PG8_MMA(1, 1, At, B1); PG8_BAR;
            }
        }
        if constexpr (ALIGN_EPI) { if (wr == 0) PG8_BAR; }
        if constexpr (!Epi::AFTER_DRAIN) { E(acc, cur, wr, wc, fr, fq); S.done(cur); }
        if (!has_next) break;
#pragma unroll
        for (int a = 0; a < 2; ++a)
#pragma unroll
            for (int b = 0; b < 2; ++b)
#pragma unroll
                for (int m = 0; m < 4; ++m)
#pragma unroll
                    for (int n = 0; n < 2; ++n) acc[a][b][m][n] = (f32x4){0.f, 0.f, 0.f, 0.f};
        cur = nxt; cA = nA; cB = nB; ++ui;
        if constexpr (ALIGN_EPI) { if (wr == 1) PG8_BAR; }
    }
    PG8_WAIT_V(0);
    if constexpr (!ALIGN_EPI) { if (wr == 0) PG8_BAR; }
    PG8_BAR;
    if constexpr (Epi::AFTER_DRAIN) { E.fused(acc, cur, wr, wc, fr, fq, lds, wid, lane); S.done(cur); }
#undef PG8_SA
#undef PG8_SB
#undef PG8_STAGE
#undef PG8_LDA
#undef PG8_LDB
#undef PG8_MMA
#undef PG8_WAIT_V
#undef PG8_WAIT_L
#undef PG8_BAR
#undef PG8_SCHED
}
}

#define LAS __attribute__((address_space(3)))
typedef unsigned short bf16;
typedef float f32x4 __attribute__((ext_vector_type(4)));
typedef float f32x2 __attribute__((ext_vector_type(2)));
typedef short bf16x8 __attribute__((ext_vector_type(8)));
typedef unsigned u32x4 __attribute__((ext_vector_type(4)));
typedef unsigned u32x2 __attribute__((ext_vector_type(2)));

constexpr int NWAVES = 8, NTHR = 512;
constexpr int DM = 1024, MP = 16384, MS = 1024, M = MP + MS, DIN = 2576, NZ = 2560, FF = 4096;
constexpr float EPS = 1e-6f;
constexpr size_t MiB = 1u << 20;
constexpr size_t W_IN = 0, W_OUT = W_IN + (size_t)NZ * DM * 2, W_FF1 = W_OUT + (size_t)DM * DM * 2, W_FF2 = W_FF1 + (size_t)FF * DM * 2,
                 W_LR = W_FF2 + (size_t)FF * DM * 2, W_RG = W_LR + 16 * DM * 2, LAYER_W = W_RG + 8 * 128 * 64 * 2;
constexpr size_t WS_W = 1 * MiB, WS_H = 49 * MiB, WS_GO = 83 * MiB, WS_BIG = 117 * MiB, WS_Z = WS_BIG, WS_MIX = WS_BIG + 85 * MiB, WS_LR = WS_BIG + 119 * MiB, WS_END = 253 * MiB;
static_assert(WS_W + 2 * LAYER_W <= WS_H, "weights fit");
static_assert((size_t)M * DM * 2 == 34 * MiB && (size_t)M * NZ * 2 == 85 * MiB && (size_t)M * FF * 2 == 136 * MiB, "sizes");
constexpr size_t OUT_GLA_P = 17825792, OUT_RG_P = 18350080, OUT_CV_P = 18358272, OUT_GLA_S = 18382848, OUT_RG_S = 20480000, OUT_CV_S = 20512768, OUT_TOTAL = 20611072;
constexpr int LDS_BYTES = 147456;

struct Args { const float* in[23]; float* out; unsigned char* ws; };
enum { I_XP = 0, I_XS, I_SGLA, I_SRG, I_SCV, I_GPRE, I_WIN, I_WLR2, I_BLR, I_GNORM, I_CW, I_CB, I_WA, I_BA, I_WX, I_BX, I_LAM, I_WOUT, I_GPOST, I_GPREFF, I_WFF1, I_WFF2, I_GPOSTFF };

#define LDS_BAR() do { asm volatile("s_waitcnt lgkmcnt(0)" ::: "memory"); __builtin_amdgcn_s_barrier(); asm volatile("" ::: "memory"); } while (0)
#define LDS_WAIT() asm volatile("s_waitcnt lgkmcnt(0)" ::: "memory")

__device__ __forceinline__ unsigned pk2(float lo, float hi) { return pg8::cvt_pk_bf16(lo, hi); }
__device__ __forceinline__ unsigned short f2bf(float f) { return (unsigned short)(pk2(f, 0.f) & 0xffffu); }
__device__ __forceinline__ float bf2f(unsigned short u) { return __uint_as_float(((unsigned)u) << 16); }
__device__ __forceinline__ float blo(unsigned w) { return __uint_as_float(w << 16); }
__device__ __forceinline__ float bhi(unsigned w) { return __uint_as_float(w & 0xffff0000u); }
__device__ __forceinline__ void unpack8(u32x4 v, float (&f)[8]) { f[0] = blo(v.x); f[1] = bhi(v.x); f[2] = blo(v.y); f[3] = bhi(v.y); f[4] = blo(v.z); f[5] = bhi(v.z); f[6] = blo(v.w); f[7] = bhi(v.w); }
__device__ __forceinline__ u32x4 pack8(const float (&f)[8]) { u32x4 o; o.x = pk2(f[0], f[1]); o.y = pk2(f[2], f[3]); o.z = pk2(f[4], f[5]); o.w = pk2(f[6], f[7]); return o; }
__device__ __forceinline__ float wave_sum(float v) {
#pragma unroll
    for (int o = 1; o < 64; o <<= 1) v += __shfl_xor(v, o);
    return v;
}
__device__ __forceinline__ float sigm(float x) { return 1.f / (1.f + __expf(-x)); }
__device__ __forceinline__ float gelu_tanh(float x) { const float u = 0.7978845608028654f * (x + 0.044715f * x * x * x); const float e = __expf(-2.f * fabsf(u)); float th = (1.f - e) / (1.f + e); th = u < 0.f ? -th : th; return 0.5f * x * (1.f + th); }
__device__ __forceinline__ const float* xrow_in(const Args& A, int m) { return m < MP ? A.in[I_XP] + (size_t)m * DM : A.in[I_XS] + (size_t)(m - MP) * DM; }

__device__ __forceinline__ void p0_transpose_item(const float* W, int ldw, int col0, int K, bf16* WT, int row_off, LAS float* scr, int kb, int nb, int lane) {
    const int k0 = 64 * kb, n0 = 32 * nb;
#pragma unroll 8
    for (int i = 0; i < 32; ++i) { const int kk = 2 * i + (lane >> 5); scr[kk * 33 + (lane & 31)] = W[(size_t)(k0 + kk) * ldw + col0 + n0 + (lane & 31)]; }
    LDS_WAIT(); asm volatile("" ::: "memory");
    const int c = lane & 7;
#pragma unroll
    for (int j = 0; j < 4; ++j) { const int n = (lane >> 3) + 8 * j; const LAS float* s = scr + (8 * c) * 33 + n;
        u32x4 o; o.x = pk2(s[0 * 33], s[1 * 33]); o.y = pk2(s[2 * 33], s[3 * 33]); o.z = pk2(s[4 * 33], s[5 * 33]); o.w = pk2(s[6 * 33], s[7 * 33]);
        *(u32x4*)(WT + (size_t)(row_off + n0 + n) * K + k0 + 8 * c) = o; }
    LDS_WAIT(); asm volatile("" ::: "memory");
}

template <bool HAS_GO, bool HAS_H>
__device__ __forceinline__ void row_op(const float* xs, const bf16* go, const f32x4 (&ga)[4], float* xo, const f32x4 (&gb)[4], bf16* hb, int lane) {
    f32x4 x[4];
#pragma unroll
    for (int j = 0; j < 4; ++j) x[j] = *(const f32x4*)(xs + 4 * lane + 256 * j);
    if (HAS_GO) {
        f32x4 f[4]; float ss = 0.f;
#pragma unroll
        for (int j = 0; j < 4; ++j) { const u32x2 wv = *(const u32x2*)(go + 4 * lane + 256 * j); f[j] = (f32x4){blo(wv.x), bhi(wv.x), blo(wv.y), bhi(wv.y)};
            ss += (f[j].x * f[j].x + f[j].y * f[j].y) + (f[j].z * f[j].z + f[j].w * f[j].w); }
        const float rstd = rsqrtf(wave_sum(ss) * (1.f / DM) + EPS);
#pragma unroll
        for (int j = 0; j < 4; ++j) { x[j] = x[j] + f[j] * rstd * ga[j]; *(f32x4*)(xo + 4 * lane + 256 * j) = x[j]; }
    }
    if (HAS_H) {
        float s2 = 0.f;
#pragma unroll
        for (int j = 0; j < 4; ++j) s2 += (x[j].x * x[j].x + x[j].y * x[j].y) + (x[j].z * x[j].z + x[j].w * x[j].w);
        const float r2 = rsqrtf(wave_sum(s2) * (1.f / DM) + EPS);
#pragma unroll
        for (int j = 0; j < 4; ++j) { const f32x4 hv = x[j] * r2 * gb[j]; u32x2 o; o.x = pk2(hv.x, hv.y); o.y = pk2(hv.z, hv.w); *(u32x2*)(hb + 4 * lane + 256 * j) = o; }
    }
}
__device__ __forceinline__ void load_g(const float* g, int lane, f32x4 (&v)[4]) {
#pragma unroll
    for (int j = 0; j < 4; ++j) v[j] = *(const f32x4*)(g + 4 * lane + 256 * j);
}

__device__ __forceinline__ void gla_chain(LAS unsigned char* L, const Args& A, int l, int smp, int b, int h) {
    const int tid = opaque_tid(), w = __builtin_amdgcn_readfirstlane(tid >> 6), lane = tid & 63, r = lane & 15, q = lane >> 4;
    const int t = tid >> 3, o8 = (tid & 7) * 8;
    LAS bf16* QT = (LAS bf16*)(L + 0); LAS bf16* KT = (LAS bf16*)(L + 9216); LAS bf16* KHT = (LAS bf16*)(L + 18432); LAS bf16* ATT = (LAS bf16*)(L + 27648);
    LAS bf16* VT = (LAS bf16*)(L + 36864); LAS bf16* ST = (LAS bf16*)(L + 55296); LAS bf16* GS = (LAS bf16*)(L + 73728);
    LAS float* LRS = (LAS float*)(L + 91136); LAS float* WL = (LAS float*)(L + 95232); LAS float* SEG = (LAS float*)(L + 99328);
    LAS float* SSQ = (LAS float*)(L + 101376); LAS float* BL = (LAS float*)(L + 101888);
    const int nchunk = smp ? 1 : 32, ntok = smp ? 32 : 64, row0 = smp ? MP + b * 32 : b * 2048, nbt = smp ? 32 : 8;
    const bf16* Z = (const bf16*)(A.ws + WS_Z); bf16* MIX = (bf16*)(A.ws + WS_MIX); const float* LR = (const float*)(A.ws + WS_LR);
    const bool valid = t < ntok;
    f32x4 S[4];
    if (smp) { const float* s0 = A.in[I_SGLA] + ((size_t)(l * 32 + b) * 4 + h) * 8192;
#pragma unroll
        for (int n = 0; n < 4; ++n) S[n] = *(const f32x4*)(s0 + (16 * n + r) * 128 + 16 * w + q * 4);
    } else {
#pragma unroll
        for (int n = 0; n < 4; ++n) S[n] = (f32x4){0.f, 0.f, 0.f, 0.f};
    }
#pragma unroll
    for (int n = 0; n < 4; ++n)
#pragma unroll
        for (int i = 0; i < 4; ++i) ST[(16 * w + q * 4 + i) * 72 + 16 * n + r] = f2bf(S[n][i]);
    { const int idx = tid * 2, j = idx >> 6, d = idx & 63; const float* src = A.in[I_WLR2] + (size_t)(l * 16 + j) * 256 + h * 64 + d; WL[j * 64 + d] = src[0]; WL[j * 64 + d + 1] = src[1]; }
    float blr[8];
#pragma unroll
    for (int dd = 0; dd < 8; ++dd) blr[dd] = A.in[I_BLR][l * 256 + h * 64 + o8 + dd];
    float gn[4];
#pragma unroll
    for (int n = 0; n < 4; ++n) gn[n] = A.in[I_GNORM][l * 128 + 16 * (4 * (w & 1) + n) + r];
    const int mi = w >> 1;

    u32x4 rq, rk, rv0, rv1, rg0, rg1; f32x2 rl;
#define GLA_LOAD(c) do { const u32x4 z4 = (u32x4){0u, 0u, 0u, 0u}; const int row_ = row0 + (c) * 64 + t; const bf16* zr = Z + (size_t)row_ * NZ; \
        rq = valid ? *(const u32x4*)(zr + h * 64 + o8) : z4; rk = valid ? *(const u32x4*)(zr + 256 + h * 64 + o8) : z4; \
        rv0 = valid ? *(const u32x4*)(zr + 512 + h * 128 + o8) : z4; rv1 = valid ? *(const u32x4*)(zr + 512 + h * 128 + 64 + o8) : z4; \
        rg0 = valid ? *(const u32x4*)(zr + 1024 + h * 128 + o8) : z4; rg1 = valid ? *(const u32x4*)(zr + 1024 + h * 128 + 64 + o8) : z4; \
        rl = valid ? *(const f32x2*)(LR + (size_t)row_ * 16 + (tid & 7) * 2) : (f32x2){0.f, 0.f}; } while (0)
    GLA_LOAD(0);
    for (int c = 0; c < nchunk; ++c) {
        LRS[t * 16 + (tid & 7) * 2] = rl.x; LRS[t * 16 + (tid & 7) * 2 + 1] = rl.y;
        LDS_BAR();
        float la[8];
        {
            float lrv[16];
#pragma unroll
            for (int j4 = 0; j4 < 4; ++j4) { const f32x4 v = *(const LAS f32x4*)(LRS + t * 16 + j4 * 4); lrv[j4 * 4] = v.x; lrv[j4 * 4 + 1] = v.y; lrv[j4 * 4 + 2] = v.z; lrv[j4 * 4 + 3] = v.w; }
#pragma unroll
            for (int dd = 0; dd < 8; ++dd) la[dd] = blr[dd];
#pragma unroll
            for (int j = 0; j < 16; ++j) { const f32x4 w0 = *(const LAS f32x4*)(WL + j * 64 + o8), w1 = *(const LAS f32x4*)(WL + j * 64 + o8 + 4);
                la[0] += lrv[j] * w0.x; la[1] += lrv[j] * w0.y; la[2] += lrv[j] * w0.z; la[3] += lrv[j] * w0.w;
                la[4] += lrv[j] * w1.x; la[5] += lrv[j] * w1.y; la[6] += lrv[j] * w1.z; la[7] += lrv[j] * w1.w; }
#pragma unroll
            for (int dd = 0; dd < 8; ++dd) { const float x = la[dd]; const float ls = fminf(x, 0.f) - log1pf(__expf(-fabsf(x))); la[dd] = valid ? ls * (1.f / 16.f) : 0.f; }
#pragma unroll
            for (int dd = 0; dd < 8; ++dd) { float v = la[dd]; float u = __shfl_up(v, 8); if (lane >= 8) v += u; u = __shfl_up(v, 16); if (lane >= 16) v += u; u = __shfl_up(v, 32); if (lane >= 32) v += u; la[dd] = v; }
            if ((lane >> 3) == 7) { *(LAS f32x4*)(SEG + w * 64 + o8) = (f32x4){la[0], la[1], la[2], la[3]}; *(LAS f32x4*)(SEG + w * 64 + o8 + 4) = (f32x4){la[4], la[5], la[6], la[7]}; }
        }
        LDS_BAR();
        float bl[8];
        {
            float pre[8];
#pragma unroll
            for (int dd = 0; dd < 8; ++dd) { pre[dd] = 0.f; bl[dd] = 0.f; }
#pragma unroll
            for (int ww = 0; ww < 8; ++ww) { const f32x4 s0 = *(const LAS f32x4*)(SEG + ww * 64 + o8), s1 = *(const LAS f32x4*)(SEG + ww * 64 + o8 + 4);
                const float m = ww < w ? 1.f : 0.f;
                pre[0] += m * s0.x; pre[1] += m * s0.y; pre[2] += m * s0.z; pre[3] += m * s0.w; pre[4] += m * s1.x; pre[5] += m * s1.y; pre[6] += m * s1.z; pre[7] += m * s1.w;
                bl[0] += s0.x; bl[1] += s0.y; bl[2] += s0.z; bl[3] += s0.w; bl[4] += s1.x; bl[5] += s1.y; bl[6] += s1.z; bl[7] += s1.w; }
#pragma unroll
            for (int dd = 0; dd < 8; ++dd) la[dd] += pre[dd];
        }
        {
            float qf[8], kf[8], qt[8], kt[8];
            unpack8(rq, qf); unpack8(rk, kf);
#pragma unroll
            for (int dd = 0; dd < 8; ++dd) { const float eb = __expf(la[dd]); qt[dd] = qf[dd] * 0.125f * eb; kt[dd] = kf[dd] * __expf(-la[dd]);
                KHT[(o8 + dd) * 72 + t] = f2bf(kf[dd] * __expf(bl[dd] - la[dd])); }
            *(LAS u32x4*)(QT + t * 72 + o8) = pack8(qt); *(LAS u32x4*)(KT + t * 72 + o8) = pack8(kt);
            const unsigned vw[8] = {rv0.x, rv0.y, rv0.z, rv0.w, rv1.x, rv1.y, rv1.z, rv1.w};
#pragma unroll
            for (int e2 = 0; e2 < 8; ++e2) { const int e = (e2 < 4 ? 0 : 64) + o8 + (e2 & 3) * 2; VT[e * 72 + t] = (bf16)(vw[e2] & 0xffffu); VT[(e + 1) * 72 + t] = (bf16)(vw[e2] >> 16); }
            *(LAS u32x4*)(GS + t * 136 + o8) = rg0; *(LAS u32x4*)(GS + t * 136 + 64 + o8) = rg1;
            if (t == 0) {
#pragma unroll
                for (int dd = 0; dd < 8; ++dd) BL[o8 + dd] = __expf(bl[dd]);
            }
        }
        if (c + 1 < nchunk) GLA_LOAD(c + 1);
        LDS_BAR();
#pragma unroll
        for (int jj = 0; jj < 2; ++jj) { const int nj = 2 * (w & 1) + jj; f32x4 acc = (f32x4){0.f, 0.f, 0.f, 0.f};
#pragma unroll
            for (int ks = 0; ks < 2; ++ks) { const bf16x8 a = *(const LAS bf16x8*)(QT + (16 * mi + r) * 72 + ks * 32 + q * 8), bb = *(const LAS bf16x8*)(KT + (16 * nj + r) * 72 + ks * 32 + q * 8);
                acc = __builtin_amdgcn_mfma_f32_16x16x32_bf16(a, bb, acc, 0, 0, 0); }
#pragma unroll
            for (int i = 0; i < 4; ++i) { const int row = 16 * mi + q * 4 + i, col = 16 * nj + r; ATT[row * 72 + col] = f2bf(col <= row ? acc[i] : 0.f); } }
        LDS_BAR();
        f32x4 O[4];
#pragma unroll
        for (int n = 0; n < 4; ++n) O[n] = (f32x4){0.f, 0.f, 0.f, 0.f};
#pragma unroll
        for (int ks = 0; ks < 2; ++ks) { const bf16x8 a = *(const LAS bf16x8*)(QT + (16 * mi + r) * 72 + ks * 32 + q * 8);
#pragma unroll
            for (int n = 0; n < 4; ++n) { const bf16x8 bb = *(const LAS bf16x8*)(ST + (16 * (4 * (w & 1) + n) + r) * 72 + ks * 32 + q * 8); O[n] = __builtin_amdgcn_mfma_f32_16x16x32_bf16(a, bb, O[n], 0, 0, 0); } }
#pragma unroll
        for (int ks = 0; ks < 2; ++ks) { const bf16x8 a = *(const LAS bf16x8*)(ATT + (16 * mi + r) * 72 + ks * 32 + q * 8);
#pragma unroll
            for (int n = 0; n < 4; ++n) { const bf16x8 bb = *(const LAS bf16x8*)(VT + (16 * (4 * (w & 1) + n) + r) * 72 + ks * 32 + q * 8); O[n] = __builtin_amdgcn_mfma_f32_16x16x32_bf16(a, bb, O[n], 0, 0, 0); } }
#pragma unroll
        for (int n = 0; n < 4; ++n) { const float dec = BL[16 * n + r]; S[n] = S[n] * dec; }
#pragma unroll
        for (int ks = 0; ks < 2; ++ks) { const bf16x8 a = *(const LAS bf16x8*)(VT + (16 * w + r) * 72 + ks * 32 + q * 8);
#pragma unroll
            for (int n = 0; n < 4; ++n) { const bf16x8 bb = *(const LAS bf16x8*)(KHT + (16 * n + r) * 72 + ks * 32 + q * 8); S[n] = __builtin_amdgcn_mfma_f32_16x16x32_bf16(a, bb, S[n], 0, 0, 0); } }
#pragma unroll
        for (int i = 0; i < 4; ++i) { float s = 0.f;
#pragma unroll
            for (int n = 0; n < 4; ++n) s += O[n][i] * O[n][i];
            s += __shfl_xor(s, 1); s += __shfl_xor(s, 2); s += __shfl_xor(s, 4); s += __shfl_xor(s, 8);
            if (r == 0) SSQ[(16 * mi + q * 4 + i) * 2 + (w & 1)] = s; }
        LDS_BAR();
#pragma unroll
        for (int n = 0; n < 4; ++n)
#pragma unroll
            for (int i = 0; i < 4; ++i) ST[(16 * w + q * 4 + i) * 72 + 16 * n + r] = f2bf(S[n][i]);
#pragma unroll
        for (int i = 0; i < 4; ++i) { const int row = 16 * mi + q * 4 + i; const float rstd = rsqrtf((SSQ[row * 2] + SSQ[row * 2 + 1]) * (1.f / 128.f) + EPS);
#pragma unroll
            for (int n = 0; n < 4; ++n) { const int e = 16 * (4 * (w & 1) + n) + r; const float gv = bf2f(GS[row * 136 + e]); GS[row * 136 + e] = f2bf(O[n][i] * rstd * gn[n] * gv * sigm(gv)); } }
        LDS_BAR();
        if (valid) { bf16* mr = MIX + (size_t)(row0 + c * 64 + t) * DM + h * 128 + o8;
            *(u32x4*)(mr) = *(const LAS u32x4*)(GS + t * 136 + o8); *(u32x4*)(mr + 64) = *(const LAS u32x4*)(GS + t * 136 + 64 + o8); }
    }
#undef GLA_LOAD
    { float* so = A.out + (smp ? OUT_GLA_S : OUT_GLA_P) + ((size_t)(l * nbt + b) * 4 + h) * 8192;
#pragma unroll
        for (int n = 0; n < 4; ++n) *(f32x4*)(so + (16 * n + r) * 128 + 16 * w + q * 4) = S[n]; }
    LDS_BAR();
}

__device__ __forceinline__ void rg_chain(LAS unsigned char* L, const Args& A, int l, int smp, int b, int g) {
    const int tid = opaque_tid(), w = __builtin_amdgcn_readfirstlane(tid >> 6), lane = tid & 63, r = lane & 15, q = lane >> 4;
    const int t = tid >> 3, c0 = (tid & 7) * 8;
    LAS float* XR = (LAS float*)(L + 0);
    LAS float* XC = (LAS float*)(L + 17152);
    LAS bf16* XCB = (LAS bf16*)(L + 34560);
    LAS float* AA = (LAS float*)(L + 43776);
    LAS float* UU = (LAS float*)(L + 61184);
    LAS float* GG = (LAS float*)(L + 78592);
    LAS float* SEGA = (LAS float*)(L + 96000);
    LAS float* SEGU = (LAS float*)(L + 98048);
    LAS bf16* YB = (LAS bf16*)(L + 100096);
    const int nchunk = smp ? 1 : 32, ntok = smp ? 32 : 64, row0 = smp ? MP + b * 32 : b * 2048, nbt = smp ? 32 : 8;
    const bf16* Z = (const bf16*)(A.ws + WS_Z); bf16* MIX = (bf16*)(A.ws + WS_MIX);
    const bool valid = t < ntok;
    const int ch0 = g * 64;
    float cw[4][8], cb[8];
#pragma unroll
    for (int dd = 0; dd < 8; ++dd) { cb[dd] = A.in[I_CB][l * 512 + ch0 + c0 + dd];
#pragma unroll
        for (int j = 0; j < 4; ++j) cw[j][dd] = A.in[I_CW][(l * 4 + j) * 512 + ch0 + c0 + dd]; }
    const bf16* wrg = (const bf16*)(A.ws + WS_W + (size_t)l * LAYER_W + W_RG) + (size_t)g * 128 * 64;
    bf16x8 Bf[4][2];
    float ba_[2], bx_[2], sp_[2];
#pragma unroll
    for (int jj = 0; jj < 2; ++jj) { const int n = 16 * (2 * (w & 1) + jj) + r;
#pragma unroll
        for (int ks = 0; ks < 2; ++ks) { Bf[jj][ks] = *(const bf16x8*)(wrg + n * 64 + ks * 32 + q * 8); Bf[2 + jj][ks] = *(const bf16x8*)(wrg + (64 + n) * 64 + ks * 32 + q * 8); }
        ba_[jj] = A.in[I_BA][l * 512 + ch0 + n]; bx_[jj] = A.in[I_BX][l * 512 + ch0 + n];
        const float lam = A.in[I_LAM][l * 512 + ch0 + n]; sp_[jj] = fmaxf(-lam, 0.f) + log1pf(__expf(-fabsf(lam))); }
    float hst = smp ? A.in[I_SRG][(size_t)(l * 32 + b) * 512 + ch0 + lane] : 0.f;
    if (tid < 192) { const int j = tid >> 6, c = tid & 63; XR[j * 64 + c] = smp ? A.in[I_SCV][((size_t)(l * 32 + b) * 3 + j) * 512 + ch0 + c] : 0.f; }
    const int mi = w >> 1;
    u32x4 rx, rgr;
#define RG_LOAD(c) do { const u32x4 z4 = (u32x4){0u, 0u, 0u, 0u}; const bf16* zr = Z + (size_t)(row0 + (c) * 64 + t) * NZ + 1536 + ch0 + c0; \
        rx = valid ? *(const u32x4*)(zr) : z4; rgr = valid ? *(const u32x4*)(zr + 512) : z4; } while (0)
    RG_LOAD(0);
    for (int c = 0; c < nchunk; ++c) {
        {
            float xf[8], gf[8]; unpack8(rx, xf); unpack8(rgr, gf);
            *(LAS f32x4*)(XR + (3 + t) * 64 + c0) = (f32x4){xf[0], xf[1], xf[2], xf[3]}; *(LAS f32x4*)(XR + (3 + t) * 64 + c0 + 4) = (f32x4){xf[4], xf[5], xf[6], xf[7]};
#pragma unroll
            for (int dd = 0; dd < 8; ++dd) gf[dd] = gelu_tanh(gf[dd]);
            *(LAS f32x4*)(GG + t * 68 + c0) = (f32x4){gf[0], gf[1], gf[2], gf[3]}; *(LAS f32x4*)(GG + t * 68 + c0 + 4) = (f32x4){gf[4], gf[5], gf[6], gf[7]};
        }
        LDS_BAR();
        {
            float xc[8];
#pragma unroll
            for (int dd = 0; dd < 8; ++dd) xc[dd] = cb[dd];
#pragma unroll
            for (int j = 0; j < 4; ++j) { const f32x4 a0 = *(const LAS f32x4*)(XR + (t + j) * 64 + c0), a1 = *(const LAS f32x4*)(XR + (t + j) * 64 + c0 + 4);
                xc[0] += cw[j][0] * a0.x; xc[1] += cw[j][1] * a0.y; xc[2] += cw[j][2] * a0.z; xc[3] += cw[j][3] * a0.w;
                xc[4] += cw[j][4] * a1.x; xc[5] += cw[j][5] * a1.y; xc[6] += cw[j][6] * a1.z; xc[7] += cw[j][7] * a1.w; }
            *(LAS f32x4*)(XC + t * 68 + c0) = (f32x4){xc[0], xc[1], xc[2], xc[3]}; *(LAS f32x4*)(XC + t * 68 + c0 + 4) = (f32x4){xc[4], xc[5], xc[6], xc[7]};
            *(LAS u32x4*)(XCB + t * 72 + c0) = pack8(xc);
        }
        if (c + 1 < nchunk) RG_LOAD(c + 1);
        LDS_BAR();
        if (tid < 192) { const int j = tid >> 6, cc = tid & 63; const float v = XR[(ntok + j) * 64 + cc];
            if (c == nchunk - 1) A.out[(smp ? OUT_CV_S : OUT_CV_P) + ((size_t)(l * nbt + b) * 3 + j) * 512 + ch0 + cc] = v;
            XR[j * 64 + cc] = v; }
        {
            f32x4 acc[4];
#pragma unroll
            for (int k = 0; k < 4; ++k) acc[k] = (f32x4){0.f, 0.f, 0.f, 0.f};
#pragma unroll
            for (int ks = 0; ks < 2; ++ks) { const bf16x8 a = *(const LAS bf16x8*)(XCB + (16 * mi + r) * 72 + ks * 32 + q * 8);
#pragma unroll
                for (int k = 0; k < 4; ++k) acc[k] = __builtin_amdgcn_mfma_f32_16x16x32_bf16(a, Bf[k][ks], acc[k], 0, 0, 0); }
#pragma unroll
            for (int jj = 0; jj < 2; ++jj)
#pragma unroll
                for (int i = 0; i < 4; ++i) { const int row = 16 * mi + q * 4 + i, col = 16 * (2 * (w & 1) + jj) + r;
                    const float rr = sigm(acc[jj][i] + ba_[jj]), ii = sigm(acc[2 + jj][i] + bx_[jj]);
                    const float lg = -8.f * rr * sp_[jj]; float a = __expf(lg); float u = sqrtf(fmaxf(-expm1f(2.f * lg), 0.f)) * ii * XC[row * 68 + col];
                    if (row >= ntok) { a = 1.f; u = 0.f; }
                    AA[row * 68 + col] = a; UU[row * 68 + col] = u; }
        }
        LDS_BAR();
        float av[8], uv[8];
        { float Ac = 1.f, Uc = 0.f;
#pragma unroll
            for (int k = 0; k < 8; ++k) { av[k] = AA[(8 * w + k) * 68 + lane]; uv[k] = UU[(8 * w + k) * 68 + lane]; Uc = av[k] * Uc + uv[k]; Ac = av[k] * Ac; }
            SEGA[w * 64 + lane] = Ac; SEGU[w * 64 + lane] = Uc; }
        LDS_BAR();
        { float hcur = hst, hin = hst;
#pragma unroll
            for (int s = 0; s < 8; ++s) { if (s == w) hin = hcur; hcur = SEGA[s * 64 + lane] * hcur + SEGU[s * 64 + lane]; }
            hst = hcur;
#pragma unroll
            for (int k = 0; k < 8; ++k) { hin = av[k] * hin + uv[k]; YB[(8 * w + k) * 72 + lane] = f2bf(hin * GG[(8 * w + k) * 68 + lane]); } }
        LDS_BAR();
        if (valid) *(u32x4*)(MIX + (size_t)(row0 + c * 64 + t) * DM + 512 + ch0 + c0) = *(const LAS u32x4*)(YB + t * 72 + c0);
    }
#undef RG_LOAD
    if (w == 0) A.out[(smp ? OUT_RG_S : OUT_RG_P) + (size_t)(l * nbt + b) * 512 + ch0 + lane] = hst;
    LDS_BAR();
}

__global__ void __launch_bounds__(NTHR) fwd_megakernel(Args A) {
    extern __shared__ __attribute__((aligned(16))) unsigned char lds_raw[];
    cg::grid_group grid = cg::this_grid();
    LAS unsigned char* L = (LAS unsigned char*)lds_raw;
    const int G = gridDim.x, blk = blockIdx.x, NGW = G * NWAVES;
#define PHASE_IDS() const int tid = opaque_tid(), lane = tid & 63, wave = __builtin_amdgcn_readfirstlane(tid >> 6), gw = blk * NWAVES + wave; (void)tid; (void)lane; (void)gw
    unsigned char* ws = A.ws;
    bf16* H = (bf16*)(ws + WS_H); bf16* GO = (bf16*)(ws + WS_GO); bf16* Zb = (bf16*)(ws + WS_Z); bf16* MIX = (bf16*)(ws + WS_MIX); bf16* HMID = (bf16*)(ws + WS_BIG);
    float* LR = (float*)(ws + WS_LR);

    {
        PHASE_IDS();
        LAS float* scr = (LAS float*)(L + wave * 16384);
        for (int it = gw; it < 2 * 5888; it += NGW) {
            const int l = it / 5888; int r = it % 5888; bf16* wl = (bf16*)(ws + WS_W + (size_t)l * LAYER_W);
            const float* win = A.in[I_WIN] + (size_t)l * DM * DIN;
            if (r < 768) { p0_transpose_item(win, DIN, 0, DM, wl + W_IN / 2, 0, scr, r / 48, r % 48, lane); }
            else if (r < 1280) { r -= 768; p0_transpose_item(win, DIN, 1552, DM, wl + W_IN / 2, 1536, scr, r / 32, r % 32, lane); }
            else if (r < 1792) { r -= 1280; p0_transpose_item(A.in[I_WOUT] + (size_t)l * DM * DM, DM, 0, DM, wl + W_OUT / 2, 0, scr, r / 32, r % 32, lane); }
            else if (r < 3840) { r -= 1792; p0_transpose_item(A.in[I_WFF1] + (size_t)l * DM * FF, FF, 0, DM, wl + W_FF1 / 2, 0, scr, r / 128, r % 128, lane); }
            else { r -= 3840; p0_transpose_item(A.in[I_WFF2] + (size_t)l * FF * DM, DM, 0, FF, wl + W_FF2 / 2, 0, scr, r / 32, r % 32, lane); }
        }
        const int gt = blk * NTHR + tid, NGT = G * NTHR;
        for (int idx = gt; idx < 2 * 16 * 1024; idx += NGT) { const int l = idx >> 14, j = (idx >> 10) & 15, k = idx & 1023;
            ((bf16*)(ws + WS_W + (size_t)l * LAYER_W + W_LR))[j * 1024 + k] = f2bf(A.in[I_WIN][(size_t)l * DM * DIN + (size_t)k * DIN + 1536 + j]); }
        for (int idx = gt; idx < 2 * 8 * 128 * 64; idx += NGT) { const int l = idx >> 16, g = (idx >> 13) & 7, n = (idx >> 6) & 127, k = idx & 63;
            const float v = n < 64 ? A.in[I_WA][((size_t)(l * 8 + g) * 64 + k) * 64 + n] : A.in[I_WX][((size_t)(l * 8 + g) * 64 + k) * 64 + n - 64];
            ((bf16*)(ws + WS_W + (size_t)l * LAYER_W + W_RG))[(g * 128 + n) * 64 + k] = f2bf(v); }
        f32x4 gz[4], gb[4];
#pragma unroll
        for (int j = 0; j < 4; ++j) gz[j] = (f32x4){0.f, 0.f, 0.f, 0.f};
        load_g(A.in[I_GPRE], lane, gb);
        for (int m = gw; m < M; m += NGW) row_op<false, true>(xrow_in(A, m), nullptr, gz, nullptr, gb, H + (size_t)m * DM, lane);
    }
    grid.sync();

#pragma unroll
    for (int l = 0; l < 2; ++l) {
        const bf16* wl = (const bf16*)(ws + WS_W + (size_t)l * LAYER_W);
        {
            pg8::Gemm g{H, wl + W_IN / 2, M, NZ, DM}; pg8::StaticOrder S; S.init(M, NZ, G, blk);
            pg8::EpiBf16<0> E{Zb, NZ};
            pg8::gemm_phase<pg8::EpiBf16<0>, pg8::StaticOrder, true, true>(L, g, S, E);
            PHASE_IDS();
            const int r = lane & 15, q = lane >> 4; const bf16* wlr = wl + W_LR / 2;
            for (int grp = gw; grp < M / 16; grp += NGW) {
                f32x4 acc = (f32x4){0.f, 0.f, 0.f, 0.f};
                const bf16* ap = H + (size_t)(grp * 16 + r) * DM + q * 8; const bf16* bp = wlr + r * DM + q * 8;
#pragma unroll 4
                for (int k0 = 0; k0 < DM; k0 += 32) { const bf16x8 av = *(const bf16x8*)(ap + k0), bv = *(const bf16x8*)(bp + k0); acc = __builtin_amdgcn_mfma_f32_16x16x32_bf16(av, bv, acc, 0, 0, 0); }
#pragma unroll
                for (int i = 0; i < 4; ++i) LR[(size_t)(grp * 16 + q * 4 + i) * 16 + r] = acc[i];
            }
        }
        grid.sync();
        for (int it = blk; it < 480; it += G) {
            if (it < 32 || (it >= 96 && it < 224)) { const int smp = it >= 96 ? 1 : 0, idx = smp ? it - 96 : it; gla_chain(L, A, l, smp, idx >> 2, idx & 3); }
            else { const int smp = it >= 224 ? 1 : 0, idx = smp ? it - 224 : it - 32; rg_chain(L, A, l, smp, idx >> 3, idx & 7); }
        }
        grid.sync();
        {
            pg8::Gemm g{MIX, wl + W_OUT / 2, M, DM, DM}; pg8::StaticOrder S; S.init(M, DM, G, blk);
            pg8::EpiBf16<0> E{GO, DM};
            pg8::gemm_phase<pg8::EpiBf16<0>, pg8::StaticOrder, true, true>(L, g, S, E);
        }
        grid.sync();
        {
            PHASE_IDS();
            f32x4 ga[4], gb[4]; load_g(A.in[I_GPOST] + l * DM, lane, ga); load_g(A.in[I_GPREFF] + l * DM, lane, gb);
            for (int m = gw; m < M; m += NGW) { const float* xs = (l == 0) ? xrow_in(A, m) : A.out + (size_t)m * DM;
                row_op<true, true>(xs, GO + (size_t)m * DM, ga, A.out + (size_t)m * DM, gb, H + (size_t)m * DM, lane); }
        }
        grid.sync();
        {
            pg8::Gemm g{H, wl + W_FF1 / 2, M, FF, DM}; pg8::StaticOrder S; S.init(M, FF, G, blk);
            pg8::EpiBf16<2> E{HMID, FF};
            pg8::gemm_phase<pg8::EpiBf16<2>, pg8::StaticOrder, true, true>(L, g, S, E);
        }
        grid.sync();
        {
            pg8::Gemm g{HMID, wl + W_FF2 / 2, M, DM, FF}; pg8::StaticOrder S; S.init(M, DM, G, blk);
            pg8::EpiBf16<0> E{GO, DM};
            pg8::gemm_phase<pg8::EpiBf16<0>, pg8::StaticOrder, true, true>(L, g, S, E);
        }
        grid.sync();
        {
            PHASE_IDS();
            f32x4 ga[4], gb[4]; load_g(A.in[I_GPOSTFF] + l * DM, lane, ga); load_g(A.in[I_GPRE] + DM, lane, gb);
            if (l == 0) { for (int m = gw; m < M; m += NGW) row_op<true, true>(A.out + (size_t)m * DM, GO + (size_t)m * DM, ga, A.out + (size_t)m * DM, gb, H + (size_t)m * DM, lane); grid.sync(); }
            else { for (int m = gw; m < M; m += NGW) row_op<true, false>(A.out + (size_t)m * DM, GO + (size_t)m * DM, ga, A.out + (size_t)m * DM, gb, nullptr, lane); }
        }
    }
}

extern "C" void kernel_launch(void* const* d_in, const int* in_sizes, int n_in, void* d_out, int out_size, void* d_ws, size_t ws_size, hipStream_t stream) {
    static int grid_blocks = 0;
    if (grid_blocks == 0) {
        if (n_in != 23 || (size_t)out_size != OUT_TOTAL || ws_size < WS_END) { fprintf(stderr, "kernel_launch: unexpected shapes n_in=%d out=%d ws=%zu\n", n_in, out_size, ws_size); grid_blocks = -1; return; }
        int dev = 0, cus = 0, per_cu = 0;
        hipGetDevice(&dev);
        hipDeviceGetAttribute(&cus, hipDeviceAttributeMultiprocessorCount, dev);
        hipFuncSetAttribute((const void*)fwd_megakernel, hipFuncAttributeMaxDynamicSharedMemorySize, LDS_BYTES);
        hipOccupancyMaxActiveBlocksPerMultiprocessor(&per_cu, (const void*)fwd_megakernel, NTHR, LDS_BYTES);
        if (per_cu < 1) { fprintf(stderr, "kernel_launch: occupancy query says %d blocks/CU\n", per_cu); per_cu = 1; }
        (void)hipGetLastError();
        grid_blocks = cus * per_cu;
    }
    if (grid_blocks < 0) return;
    Args a{};
    for (int i = 0; i < 23; ++i) a.in[i] = (const float*)d_in[i];
    a.out = (float*)d_out; a.ws = (unsigned char*)d_ws;
    void* args[] = {&a};
    hipError_t e = hipLaunchCooperativeKernel((const void*)fwd_megakernel, dim3(grid_blocks), dim3(NTHR), args, LDS_BYTES, stream);
    if (e != hipSuccess) fprintf(stderr, "cooperative launch failed: %s (grid %d)\n", hipGetErrorString(e), grid_blocks);
}
```

```cpp
#include <hip/hip_runtime.h>
#include <hip/hip_cooperative_groups.h>
#include <cstdio>
#include <cstdint>
namespace cg = cooperative_groups;
__device__ __forceinline__ int opaque_tid() { int t = threadIdx.x; asm volatile("" : "+v"(t)); return t; }
namespace pg8 {
#define PG8_LAS __attribute__((address_space(3)))
typedef unsigned short bf16_t;
typedef short bf16x8 __attribute__((ext_vector_type(8)));
typedef float f32x4 __attribute__((ext_vector_type(4)));
typedef unsigned u32x4 __attribute__((ext_vector_type(4)));
constexpr int BM = 256, BK = 64, HALF = 128, HTB = HALF * BK * 2  , STAGE_BYTES = 8 * HTB, NXCD = 8, WGM = 8;

__host__ __device__ __forceinline__ int lds_byte(int r, int c) { const int st = (r >> 4) * 2 + (c >> 5), rr = r & 15, cc = c & 31, ob = rr * 64 + cc * 2; return st * 1024 + (ob ^ (((ob >> 9) & 1) << 5)); }
__host__ __device__ __forceinline__ void stage_rc(int b, int& R, int& C) { const int st = b / 1024, sb = b % 1024, swz = sb ^ (((sb >> 9) & 1) << 5); R = (st >> 1) * 16 + swz / 64; C = (st & 1) * 32 + (swz % 64) / 2; }
__host__ __device__ __forceinline__ int perm32(int rho) { const int n = rho >> 4, i = rho & 15; return 8 * (i >> 2) + 4 * n + (i & 3); }

struct Unit { int pm, pn; };
struct Gemm { const bf16_t* A; const bf16_t* Bt; int M, N, K; };

struct StaticOrder {
    int nM, nN, nwg, G, c;
    __host__ __device__ void init(int M, int N, int G_, int c_) { nM = M / BM; nN = N / BM; nwg = nM * nN; G = G_; c = c_; }
    __host__ __device__ bool next(int i, Unit& u) const {
        const long L = (long)i * G + c; if (L >= nwg) return false;
        int wgid = (int)L; { const int q = nwg / NXCD, r = nwg % NXCD, xcd = wgid % NXCD, off = wgid / NXCD; wgid = (xcd < r ? xcd * (q + 1) : r * (q + 1) + (xcd - r) * q) + off; }
        const int nig = WGM * nN, gid = wgid / nig, fm = gid * WGM, gsz = (nM - fm) < WGM ? (nM - fm) : WGM;
        u.pm = fm + ((wgid % nig) % gsz); u.pn = (wgid % nig) / gsz; return true;
    }
    __device__ __forceinline__ void a_ready(const Unit&) const {}
    __device__ __forceinline__ void done(const Unit&) const {}
};

__device__ __forceinline__ unsigned cvt_pk_bf16(float lo, float hi) { unsigned r; asm volatile("v_cvt_pk_bf16_f32 %0, %1, %2" : "=v"(r) : "v"(lo), "v"(hi)); return r; }
template <int ACT> struct EpiBf16 {
    static constexpr bool PERM = true, AFTER_DRAIN = false;
    bf16_t* O; int ldc;
    __device__ __forceinline__ void operator()(const f32x4 (&acc)[2][2][4][2], const Unit& u, int wr, int wc, int fr, int fq) const {
        const int row0 = u.pm * BM + wr * 64 + fr; const int col0 = u.pn * BM + wc * 32 + 8 * fq;
#pragma unroll
        for (int ai = 0; ai < 2; ++ai)
#pragma unroll
            for (int m = 0; m < 4; ++m) { bf16_t* rowp = O + (size_t)(row0 + ai * HALF + m * 16) * ldc + col0;
#pragma unroll
                for (int bj = 0; bj < 2; ++bj) { f32x4 v0 = acc[ai][bj][m][0], v1 = acc[ai][bj][m][1];
                    if (ACT == 2) {
#pragma unroll
                        for (int e = 0; e < 4; ++e) { float a = fmaxf(v0[e], 0.f), b = fmaxf(v1[e], 0.f); v0[e] = a * a; v1[e] = b * b; }
                    }
                    u32x4 w; w.x = cvt_pk_bf16(v0[0], v0[1]); w.y = cvt_pk_bf16(v0[2], v0[3]); w.z = cvt_pk_bf16(v1[0], v1[1]); w.w = cvt_pk_bf16(v1[2], v1[3]);
                    *(u32x4*)(rowp + bj * HALF) = w; } }
    }
};

template <class Epi, class Sched, bool ALIGN_EPI = false, bool SP2 = false>
__device__ __forceinline__ void gemm_phase(PG8_LAS unsigned char* lds, const Gemm g, const Sched& S, const Epi& E) {
    const int tid = opaque_tid(), wid = __builtin_amdgcn_readfirstlane(tid >> 6), lane = tid & 63, wr = wid >> 2, wc = wid & 3, fr = lane & 15, fq = lane >> 4;
    const int K = g.K, nt = K / BK;
    unsigned voffA[2], voffB[2];
#pragma unroll
    for (int i = 0; i < 2; ++i) { int R, C; stage_rc(tid * 16 + i * 8192, R, C); const int Rb = Epi::PERM ? ((R & ~31) + perm32(R & 31)) : R;
        voffA[i] = (unsigned)(R * K + C) * 2u; voffB[i] = (unsigned)(Rb * K + C) * 2u; }
    const size_t kstep = (size_t)(BK * 2);
    const size_t hstep = (size_t)HALF * K * 2;
    const size_t tstep = 2 * hstep;
    const unsigned ldsw = (unsigned)wid * 1024u;
    const int aoff = lds_byte(wr * 64 + fr, fq * 8), boff = lds_byte(wc * 32 + fr, fq * 8);
#define PG8_SA(b, h) (((b) * 2 + (h)) * HTB)
#define PG8_SB(b, h) ((4 + (b) * 2 + (h)) * HTB)
#define PG8_STAGE(bufoff, gbase, voff) do { _Pragma("unroll") for (int _i = 0; _i < 2; ++_i) \
        __builtin_amdgcn_global_load_lds((const unsigned*)((const char*)(gbase) + (voff)[_i]), (PG8_LAS unsigned*)(lds + (bufoff) + ldsw + _i * 8192), 16, 0, 0); } while (0)
#define PG8_LDA(dst, b, h) do { _Pragma("unroll") for (int m = 0; m < 4; ++m) _Pragma("unroll") for (int k = 0; k < 2; ++k) dst[m][k] = *(const PG8_LAS bf16x8*)(lds + PG8_SA(b, h) + aoff + m * 2048 + k * 1024); } while (0)
#define PG8_LDB(dst, b, h) do { _Pragma("unroll") for (int n = 0; n < 2; ++n) _Pragma("unroll") for (int k = 0; k < 2; ++k) dst[n][k] = *(const PG8_LAS bf16x8*)(lds + PG8_SB(b, h) + boff + n * 2048 + k * 1024); } while (0)
#define PG8_MMA(ai, bj, At, Bt) do { __builtin_amdgcn_s_setprio(1); _Pragma("unroll") for (int m = 0; m < 4; ++m) _Pragma("unroll") for (int n = 0; n < 2; ++n) _Pragma("unroll") for (int k = 0; k < 2; ++k) \
        acc[ai][bj][m][n] = __builtin_amdgcn_mfma_f32_16x16x32_bf16(Bt[n][k], At[m][k], acc[ai][bj][m][n], 0, 0, 0); __builtin_amdgcn_s_setprio(0); } while (0)
#define PG8_WAIT_V(n) asm volatile("s_waitcnt vmcnt(" #n ")" ::: "memory")
#define PG8_WAIT_L(n) asm volatile("s_waitcnt lgkmcnt(" #n ")" ::: "memory")
#define PG8_BAR __builtin_amdgcn_s_barrier()
#define PG8_SCHED __builtin_amdgcn_sched_barrier(0)
    Unit cur, nxt; int ui = 0;
    if (!S.next(0, cur)) return;
    f32x4 acc[2][2][4][2];
#pragma unroll
    for (int a = 0; a < 2; ++a)
#pragma unroll
        for (int b = 0; b < 2; ++b)
#pragma unroll
            for (int m = 0; m < 4; ++m)
#pragma unroll
                for (int n = 0; n < 2; ++n) acc[a][b][m][n] = (f32x4){0.f, 0.f, 0.f, 0.f};
    bf16x8 At[4][2], B0[2][2], B1[2][2];
    const char* cA = (const char*)g.A + (size_t)cur.pm * tstep; const char* cB = (const char*)g.Bt + (size_t)cur.pn * tstep;
    S.a_ready(cur);
    if constexpr (SP2) {
        PG8_STAGE(PG8_SB(0, 0), cB, voffB); PG8_STAGE(PG8_SB(0, 1), cB + hstep, voffB); PG8_STAGE(PG8_SA(0, 0), cA, voffA); PG8_STAGE(PG8_SA(0, 1), cA + hstep, voffA);
        if (wr == 1) PG8_BAR;
        PG8_WAIT_V(2); PG8_BAR;
        PG8_STAGE(PG8_SB(1, 0), cB + kstep, voffB); PG8_STAGE(PG8_SA(1, 0), cA + kstep, voffA); PG8_STAGE(PG8_SB(1, 1), cB + hstep + kstep, voffB);
        PG8_WAIT_V(6); PG8_BAR;
    } else {
        PG8_STAGE(PG8_SB(0, 0), cB, voffB); PG8_STAGE(PG8_SA(0, 0), cA, voffA); PG8_STAGE(PG8_SB(0, 1), cB + hstep, voffB); PG8_STAGE(PG8_SA(0, 1), cA + hstep, voffA);
        if (wr == 1) PG8_BAR;
        PG8_WAIT_V(4); PG8_BAR;
        PG8_STAGE(PG8_SB(1, 0), cB + kstep, voffB); PG8_STAGE(PG8_SA(1, 0), cA + kstep, voffA); PG8_STAGE(PG8_SB(1, 1), cB + hstep + kstep, voffB);
        PG8_WAIT_V(6); PG8_BAR;
    }
    for (;;) {
        const bool has_next = S.next(ui + 1, nxt);
        const char* nA = has_next ? (const char*)g.A + (size_t)nxt.pm * tstep : cA; const char* nB = has_next ? (const char*)g.Bt + (size_t)nxt.pn * tstep : cB;
        for (int t = 0; t < nt; t += 2) {
            const bool last = (t == nt - 2);
            const char* a1 = cA + (size_t)(t + 1) * kstep;
            const char* a2 = last ? nA : cA + (size_t)(t + 2) * kstep; const char* b2 = last ? nB : cB + (size_t)(t + 2) * kstep;
            const char* a3 = a2 + kstep; const char* b3 = b2 + kstep;
            if (last && has_next) S.a_ready(nxt);
            if constexpr (SP2) {
            PG8_LDB(B0, 0, 0); PG8_LDB(B1, 0, 1); PG8_SCHED; PG8_LDA(At, 0, 0); PG8_STAGE(PG8_SA(1, 1), a1 + hstep, voffA);
            PG8_WAIT_V(8); PG8_WAIT_L(0); PG8_BAR; PG8_MMA(0, 0, At, B0); PG8_MMA(0, 1, At, B1); PG8_BAR; PG8_SCHED;
            PG8_LDA(At, 0, 1); PG8_STAGE(PG8_SB(0, 0), b2, voffB); PG8_STAGE(PG8_SB(0, 1), b2 + hstep, voffB); PG8_STAGE(PG8_SA(0, 0), a2, voffA);
            PG8_WAIT_V(8); PG8_WAIT_L(0); PG8_BAR; PG8_MMA(1, 0, At, B0); PG8_MMA(1, 1, At, B1); PG8_BAR; PG8_SCHED;
            PG8_LDB(B0, 1, 0); PG8_LDB(B1, 1, 1); PG8_SCHED; PG8_LDA(At, 1, 0); PG8_STAGE(PG8_SA(0, 1), a2 + hstep, voffA);
            PG8_WAIT_V(8); PG8_WAIT_L(0); PG8_BAR; PG8_MMA(0, 0, At, B0); PG8_MMA(0, 1, At, B1); PG8_BAR; PG8_SCHED;
            PG8_LDA(At, 1, 1); PG8_STAGE(PG8_SB(1, 0), b3, voffB); PG8_STAGE(PG8_SB(1, 1), b3 + hstep, voffB); PG8_STAGE(PG8_SA(1, 0), a3, voffA);
            PG8_WAIT_V(8); PG8_WAIT_L(0); PG8_BAR; PG8_MMA(1, 0, At, B0); PG8_MMA(1, 1, At, B1); PG8_BAR; PG8_SCHED;
            } else {
            PG8_LDB(B0, 0, 0); PG8_SCHED; PG8_LDA(At, 0, 0); PG8_STAGE(PG8_SA(1, 1), a1 + hstep, voffA);
            PG8_WAIT_L(8); PG8_BAR; PG8_WAIT_L(0); PG8_MMA(0, 0, At, B0); PG8_BAR; PG8_SCHED;
            PG8_LDB(B1, 0, 1); PG8_STAGE(PG8_SB(0, 0), b2, voffB);
            PG8_BAR; PG8_WAIT_L(0); PG8_MMA(0, 1, At, B1); PG8_BAR;
            PG8_LDA(At, 0, 1); PG8_STAGE(PG8_SA(0, 0), a2, voffA);
            PG8_BAR; PG8_WAIT_L(0); PG8_MMA(1, 0, At, B0); PG8_BAR; PG8_SCHED;
            PG8_STAGE(PG8_SB(0, 1), b2 + hstep, voffB);
            PG8_WAIT_V(6); PG8_BAR; PG8_MMA(1, 1, At, B1); PG8_BAR;
            PG8_LDB(B0, 1, 0); PG8_SCHED; PG8_LDA(At, 1, 0); PG8_STAGE(PG8_SA(0, 1), a2 + hstep, voffA);
            PG8_WAIT_L(8); PG8_BAR; PG8_WAIT_L(0); PG8_MMA(0, 0, At, B0); PG8_BAR; PG8_SCHED;
            PG8_LDB(B1, 1, 1); PG8_STAGE(PG8_SB(1, 0), b3, voffB);
            PG8_BAR; PG8_WAIT_L(0); PG8_MMA(0, 1, At, B1); PG8_BAR;
            PG8_LDA(At, 1, 1); PG8_STAGE(PG8_SA(1, 0), a3, voffA);
            PG8_BAR; PG8_WAIT_L(0); PG8_MMA(1, 0, At, B0); PG8_BAR; PG8_SCHED;
            PG8_STAGE(PG8_SB(1, 1), b3 + hstep, voffB);
            PG8_WAIT_V(6); PG8_BAR; PG8_MMA(1, 1, At, B1); PG8_BAR;
            }
        }
        if constexpr (ALIGN_EPI) { if (wr == 0) PG8_BAR; }
        if constexpr (!Epi::AFTER_DRAIN) { E(acc, cur, wr, wc, fr, fq); S.done(cur); }
        if (!has_next) break;
#pragma unroll
        for (int a = 0; a < 2; ++a)
#pragma unroll
            for (int b = 0; b < 2; ++b)
#pragma unroll
                for (int m = 0; m < 4; ++m)
#pragma unroll
                    for (int n = 0; n < 2; ++n) acc[a][b][m][n] = (f32x4){0.f, 0.f, 0.f, 0.f};
        cur = nxt; cA = nA; cB = nB; ++ui;
        if constexpr (ALIGN_EPI) { if (wr == 1) PG8_BAR; }
    }
    PG8_WAIT_V(0);
    if constexpr (!ALIGN_EPI) { if (wr == 0) PG8_BAR; }
    PG8_BAR;
    if constexpr (Epi::AFTER_DRAIN) { E.fused(acc, cur, wr, wc, fr, fq, lds, wid, lane); S.done(cur); }
#undef PG8_SA
#undef PG8_SB
#undef PG8_STAGE
#undef PG8_LDA
#undef PG8_LDB
#undef PG8_MMA
#undef PG8_WAIT_V
#undef PG8_WAIT_L
#undef PG8_BAR
#undef PG8_SCHED
}
}

#define LAS __attribute__((address_space(3)))
typedef unsigned short bf16;
typedef float f32x4 __attribute__((ext_vector_type(4)));
typedef float f32x2 __attribute__((ext_vector_type(2)));
typedef short bf16x8 __attribute__((ext_vector_type(8)));
typedef unsigned u32x4 __attribute__((ext_vector_type(4)));
typedef unsigned u32x2 __attribute__((ext_vector_type(2)));

constexpr int NWAVES = 8, NTHR = 512;
constexpr int DM = 1024, MP = 16384, MS = 1024, M = MP + MS, DIN = 2576, NZ = 2560, FF = 4096;
constexpr float EPS = 1e-6f;
constexpr size_t MiB = 1u << 20;
constexpr size_t W_IN = 0, W_OUT = W_IN + (size_t)NZ * DM * 2, W_FF1 = W_OUT + (size_t)DM * DM * 2, W_FF2 = W_FF1 + (size_t)FF * DM * 2,
                 W_LR = W_FF2 + (size_t)FF * DM * 2, W_RG = W_LR + 16 * DM * 2, LAYER_W = W_RG + 8 * 128 * 64 * 2;
constexpr size_t WS_W = 1 * MiB, WS_H = 49 * MiB, WS_GO = 83 * MiB, WS_BIG = 117 * MiB, WS_Z = WS_BIG, WS_MIX = WS_BIG + 85 * MiB, WS_DS = WS_BIG + 119 * MiB, WS_DEC = WS_BIG + 135 * MiB, WS_LR = 253 * MiB, WS_CA = 254 * MiB + 256 * 1024, WS_END = 256 * MiB;
static_assert(WS_W + 2 * LAYER_W <= WS_H, "weights fit");
static_assert((size_t)M * DM * 2 == 34 * MiB && (size_t)M * NZ * 2 == 85 * MiB && (size_t)M * FF * 2 == 136 * MiB, "sizes");
constexpr size_t OUT_GLA_P = 17825792, OUT_RG_P = 18350080, OUT_CV_P = 18358272, OUT_GLA_S = 18382848, OUT_RG_S = 20480000, OUT_CV_S = 20512768, OUT_TOTAL = 20611072;
constexpr int LDS_BYTES = 147456;

struct Args { const float* in[23]; float* out; unsigned char* ws; };
enum { I_XP = 0, I_XS, I_SGLA, I_SRG, I_SCV, I_GPRE, I_WIN, I_WLR2, I_BLR, I_GNORM, I_CW, I_CB, I_WA, I_BA, I_WX, I_BX, I_LAM, I_WOUT, I_GPOST, I_GPREFF, I_WFF1, I_WFF2, I_GPOSTFF };

#define LDS_BAR() do { asm volatile("s_waitcnt lgkmcnt(0)" ::: "memory"); __builtin_amdgcn_s_barrier(); asm volatile("" ::: "memory"); } while (0)
#define LDS_WAIT() asm volatile("s_waitcnt lgkmcnt(0)" ::: "memory")

__device__ __forceinline__ unsigned pk2(float lo, float hi) { return pg8::cvt_pk_bf16(lo, hi); }
__device__ __forceinline__ unsigned short f2bf(float f) { return (unsigned short)(pk2(f, 0.f) & 0xffffu); }
__device__ __forceinline__ float bf2f(unsigned short u) { return __uint_as_float(((unsigned)u) << 16); }
__device__ __forceinline__ float blo(unsigned w) { return __uint_as_float(w << 16); }
__device__ __forceinline__ float bhi(unsigned w) { return __uint_as_float(w & 0xffff0000u); }
__device__ __forceinline__ void unpack8(u32x4 v, float (&f)[8]) { f[0] = blo(v.x); f[1] = bhi(v.x); f[2] = blo(v.y); f[3] = bhi(v.y); f[4] = blo(v.z); f[5] = bhi(v.z); f[6] = blo(v.w); f[7] = bhi(v.w); }
__device__ __forceinline__ u32x4 pack8(const float (&f)[8]) { u32x4 o; o.x = pk2(f[0], f[1]); o.y = pk2(f[2], f[3]); o.z = pk2(f[4], f[5]); o.w = pk2(f[6], f[7]); return o; }
__device__ __forceinline__ float wave_sum(float v) {
#pragma unroll
    for (int o = 1; o < 64; o <<= 1) v += __shfl_xor(v, o);
    return v;
}
__device__ __forceinline__ float sigm(float x) { return __builtin_amdgcn_rcpf(1.f + __expf(-x)); }
__device__ __forceinline__ float gelu_tanh(float x) { const float u = 0.7978845608028654f * (x + 0.044715f * x * x * x); const float e = __expf(-2.f * fabsf(u)); float th = (1.f - e) * __builtin_amdgcn_rcpf(1.f + e); th = u < 0.f ? -th : th; return 0.5f * x * (1.f + th); }
__device__ __forceinline__ const float* xrow_in(const Args& A, int m) { return m < MP ? A.in[I_XP] + (size_t)m * DM : A.in[I_XS] + (size_t)(m - MP) * DM; }

__device__ __forceinline__ void p0_transpose_item(const float* W, int ldw, int col0, int K, bf16* WT, int row_off, LAS float* scr, int kb, int nb, int lane) {
    const int k0 = 64 * kb, n0 = 32 * nb;
#pragma unroll 8
    for (int i = 0; i < 32; ++i) { const int kk = 2 * i + (lane >> 5); scr[kk * 33 + (lane & 31)] = W[(size_t)(k0 + kk) * ldw + col0 + n0 + (lane & 31)]; }
    LDS_WAIT(); asm volatile("" ::: "memory");
    const int c = lane & 7;
#pragma unroll
    for (int j = 0; j < 4; ++j) { const int n = (lane >> 3) + 8 * j; const LAS float* s = scr + (8 * c) * 33 + n;
        u32x4 o; o.x = pk2(s[0 * 33], s[1 * 33]); o.y = pk2(s[2 * 33], s[3 * 33]); o.z = pk2(s[4 * 33], s[5 * 33]); o.w = pk2(s[6 * 33], s[7 * 33]);
        *(u32x4*)(WT + (size_t)(row_off + n0 + n) * K + k0 + 8 * c) = o; }
    LDS_WAIT(); asm volatile("" ::: "memory");
}

template <bool HAS_GO, bool HAS_H>
__device__ __forceinline__ void row_op(const float* xs, const bf16* go, const f32x4 (&ga)[4], float* xo, const f32x4 (&gb)[4], bf16* hb, int lane) {
    f32x4 x[4];
#pragma unroll
    for (int j = 0; j < 4; ++j) x[j] = *(const f32x4*)(xs + 4 * lane + 256 * j);
    if (HAS_GO) {
        f32x4 f[4]; float ss = 0.f;
#pragma unroll
        for (int j = 0; j < 4; ++j) { const u32x2 wv = *(const u32x2*)(go + 4 * lane + 256 * j); f[j] = (f32x4){blo(wv.x), bhi(wv.x), blo(wv.y), bhi(wv.y)};
            ss += (f[j].x * f[j].x + f[j].y * f[j].y) + (f[j].z * f[j].z + f[j].w * f[j].w); }
        const float rstd = rsqrtf(wave_sum(ss) * (1.f / DM) + EPS);
#pragma unroll
        for (int j = 0; j < 4; ++j) { x[j] = x[j] + f[j] * rstd * ga[j]; *(f32x4*)(xo + 4 * lane + 256 * j) = x[j]; }
    }
    if (HAS_H) {
        float s2 = 0.f;
#pragma unroll
        for (int j = 0; j < 4; ++j) s2 += (x[j].x * x[j].x + x[j].y * x[j].y) + (x[j].z * x[j].z + x[j].w * x[j].w);
        const float r2 = rsqrtf(wave_sum(s2) * (1.f / DM) + EPS);
#pragma unroll
        for (int j = 0; j < 4; ++j) { const f32x4 hv = x[j] * r2 * gb[j]; u32x2 o; o.x = pk2(hv.x, hv.y); o.y = pk2(hv.z, hv.w); *(u32x2*)(hb + 4 * lane + 256 * j) = o; }
    }
}
__device__ __forceinline__ void load_g(const float* g, int lane, f32x4 (&v)[4]) {
#pragma unroll
    for (int j = 0; j < 4; ++j) v[j] = *(const f32x4*)(g + 4 * lane + 256 * j);
}

template <int MODE>
__device__ __forceinline__ void gla_item(LAS unsigned char* L, const Args& A, int l, int b, int h, int c) {
    const int tid = opaque_tid(), w = __builtin_amdgcn_readfirstlane(tid >> 6), lane = tid & 63, r = lane & 15, q = lane >> 4;
    const int t = tid >> 3, oct = tid & 7, o8 = oct * 8, tsw = t ^ (oct << 3);
    LAS bf16* QT = (LAS bf16*)(L + 0); LAS bf16* KT = (LAS bf16*)(L + 9216); LAS bf16* KHT = (LAS bf16*)(L + 18432); LAS bf16* ATT = (LAS bf16*)(L + 27648);
    LAS bf16* VT = (LAS bf16*)(L + 36864); LAS bf16* ST = (LAS bf16*)(L + 55296); LAS bf16* GS = (LAS bf16*)(L + 73728);
    LAS float* LRS = (LAS float*)(L + 91136); LAS float* WL = (LAS float*)(L + 95232); LAS float* SEG = (LAS float*)(L + 99328);
    LAS float* SSQ = (LAS float*)(L + 101376); LAS float* BL = (LAS float*)(L + 101888);
    constexpr bool SMP = (MODE == 0), DO_OUT = (MODE != 1), DO_S = (MODE != 2);
    const int ntok = SMP ? 32 : 64, row0 = SMP ? MP + b * 32 : b * 2048 + c * 64;
    const int item = (b * 4 + h) * 32 + c;
    const bf16* Z = (const bf16*)(A.ws + WS_Z); bf16* MIX = (bf16*)(A.ws + WS_MIX); const float* LR = (const float*)(A.ws + WS_LR);
    bf16* DS = (bf16*)(A.ws + WS_DS) + (size_t)item * 8192; float* DEC = (float*)(A.ws + WS_DEC) + (size_t)item * 64;
    const bool valid = t < ntok;
    const u32x4 z4 = (u32x4){0u, 0u, 0u, 0u};
    const bf16* zr = Z + (size_t)(row0 + t) * NZ;
    u32x4 rq = z4, rk, rv0, rv1, rg0 = z4, rg1 = z4; f32x2 rl;
    rk = valid ? *(const u32x4*)(zr + 256 + h * 64 + o8) : z4;
    rv0 = valid ? *(const u32x4*)(zr + 512 + h * 128 + o8) : z4; rv1 = valid ? *(const u32x4*)(zr + 512 + h * 128 + 64 + o8) : z4;
    rl = valid ? *(const f32x2*)(LR + (size_t)(row0 + t) * 16 + oct * 2) : (f32x2){0.f, 0.f};
    if (DO_OUT) { rq = valid ? *(const u32x4*)(zr + h * 64 + o8) : z4; rg0 = valid ? *(const u32x4*)(zr + 1024 + h * 128 + o8) : z4; rg1 = valid ? *(const u32x4*)(zr + 1024 + h * 128 + 64 + o8) : z4; }
    f32x4 S[4];
#pragma unroll
    for (int n = 0; n < 4; ++n) S[n] = (f32x4){0.f, 0.f, 0.f, 0.f};
    if (MODE == 0) { const float* s0 = A.in[I_SGLA] + ((size_t)(l * 32 + b) * 4 + h) * 8192;
#pragma unroll
        for (int n = 0; n < 4; ++n) S[n] = *(const f32x4*)(s0 + (16 * n + r) * 128 + 16 * w + q * 4);
#pragma unroll
        for (int n = 0; n < 4; ++n)
#pragma unroll
            for (int i = 0; i < 4; ++i) ST[(16 * w + q * 4 + i) * 72 + 16 * n + r] = f2bf(S[n][i]);
    }
    if (MODE == 2) {
#pragma unroll
        for (int k = 0; k < 2; ++k) { const int idx = tid + 512 * k, row = idx >> 3, c8 = (idx & 7) * 8; *(LAS u32x4*)(ST + row * 72 + c8) = *(const u32x4*)(DS + row * 64 + c8); }
    }
    { const int idx = tid * 2, j = idx >> 6, d = idx & 63; const float* src = A.in[I_WLR2] + (size_t)(l * 16 + j) * 256 + h * 64 + d; WL[j * 64 + d] = src[0]; WL[j * 64 + d + 1] = src[1]; }
    float blr[8];
#pragma unroll
    for (int dd = 0; dd < 8; ++dd) blr[dd] = A.in[I_BLR][l * 256 + h * 64 + o8 + dd];
    const int mi = w >> 1;
    LRS[t * 16 + oct * 2] = rl.x; LRS[t * 16 + oct * 2 + 1] = rl.y;
    LDS_BAR();
    float la[8];
    {
        float lrv[16];
#pragma unroll
        for (int j4 = 0; j4 < 4; ++j4) { const f32x4 v = *(const LAS f32x4*)(LRS + t * 16 + j4 * 4); lrv[j4 * 4] = v.x; lrv[j4 * 4 + 1] = v.y; lrv[j4 * 4 + 2] = v.z; lrv[j4 * 4 + 3] = v.w; }
#pragma unroll
        for (int dd = 0; dd < 8; ++dd) la[dd] = blr[dd];
#pragma unroll
        for (int j = 0; j < 16; ++j) { const f32x4 w0 = *(const LAS f32x4*)(WL + j * 64 + o8), w1 = *(const LAS f32x4*)(WL + j * 64 + o8 + 4);
            la[0] += lrv[j] * w0.x; la[1] += lrv[j] * w0.y; la[2] += lrv[j] * w0.z; la[3] += lrv[j] * w0.w;
            la[4] += lrv[j] * w1.x; la[5] += lrv[j] * w1.y; la[6] += lrv[j] * w1.z; la[7] += lrv[j] * w1.w; }
#pragma unroll
        for (int dd = 0; dd < 8; ++dd) { const float x = la[dd]; const float ls = fminf(x, 0.f) - __logf(1.f + __expf(-fabsf(x))); la[dd] = valid ? ls * (1.f / 16.f) : 0.f; }
#pragma unroll
        for (int dd = 0; dd < 8; ++dd) { float v = la[dd]; float u = __shfl_up(v, 8); if (lane >= 8) v += u; u = __shfl_up(v, 16); if (lane >= 16) v += u; u = __shfl_up(v, 32); if (lane >= 32) v += u; la[dd] = v; }
        if ((lane >> 3) == 7) { *(LAS f32x4*)(SEG + w * 64 + o8) = (f32x4){la[0], la[1], la[2], la[3]}; *(LAS f32x4*)(SEG + w * 64 + o8 + 4) = (f32x4){la[4], la[5], la[6], la[7]}; }
    }
    LDS_BAR();
    float bl[8];
    {
        float pre[8];
#pragma unroll
        for (int dd = 0; dd < 8; ++dd) { pre[dd] = 0.f; bl[dd] = 0.f; }
#pragma unroll
        for (int ww = 0; ww < 8; ++ww) { const f32x4 s0 = *(const LAS f32x4*)(SEG + ww * 64 + o8), s1 = *(const LAS f32x4*)(SEG + ww * 64 + o8 + 4);
            const float m = ww < w ? 1.f : 0.f;
            pre[0] += m * s0.x; pre[1] += m * s0.y; pre[2] += m * s0.z; pre[3] += m * s0.w; pre[4] += m * s1.x; pre[5] += m * s1.y; pre[6] += m * s1.z; pre[7] += m * s1.w;
            bl[0] += s0.x; bl[1] += s0.y; bl[2] += s0.z; bl[3] += s0.w; bl[4] += s1.x; bl[5] += s1.y; bl[6] += s1.z; bl[7] += s1.w; }
#pragma unroll
        for (int dd = 0; dd < 8; ++dd) la[dd] += pre[dd];
    }
    {
        float kf[8]; unpack8(rk, kf);
        if (DO_OUT) { float qf[8], qt[8], kt[8]; unpack8(rq, qf);
#pragma unroll
            for (int dd = 0; dd < 8; ++dd) { qt[dd] = qf[dd] * 0.125f * __expf(la[dd]); kt[dd] = kf[dd] * __expf(-la[dd]); }
            *(LAS u32x4*)(QT + t * 72 + o8) = pack8(qt); *(LAS u32x4*)(KT + t * 72 + o8) = pack8(kt);
            *(LAS u32x4*)(GS + t * 136 + o8) = rg0; *(LAS u32x4*)(GS + t * 136 + 64 + o8) = rg1; }
        if (DO_S) {
#pragma unroll
            for (int dd = 0; dd < 8; ++dd) KHT[(o8 + dd) * 72 + tsw] = f2bf(kf[dd] * __expf(bl[dd] - la[dd]));
            if (t == 0) {
#pragma unroll
                for (int dd = 0; dd < 8; ++dd) BL[o8 + dd] = __expf(bl[dd]);
            } }
        const unsigned vw[8] = {rv0.x, rv0.y, rv0.z, rv0.w, rv1.x, rv1.y, rv1.z, rv1.w};
#pragma unroll
        for (int e2 = 0; e2 < 8; ++e2) { const int e = (e2 < 4 ? 0 : 64) + o8 + (e2 & 3) * 2; VT[e * 72 + tsw] = (bf16)(vw[e2] & 0xffffu); VT[(e + 1) * 72 + tsw] = (bf16)(vw[e2] >> 16); }
    }
    LDS_BAR();
    const int swr = (r >> 3);
    f32x4 O[4];
    if (DO_OUT) {
#pragma unroll
        for (int jj = 0; jj < 2; ++jj) { const int nj = 2 * (w & 1) + jj; f32x4 acc = (f32x4){0.f, 0.f, 0.f, 0.f};
#pragma unroll
            for (int ks = 0; ks < 2; ++ks) { const bf16x8 a = *(const LAS bf16x8*)(QT + (16 * mi + r) * 72 + ks * 32 + q * 8), bb = *(const LAS bf16x8*)(KT + (16 * nj + r) * 72 + ks * 32 + q * 8);
                acc = __builtin_amdgcn_mfma_f32_16x16x32_bf16(a, bb, acc, 0, 0, 0); }
#pragma unroll
            for (int i = 0; i < 4; ++i) { const int row = 16 * mi + q * 4 + i, col = 16 * nj + r; ATT[row * 72 + col] = f2bf(col <= row ? acc[i] : 0.f); } }
        LDS_BAR();
#pragma unroll
        for (int n = 0; n < 4; ++n) O[n] = (f32x4){0.f, 0.f, 0.f, 0.f};
#pragma unroll
        for (int ks = 0; ks < 2; ++ks) { const bf16x8 a = *(const LAS bf16x8*)(QT + (16 * mi + r) * 72 + ks * 32 + q * 8);
#pragma unroll
            for (int n = 0; n < 4; ++n) { const bf16x8 bb = *(const LAS bf16x8*)(ST + (16 * (4 * (w & 1) + n) + r) * 72 + ks * 32 + q * 8); O[n] = __builtin_amdgcn_mfma_f32_16x16x32_bf16(a, bb, O[n], 0, 0, 0); } }
#pragma unroll
        for (int ks = 0; ks < 2; ++ks) { const bf16x8 a = *(const LAS bf16x8*)(ATT + (16 * mi + r) * 72 + ks * 32 + q * 8);
#pragma unroll
            for (int n = 0; n < 4; ++n) { const int sw = ((2 * n + swr) & 7) << 3; const bf16x8 bb = *(const LAS bf16x8*)(VT + (16 * (4 * (w & 1) + n) + r) * 72 + ((ks * 32 + q * 8) ^ sw)); O[n] = __builtin_amdgcn_mfma_f32_16x16x32_bf16(a, bb, O[n], 0, 0, 0); } }
    }
    if (DO_S) {
#pragma unroll
        for (int n = 0; n < 4; ++n) { const float dec = BL[16 * n + r]; S[n] = S[n] * dec; }
#pragma unroll
        for (int ks = 0; ks < 2; ++ks) { const int swa = ((2 * w + swr) & 7) << 3; const bf16x8 a = *(const LAS bf16x8*)(VT + (16 * w + r) * 72 + ((ks * 32 + q * 8) ^ swa));
#pragma unroll
            for (int n = 0; n < 4; ++n) { const int sw = ((2 * n + swr) & 7) << 3; const bf16x8 bb = *(const LAS bf16x8*)(KHT + (16 * n + r) * 72 + ((ks * 32 + q * 8) ^ sw)); S[n] = __builtin_amdgcn_mfma_f32_16x16x32_bf16(a, bb, S[n], 0, 0, 0); } }
    }
    if (DO_OUT) {
#pragma unroll
        for (int i = 0; i < 4; ++i) { float s = 0.f;
#pragma unroll
            for (int n = 0; n < 4; ++n) s += O[n][i] * O[n][i];
            s += __shfl_xor(s, 1); s += __shfl_xor(s, 2); s += __shfl_xor(s, 4); s += __shfl_xor(s, 8);
            if (r == 0) SSQ[(16 * mi + q * 4 + i) * 2 + (w & 1)] = s; }
    }
    LDS_BAR();
    if (MODE == 1) {
#pragma unroll
        for (int n = 0; n < 4; ++n)
#pragma unroll
            for (int i = 0; i < 4; ++i) ST[(16 * w + q * 4 + i) * 72 + 16 * n + r] = f2bf(S[n][i]);
        if (tid < 64) DEC[tid] = BL[tid];
    }
    if (DO_OUT) {
        float gn[4];
#pragma unroll
        for (int n = 0; n < 4; ++n) gn[n] = A.in[I_GNORM][l * 128 + 16 * (4 * (w & 1) + n) + r];
#pragma unroll
        for (int i = 0; i < 4; ++i) { const int row = 16 * mi + q * 4 + i; const float rstd = __builtin_amdgcn_rsqf((SSQ[row * 2] + SSQ[row * 2 + 1]) * (1.f / 128.f) + EPS);
#pragma unroll
            for (int n = 0; n < 4; ++n) { const int e = 16 * (4 * (w & 1) + n) + r; const float gv = bf2f(GS[row * 136 + e]); GS[row * 136 + e] = f2bf(O[n][i] * rstd * gn[n] * gv * sigm(gv)); } }
    }
    LDS_BAR();
    if (DO_OUT) { if (valid) { bf16* mr = MIX + (size_t)(row0 + t) * DM + h * 128 + o8;
        *(u32x4*)(mr) = *(const LAS u32x4*)(GS + t * 136 + o8); *(u32x4*)(mr + 64) = *(const LAS u32x4*)(GS + t * 136 + 64 + o8); } }
    if (MODE == 1) {
#pragma unroll
        for (int k = 0; k < 2; ++k) { const int idx = tid + 512 * k, row = idx >> 3, c8 = (idx & 7) * 8; *(u32x4*)(DS + row * 64 + c8) = *(const LAS u32x4*)(ST + row * 72 + c8); }
    }
    if (MODE == 0) { float* so = A.out + OUT_GLA_S + ((size_t)(l * 32 + b) * 4 + h) * 8192;
#pragma unroll
        for (int n = 0; n < 4; ++n) *(f32x4*)(so + (16 * n + r) * 128 + 16 * w + q * 4) = S[n]; }
    LDS_BAR();
}

__device__ __forceinline__ void gla_scan(const Args& A, int l, int gt, int NGT) {
    unsigned* DS32 = (unsigned*)(A.ws + WS_DS); const float* DEC = (const float*)(A.ws + WS_DEC);
    for (int e = gt; e < 32 * 4096; e += NGT) {
        const int bh = e >> 12, p = e & 4095, dk0 = (2 * p) & 63, dv = p >> 5;
        float s0 = 0.f, s1 = 0.f;
        unsigned* dp = DS32 + (size_t)bh * 32 * 4096 + p; const float* dc = DEC + (size_t)bh * 32 * 64 + dk0;
#pragma unroll 8
        for (int c = 0; c < 32; ++c) { const unsigned wv = dp[(size_t)c * 4096]; const f32x2 d = *(const f32x2*)(dc + c * 64);
            dp[(size_t)c * 4096] = pk2(s0, s1); s0 = d.x * s0 + blo(wv); s1 = d.y * s1 + bhi(wv); }
        float* so = A.out + OUT_GLA_P + ((size_t)(l * 8) * 4 + bh) * 8192;
        so[dk0 * 128 + dv] = s0; so[(dk0 + 1) * 128 + dv] = s1;
    }
}

template <int MODE>
__device__ __forceinline__ void rg_item(LAS unsigned char* L, const Args& A, int l, int smp, int b, int c) {
    const int tid = opaque_tid(), w = __builtin_amdgcn_readfirstlane(tid >> 6), lane = tid & 63, r = lane & 15, q = lane >> 4, tl = lane >> 3, oct = lane & 7;
    const int ch0 = w * 64;
    LAS bf16* XR = (LAS bf16*)(L + w * 18432);
    LAS bf16* XCB = XR + 67 * 64;
    const int ntok = smp ? 32 : 64, row0 = smp ? MP + b * 32 : b * 2048 + c * 64, nbt = smp ? 32 : 8;
    const bf16* Z = (const bf16*)(A.ws + WS_Z); bf16* MIX = (bf16*)(A.ws + WS_MIX);
    float* CA = (float*)(A.ws + WS_CA); float* CU = CA + 8 * 32 * 512;
    const u32x4 z4 = (u32x4){0u, 0u, 0u, 0u};
    LDS_BAR();
    if (lane < 24) { const int j = lane >> 3; u32x4 v = z4;
        if (c > 0) v = *(const u32x4*)(Z + (size_t)(row0 - 3 + j) * NZ + 1536 + ch0 + oct * 8);
        else if (smp) { const float* sp = A.in[I_SCV] + ((size_t)(l * 32 + b) * 3 + j) * 512 + ch0 + oct * 8; const f32x4 a0 = *(const f32x4*)sp, a1 = *(const f32x4*)(sp + 4);
            v.x = pk2(a0.x, a0.y); v.y = pk2(a0.z, a0.w); v.z = pk2(a1.x, a1.y); v.w = pk2(a1.z, a1.w); }
        *(LAS u32x4*)(XR + j * 64 + oct * 8) = v; }
#pragma unroll
    for (int s = 0; s < 8; ++s) { const int t = s * 8 + tl; const u32x4 v = (t < ntok) ? *(const u32x4*)(Z + (size_t)(row0 + t) * NZ + 1536 + ch0 + oct * 8) : z4; *(LAS u32x4*)(XR + (3 + t) * 64 + oct * 8) = v; }
    LDS_WAIT(); asm volatile("" ::: "memory");
    {
        float cw[4][8], cb[8];
#pragma unroll
        for (int dd = 0; dd < 8; ++dd) { cb[dd] = A.in[I_CB][l * 512 + ch0 + oct * 8 + dd];
#pragma unroll
            for (int j = 0; j < 4; ++j) cw[j][dd] = A.in[I_CW][(l * 4 + j) * 512 + ch0 + oct * 8 + dd]; }
#pragma unroll
        for (int s = 0; s < 8; ++s) { const int t = s * 8 + tl; float xc[8];
#pragma unroll
            for (int dd = 0; dd < 8; ++dd) xc[dd] = cb[dd];
#pragma unroll
            for (int j = 0; j < 4; ++j) { float xf[8]; unpack8(*(const LAS u32x4*)(XR + (t + j) * 64 + oct * 8), xf);
#pragma unroll
                for (int dd = 0; dd < 8; ++dd) xc[dd] += cw[j][dd] * xf[dd]; }
            *(LAS u32x4*)(XCB + t * 72 + oct * 8) = pack8(xc); }
    }
    if (MODE == 2 && (smp || c == 31)) {
#pragma unroll
        for (int j = 0; j < 3; ++j) A.out[(smp ? OUT_CV_S : OUT_CV_P) + ((size_t)(l * nbt + b) * 3 + j) * 512 + ch0 + lane] = bf2f(XR[(ntok + j) * 64 + lane]);
    }
    LDS_WAIT(); asm volatile("" ::: "memory");
    const bf16* wrg = (const bf16*)(A.ws + WS_W + (size_t)l * LAYER_W + W_RG) + (size_t)w * 128 * 64;
    bf16x8 Bf[8][2];
#pragma unroll
    for (int n = 0; n < 8; ++n)
#pragma unroll
        for (int ks = 0; ks < 2; ++ks) Bf[n][ks] = *(const bf16x8*)(wrg + (16 * n + r) * 64 + ks * 32 + q * 8);
    float ba_[4], bx_[4], sp_[4], hc[4], At[4], Ut[4];
#pragma unroll
    for (int n = 0; n < 4; ++n) { const int ch = l * 512 + ch0 + 16 * n + r; ba_[n] = A.in[I_BA][ch]; bx_[n] = A.in[I_BX][ch];
        const float lam = A.in[I_LAM][ch]; sp_[n] = 8.f * (fmaxf(-lam, 0.f) + __logf(1.f + __expf(-fabsf(lam)))); At[n] = 1.f; Ut[n] = 0.f; hc[n] = 0.f; }
    if (MODE == 2) {
        if (smp) {
#pragma unroll
            for (int n = 0; n < 4; ++n) hc[n] = A.in[I_SRG][(size_t)(l * 32 + b) * 512 + ch0 + 16 * n + r];
        } else {
            for (int cc = 0; cc < c; ++cc) {
#pragma unroll
                for (int n = 0; n < 4; ++n) { const int ix = (b * 32 + cc) * 512 + ch0 + 16 * n + r; hc[n] = CA[ix] * hc[n] + CU[ix]; } }
        }
    }
    const int nm = ntok >> 4;
    for (int m = 0; m < nm; ++m) {
        unsigned short grv[4][4];
        if (MODE == 2) {
#pragma unroll
            for (int n = 0; n < 4; ++n)
#pragma unroll
                for (int i = 0; i < 4; ++i) grv[n][i] = Z[(size_t)(row0 + 16 * m + 4 * q + i) * NZ + 2048 + ch0 + 16 * n + r];
        }
        f32x4 acc[8];
#pragma unroll
        for (int k = 0; k < 8; ++k) acc[k] = (f32x4){0.f, 0.f, 0.f, 0.f};
#pragma unroll
        for (int ks = 0; ks < 2; ++ks) { const bf16x8 a = *(const LAS bf16x8*)(XCB + (16 * m + r) * 72 + ks * 32 + q * 8);
#pragma unroll
            for (int k = 0; k < 8; ++k) acc[k] = __builtin_amdgcn_mfma_f32_16x16x32_bf16(a, Bf[k][ks], acc[k], 0, 0, 0); }
#pragma unroll
        for (int n = 0; n < 4; ++n) {
            float av[4], uv[4]; float Aq = 1.f, Uq = 0.f;
#pragma unroll
            for (int i = 0; i < 4; ++i) { const float rr = sigm(acc[n][i] + ba_[n]), ii = sigm(acc[4 + n][i] + bx_[n]);
                const float a = __expf(-rr * sp_[n]); const float xcv = bf2f(XCB[(16 * m + 4 * q + i) * 72 + 16 * n + r]);
                const float u = __builtin_amdgcn_sqrtf(fmaxf(1.f - a * a, 0.f)) * ii * xcv;
                av[i] = a; uv[i] = u; Uq = a * Uq + u; Aq = a * Aq; }
            { const float A1 = __shfl_up(Aq, 16), U1 = __shfl_up(Uq, 16); if (q >= 1) { Uq = Aq * U1 + Uq; Aq = Aq * A1; } }
            { const float A2 = __shfl_up(Aq, 32), U2 = __shfl_up(Uq, 32); if (q >= 2) { Uq = Aq * U2 + Uq; Aq = Aq * A2; } }
            const float Am = __shfl(Aq, 48 + r), Um = __shfl(Uq, 48 + r);
            if (MODE == 1) { Ut[n] = Am * Ut[n] + Um; At[n] = Am * At[n]; }
            else {
                const float Aex = __shfl_up(Aq, 16), Uex = __shfl_up(Uq, 16);
                float hin = (q == 0) ? hc[n] : Aex * hc[n] + Uex;
#pragma unroll
                for (int i = 0; i < 4; ++i) { hin = av[i] * hin + uv[i]; XR[(16 * m + 4 * q + i) * 64 + 16 * n + r] = f2bf(hin * gelu_tanh(bf2f(grv[n][i]))); }
                hc[n] = Am * hc[n] + Um;
            }
        }
    }
    if (MODE == 1) { if (q == 0) {
#pragma unroll
        for (int n = 0; n < 4; ++n) { const int ix = (b * 32 + c) * 512 + ch0 + 16 * n + r; CA[ix] = At[n]; CU[ix] = Ut[n]; } } }
    else {
        LDS_WAIT(); asm volatile("" ::: "memory");
#pragma unroll
        for (int s = 0; s < 8; ++s) { const int t = s * 8 + tl; if (t < ntok) *(u32x4*)(MIX + (size_t)(row0 + t) * DM + 512 + ch0 + oct * 8) = *(const LAS u32x4*)(XR + t * 64 + oct * 8); }
        if ((smp || c == 31) && q == 0) {
#pragma unroll
            for (int n = 0; n < 4; ++n) A.out[(smp ? OUT_RG_S : OUT_RG_P) + (size_t)(l * nbt + b) * 512 + ch0 + 16 * n + r] = hc[n]; }
    }
    LDS_BAR();
}

__global__ void __launch_bounds__(NTHR) fwd_megakernel(Args A) {
    extern __shared__ __attribute__((aligned(16))) unsigned char lds_raw[];
    cg::grid_group grid = cg::this_grid();
    LAS unsigned char* L = (LAS unsigned char*)lds_raw;
    const int G = gridDim.x, blk = blockIdx.x, NGW = G * NWAVES;
#define PHASE_IDS() const int tid = opaque_tid(), lane = tid & 63, wave = __builtin_amdgcn_readfirstlane(tid >> 6), gw = blk * NWAVES + wave; (void)tid; (void)lane; (void)gw
    unsigned char* ws = A.ws;
    bf16* H = (bf16*)(ws + WS_H); bf16* GO = (bf16*)(ws + WS_GO); bf16* Zb = (bf16*)(ws + WS_Z); bf16* MIX = (bf16*)(ws + WS_MIX); bf16* HMID = (bf16*)(ws + WS_BIG);
    float* LR = (float*)(ws + WS_LR);

    {
        PHASE_IDS();
        LAS float* scr = (LAS float*)(L + wave * 16384);
        for (int it = gw; it < 2 * 5888; it += NGW) {
            const int l = it / 5888; int r = it % 5888; bf16* wl = (bf16*)(ws + WS_W + (size_t)l * LAYER_W);
            const float* win = A.in[I_WIN] + (size_t)l * DM * DIN;
            if (r < 768) { p0_transpose_item(win, DIN, 0, DM, wl + W_IN / 2, 0, scr, r / 48, r % 48, lane); }
            else if (r < 1280) { r -= 768; p0_transpose_item(win, DIN, 1552, DM, wl + W_IN / 2, 1536, scr, r / 32, r % 32, lane); }
            else if (r < 1792) { r -= 1280; p0_transpose_item(A.in[I_WOUT] + (size_t)l * DM * DM, DM, 0, DM, wl + W_OUT / 2, 0, scr, r / 32, r % 32, lane); }
            else if (r < 3840) { r -= 1792; p0_transpose_item(A.in[I_WFF1] + (size_t)l * DM * FF, FF, 0, DM, wl + W_FF1 / 2, 0, scr, r / 128, r % 128, lane); }
            else { r -= 3840; p0_transpose_item(A.in[I_WFF2] + (size_t)l * FF * DM, DM, 0, FF, wl + W_FF2 / 2, 0, scr, r / 32, r % 32, lane); }
        }
        const int gt = blk * NTHR + tid, NGT = G * NTHR;
        for (int idx = gt; idx < 2 * 16 * 1024; idx += NGT) { const int l = idx >> 14, j = (idx >> 10) & 15, k = idx & 1023;
            ((bf16*)(ws + WS_W + (size_t)l * LAYER_W + W_LR))[j * 1024 + k] = f2bf(A.in[I_WIN][(size_t)l * DM * DIN + (size_t)k * DIN + 1536 + j]); }
        for (int idx = gt; idx < 2 * 8 * 128 * 64; idx += NGT) { const int l = idx >> 16, g = (idx >> 13) & 7, n = (idx >> 6) & 127, k = idx & 63;
            const float v = n < 64 ? A.in[I_WA][((size_t)(l * 8 + g) * 64 + k) * 64 + n] : A.in[I_WX][((size_t)(l * 8 + g) * 64 + k) * 64 + n - 64];
            ((bf16*)(ws + WS_W + (size_t)l * LAYER_W + W_RG))[(g * 128 + n) * 64 + k] = f2bf(v); }
        f32x4 gz[4], gb[4];
#pragma unroll
        for (int j = 0; j < 4; ++j) gz[j] = (f32x4){0.f, 0.f, 0.f, 0.f};
        load_g(A.in[I_GPRE], lane, gb);
        for (int m = gw; m < M; m += NGW) row_op<false, true>(xrow_in(A, m), nullptr, gz, nullptr, gb, H + (size_t)m * DM, lane);
    }
    grid.sync();

#pragma unroll
    for (int l = 0; l < 2; ++l) {
        const bf16* wl = (const bf16*)(ws + WS_W + (size_t)l * LAYER_W);
        {
            pg8::Gemm g{H, wl + W_IN / 2, M, NZ, DM}; pg8::StaticOrder S; S.init(M, NZ, G, blk);
            pg8::EpiBf16<0> E{Zb, NZ};
            pg8::gemm_phase<pg8::EpiBf16<0>, pg8::StaticOrder, true, true>(L, g, S, E);
            PHASE_IDS();
            const int r = lane & 15, q = lane >> 4; const bf16* wlr = wl + W_LR / 2;
            for (int grp = gw; grp < M / 16; grp += NGW) {
                f32x4 acc = (f32x4){0.f, 0.f, 0.f, 0.f};
                const bf16* ap = H + (size_t)(grp * 16 + r) * DM + q * 8; const bf16* bp = wlr + r * DM + q * 8;
#pragma unroll 4
                for (int k0 = 0; k0 < DM; k0 += 32) { const bf16x8 av = *(const bf16x8*)(ap + k0), bv = *(const bf16x8*)(bp + k0); acc = __builtin_amdgcn_mfma_f32_16x16x32_bf16(av, bv, acc, 0, 0, 0); }
#pragma unroll
                for (int i = 0; i < 4; ++i) LR[(size_t)(grp * 16 + q * 4 + i) * 16 + r] = acc[i];
            }
        }
        grid.sync();
        for (int it = blk; it < 1408; it += G) {
            if (it < 256) rg_item<1>(L, A, l, 0, it >> 5, it & 31);
            else if (it < 1280) { const int j = it - 256; gla_item<1>(L, A, l, j >> 7, (j >> 5) & 3, j & 31); }
            else { const int j = it - 1280; gla_item<0>(L, A, l, j >> 2, j & 3, 0); }
        }
        grid.sync();
        { PHASE_IDS(); gla_scan(A, l, blk * NTHR + tid, G * NTHR); }
        for (int it = blk; it < 288; it += G) { const int smp = it >= 256 ? 1 : 0; rg_item<2>(L, A, l, smp, smp ? it - 256 : it >> 5, smp ? 0 : it & 31); }
        grid.sync();
        for (int it = blk; it < 1024; it += G) gla_item<2>(L, A, l, it >> 7, (it >> 5) & 3, it & 31);
        grid.sync();
        {
            pg8::Gemm g{MIX, wl + W_OUT / 2, M, DM, DM}; pg8::StaticOrder S; S.init(M, DM, G, blk);
            pg8::EpiBf16<0> E{GO, DM};
            pg8::gemm_phase<pg8::EpiBf16<0>, pg8::StaticOrder, true, true>(L, g, S, E);
        }
        grid.sync();
        {
            PHASE_IDS();
            f32x4 ga[4], gb[4]; load_g(A.in[I_GPOST] + l * DM, lane, ga); load_g(A.in[I_GPREFF] + l * DM, lane, gb);
            for (int m = gw; m < M; m += NGW) { const float* xs = (l == 0) ? xrow_in(A, m) : A.out + (size_t)m * DM;
                row_op<true, true>(xs, GO + (size_t)m * DM, ga, A.out + (size_t)m * DM, gb, H + (size_t)m * DM, lane); }
        }
        grid.sync();
        {
            pg8::Gemm g{H, wl + W_FF1 / 2, M, FF, DM}; pg8::StaticOrder S; S.init(M, FF, G, blk);
            pg8::EpiBf16<2> E{HMID, FF};
            pg8::gemm_phase<pg8::EpiBf16<2>, pg8::StaticOrder, true, true>(L, g, S, E);
        }
        grid.sync();
        {
            pg8::Gemm g{HMID, wl + W_FF2 / 2, M, DM, FF}; pg8::StaticOrder S; S.init(M, DM, G, blk);
            pg8::EpiBf16<0> E{GO, DM};
            pg8::gemm_phase<pg8::EpiBf16<0>, pg8::StaticOrder, true, true>(L, g, S, E);
        }
        grid.sync();
        {
            PHASE_IDS();
            f32x4 ga[4], gb[4]; load_g(A.in[I_GPOSTFF] + l * DM, lane, ga); load_g(A.in[I_GPRE] + DM, lane, gb);
            if (l == 0) { for (int m = gw; m < M; m += NGW) row_op<true, true>(A.out + (size_t)m * DM, GO + (size_t)m * DM, ga, A.out + (size_t)m * DM, gb, H + (size_t)m * DM, lane); grid.sync(); }
            else { for (int m = gw; m < M; m += NGW) row_op<true, false>(A.out + (size_t)m * DM, GO + (size_t)m * DM, ga, A.out + (size_t)m * DM, gb, nullptr, lane); }
        }
    }
}

extern "C" void kernel_launch(void* const* d_in, const int* in_sizes, int n_in, void* d_out, int out_size, void* d_ws, size_t ws_size, hipStream_t stream) {
    static int grid_blocks = 0;
    if (grid_blocks == 0) {
        if (n_in != 23 || (size_t)out_size != OUT_TOTAL || ws_size < WS_END) { fprintf(stderr, "kernel_launch: unexpected shapes n_in=%d out=%d ws=%zu\n", n_in, out_size, ws_size); grid_blocks = -1; return; }
        int dev = 0, cus = 0, per_cu = 0;
        hipGetDevice(&dev);
        hipDeviceGetAttribute(&cus, hipDeviceAttributeMultiprocessorCount, dev);
        hipFuncSetAttribute((const void*)fwd_megakernel, hipFuncAttributeMaxDynamicSharedMemorySize, LDS_BYTES);
        hipOccupancyMaxActiveBlocksPerMultiprocessor(&per_cu, (const void*)fwd_megakernel, NTHR, LDS_BYTES);
        if (per_cu < 1) { fprintf(stderr, "kernel_launch: occupancy query says %d blocks/CU\n", per_cu); per_cu = 1; }
        (void)hipGetLastError();
        grid_blocks = cus * per_cu;
    }
    if (grid_blocks < 0) return;
    Args a{};
    for (int i = 0; i < 23; ++i) a.in[i] = (const float*)d_in[i];
    a.out = (float*)d_out; a.ws = (unsigned char*)d_ws;
    void* args[] = {&a};
    hipError_t e = hipLaunchCooperativeKernel((const void*)fwd_megakernel, dim3(grid_blocks), dim3(NTHR), args, LDS_BYTES, stream);
    if (e != hipSuccess) fprintf(stderr, "cooperative launch failed: %s (grid %d)\n", hipGetErrorString(e), grid_blocks);
}
```

```cpp
#include <hip/hip_runtime.h>
#include <hip/hip_cooperative_groups.h>
#include <cstdio>
#include <cstdint>
namespace cg = cooperative_groups;
__device__ __forceinline__ int opaque_tid() { int t = threadIdx.x; asm volatile("" : "+v"(t)); return t; }
namespace pg8 {
#define PG8_LAS __attribute__((address_space(3)))
typedef unsigned short bf16_t;
typedef short bf16x8 __attribute__((ext_vector_type(8)));
typedef float f32x4 __attribute__((ext_vector_type(4)));
typedef unsigned u32x4 __attribute__((ext_vector_type(4)));
constexpr int BM = 256, BK = 64, HALF = 128, HTB = HALF * BK * 2  , STAGE_BYTES = 8 * HTB, NXCD = 8, WGM = 8;

__host__ __device__ __forceinline__ int lds_byte(int r, int c) { const int st = (r >> 4) * 2 + (c >> 5), rr = r & 15, cc = c & 31, ob = rr * 64 + cc * 2; return st * 1024 + (ob ^ (((ob >> 9) & 1) << 5)); }
__host__ __device__ __forceinline__ void stage_rc(int b, int& R, int& C) { const int st = b / 1024, sb = b % 1024, swz = sb ^ (((sb >> 9) & 1) << 5); R = (st >> 1) * 16 + swz / 64; C = (st & 1) * 32 + (swz % 64) / 2; }
__host__ __device__ __forceinline__ int perm32(int rho) { const int n = rho >> 4, i = rho & 15; return 8 * (i >> 2) + 4 * n + (i & 3); }

struct Unit { int pm, pn, k0, nt, ks; };
struct Gemm { const bf16_t* A; const bf16_t* Bt; int M, N, K; };

struct StaticOrder {
    int nM, nN, nwg, G, c, ntf;
    __host__ __device__ void init(int M, int N, int K, int G_, int c_) { nM = M / BM; nN = N / BM; nwg = nM * nN; G = G_; c = c_; ntf = K / BK; }
    __host__ __device__ void map(int wgid, Unit& u) const { { const int q = nwg / NXCD, r = nwg % NXCD, xcd = wgid % NXCD, off = wgid / NXCD; wgid = (xcd < r ? xcd * (q + 1) : r * (q + 1) + (xcd - r) * q) + off; }
        const int nig = WGM * nN, gid = wgid / nig, fm = gid * WGM, gsz = (nM - fm) < WGM ? (nM - fm) : WGM;
        u.pm = fm + ((wgid % nig) % gsz); u.pn = (wgid % nig) / gsz; u.k0 = 0; u.nt = ntf; u.ks = -1; }
    __host__ __device__ bool next(int i, Unit& u) const { const long L = (long)i * G + c; if (L >= nwg) return false; map((int)L, u); return true; }
    __device__ __forceinline__ void a_ready(const Unit&) const {}
    __device__ __forceinline__ void done(const Unit&) const {}
};
struct SplitOrder {
    StaticOrder P; int nsplit, ntsub;
    __host__ __device__ void init(int K, int G_, int c_, int nsplit_) { P.init(16384, 1024, K, G_, c_); nsplit = nsplit_; ntsub = K / BK / nsplit_; }
    __host__ __device__ bool next(int i, Unit& u) const { const long L = (long)i * P.G + P.c; if (L < 256) { P.map((int)L, u); return true; }
        const int s = (int)(L - 256); if (s >= 16 * nsplit) return false; const int su = s / nsplit, ks = s % nsplit; u.pm = 64 + (su >> 2); u.pn = su & 3; u.k0 = ks * ntsub * BK; u.nt = ntsub; u.ks = ks; return true; }
    __device__ __forceinline__ void a_ready(const Unit&) const {}
    __device__ __forceinline__ void done(const Unit&) const {}
};


__device__ __forceinline__ unsigned cvt_pk_bf16(float lo, float hi) { unsigned r; asm volatile("v_cvt_pk_bf16_f32 %0, %1, %2" : "=v"(r) : "v"(lo), "v"(hi)); return r; }
template <int ACT> struct EpiBf16 {
    static constexpr bool PERM = true, AFTER_DRAIN = false;
    bf16_t* O; int ldc; float* part;
    __device__ __forceinline__ void operator()(const f32x4 (&acc)[2][2][4][2], const Unit& u, int wr, int wc, int fr, int fq) const {
        const int row0 = u.pm * BM + wr * 64 + fr; const int col0 = u.pn * BM + wc * 32 + 8 * fq;
        if (u.ks >= 0) {
#pragma unroll
            for (int ai = 0; ai < 2; ++ai)
#pragma unroll
                for (int m = 0; m < 4; ++m) { float* rowp = part + ((size_t)u.ks << 20) + (size_t)(row0 - 16384 + ai * HALF + m * 16) * 1024 + col0;
#pragma unroll
                    for (int bj = 0; bj < 2; ++bj) { *(f32x4*)(rowp + bj * HALF) = acc[ai][bj][m][0]; *(f32x4*)(rowp + bj * HALF + 4) = acc[ai][bj][m][1]; } }
            return;
        }
#pragma unroll
        for (int ai = 0; ai < 2; ++ai)
#pragma unroll
            for (int m = 0; m < 4; ++m) { bf16_t* rowp = O + (size_t)(row0 + ai * HALF + m * 16) * ldc + col0;
#pragma unroll
                for (int bj = 0; bj < 2; ++bj) { f32x4 v0 = acc[ai][bj][m][0], v1 = acc[ai][bj][m][1];
                    if (ACT == 2) {
#pragma unroll
                        for (int e = 0; e < 4; ++e) { float a = fmaxf(v0[e], 0.f), b = fmaxf(v1[e], 0.f); v0[e] = a * a; v1[e] = b * b; }
                    }
                    u32x4 w; w.x = cvt_pk_bf16(v0[0], v0[1]); w.y = cvt_pk_bf16(v0[2], v0[3]); w.z = cvt_pk_bf16(v1[0], v1[1]); w.w = cvt_pk_bf16(v1[2], v1[3]);
                    *(u32x4*)(rowp + bj * HALF) = w; } }
    }
};

template <class Epi, class Sched, bool ALIGN_EPI = false, bool SP2 = false>
__device__ __forceinline__ void gemm_phase(PG8_LAS unsigned char* lds, const Gemm g, const Sched& S, const Epi& E) {
    const int tid = opaque_tid(), wid = __builtin_amdgcn_readfirstlane(tid >> 6), lane = tid & 63, wr = wid >> 2, wc = wid & 3, fr = lane & 15, fq = lane >> 4;
    const int K = g.K;
    unsigned voffA[2], voffB[2];
#pragma unroll
    for (int i = 0; i < 2; ++i) { int R, C; stage_rc(tid * 16 + i * 8192, R, C); const int Rb = Epi::PERM ? ((R & ~31) + perm32(R & 31)) : R;
        voffA[i] = (unsigned)(R * K + C) * 2u; voffB[i] = (unsigned)(Rb * K + C) * 2u; }
    const size_t kstep = (size_t)(BK * 2);
    const size_t hstep = (size_t)HALF * K * 2;
    const size_t tstep = 2 * hstep;
    const unsigned ldsw = (unsigned)wid * 1024u;
    const int aoff = lds_byte(wr * 64 + fr, fq * 8), boff = lds_byte(wc * 32 + fr, fq * 8);
#define PG8_SA(b, h) (((b) * 2 + (h)) * HTB)
#define PG8_SB(b, h) ((4 + (b) * 2 + (h)) * HTB)
#define PG8_STAGE(bufoff, gbase, voff) do { _Pragma("unroll") for (int _i = 0; _i < 2; ++_i) \
        __builtin_amdgcn_global_load_lds((const unsigned*)((const char*)(gbase) + (voff)[_i]), (PG8_LAS unsigned*)(lds + (bufoff) + ldsw + _i * 8192), 16, 0, 0); } while (0)
#define PG8_LDA(dst, b, h) do { _Pragma("unroll") for (int m = 0; m < 4; ++m) _Pragma("unroll") for (int k = 0; k < 2; ++k) dst[m][k] = *(const PG8_LAS bf16x8*)(lds + PG8_SA(b, h) + aoff + m * 2048 + k * 1024); } while (0)
#define PG8_LDB(dst, b, h) do { _Pragma("unroll") for (int n = 0; n < 2; ++n) _Pragma("unroll") for (int k = 0; k < 2; ++k) dst[n][k] = *(const PG8_LAS bf16x8*)(lds + PG8_SB(b, h) + boff + n * 2048 + k * 1024); } while (0)
#define PG8_MMA(ai, bj, At, Bt) do { __builtin_amdgcn_s_setprio(1); _Pragma("unroll") for (int m = 0; m < 4; ++m) _Pragma("unroll") for (int n = 0; n < 2; ++n) _Pragma("unroll") for (int k = 0; k < 2; ++k) \
        acc[ai][bj][m][n] = __builtin_amdgcn_mfma_f32_16x16x32_bf16(Bt[n][k], At[m][k], acc[ai][bj][m][n], 0, 0, 0); __builtin_amdgcn_s_setprio(0); } while (0)
#define PG8_WAIT_V(n) asm volatile("s_waitcnt vmcnt(" #n ")" ::: "memory")
#define PG8_WAIT_L(n) asm volatile("s_waitcnt lgkmcnt(" #n ")" ::: "memory")
#define PG8_BAR __builtin_amdgcn_s_barrier()
#define PG8_SCHED __builtin_amdgcn_sched_barrier(0)
    Unit cur, nxt; int ui = 0;
    if (!S.next(0, cur)) return;
    f32x4 acc[2][2][4][2];
#pragma unroll
    for (int a = 0; a < 2; ++a)
#pragma unroll
        for (int b = 0; b < 2; ++b)
#pragma unroll
            for (int m = 0; m < 4; ++m)
#pragma unroll
                for (int n = 0; n < 2; ++n) acc[a][b][m][n] = (f32x4){0.f, 0.f, 0.f, 0.f};
    bf16x8 At[4][2], B0[2][2], B1[2][2];
    const char* cA = (const char*)g.A + (size_t)cur.pm * tstep + (size_t)cur.k0 * 2; const char* cB = (const char*)g.Bt + (size_t)cur.pn * tstep + (size_t)cur.k0 * 2;
    S.a_ready(cur);
    if constexpr (SP2) {
        PG8_STAGE(PG8_SB(0, 0), cB, voffB); PG8_STAGE(PG8_SB(0, 1), cB + hstep, voffB); PG8_STAGE(PG8_SA(0, 0), cA, voffA); PG8_STAGE(PG8_SA(0, 1), cA + hstep, voffA);
        if (wr == 1) PG8_BAR;
        PG8_WAIT_V(2); PG8_BAR;
        PG8_STAGE(PG8_SB(1, 0), cB + kstep, voffB); PG8_STAGE(PG8_SA(1, 0), cA + kstep, voffA); PG8_STAGE(PG8_SB(1, 1), cB + hstep + kstep, voffB);
        PG8_WAIT_V(6); PG8_BAR;
    } else {
        PG8_STAGE(PG8_SB(0, 0), cB, voffB); PG8_STAGE(PG8_SA(0, 0), cA, voffA); PG8_STAGE(PG8_SB(0, 1), cB + hstep, voffB); PG8_STAGE(PG8_SA(0, 1), cA + hstep, voffA);
        if (wr == 1) PG8_BAR;
        PG8_WAIT_V(4); PG8_BAR;
        PG8_STAGE(PG8_SB(1, 0), cB + kstep, voffB); PG8_STAGE(PG8_SA(1, 0), cA + kstep, voffA); PG8_STAGE(PG8_SB(1, 1), cB + hstep + kstep, voffB);
        PG8_WAIT_V(6); PG8_BAR;
    }
    for (;;) {
        const bool has_next = S.next(ui + 1, nxt);
        const char* nA = has_next ? (const char*)g.A + (size_t)nxt.pm * tstep + (size_t)nxt.k0 * 2 : cA; const char* nB = has_next ? (const char*)g.Bt + (size_t)nxt.pn * tstep + (size_t)nxt.k0 * 2 : cB;
        const int nt = cur.nt;
        for (int t = 0; t < nt; t += 2) {
            const bool last = (t == nt - 2);
            const char* a1 = cA + (size_t)(t + 1) * kstep;
            const char* a2 = last ? nA : cA + (size_t)(t + 2) * kstep; const char* b2 = last ? nB : cB + (size_t)(t + 2) * kstep;
            const char* a3 = a2 + kstep; const char* b3 = b2 + kstep;
            if (last && has_next) S.a_ready(nxt);
            if constexpr (SP2) {
            PG8_LDB(B0, 0, 0); PG8_LDB(B1, 0, 1); PG8_SCHED; PG8_LDA(At, 0, 0); PG8_STAGE(PG8_SA(1, 1), a1 + hstep, voffA);
            PG8_WAIT_V(8); PG8_WAIT_L(0); PG8_BAR; PG8_MMA(0, 0, At, B0); PG8_MMA(0, 1, At, B1); PG8_BAR; PG8_SCHED;
            PG8_LDA(At, 0, 1); PG8_STAGE(PG8_SB(0, 0), b2, voffB); PG8_STAGE(PG8_SB(0, 1), b2 + hstep, voffB); PG8_STAGE(PG8_SA(0, 0), a2, voffA);
            PG8_WAIT_V(8); PG8_WAIT_L(0); PG8_BAR; PG8_MMA(1, 0, At, B0); PG8_MMA(1, 1, At, B1); PG8_BAR; PG8_SCHED;
            PG8_LDB(B0, 1, 0); PG8_LDB(B1, 1, 1); PG8_SCHED; PG8_LDA(At, 1, 0); PG8_STAGE(PG8_SA(0, 1), a2 + hstep, voffA);
            PG8_WAIT_V(8); PG8_WAIT_L(0); PG8_BAR; PG8_MMA(0, 0, At, B0); PG8_MMA(0, 1, At, B1); PG8_BAR; PG8_SCHED;
            PG8_LDA(At, 1, 1); PG8_STAGE(PG8_SB(1, 0), b3, voffB); PG8_STAGE(PG8_SB(1, 1), b3 + hstep, voffB); PG8_STAGE(PG8_SA(1, 0), a3, voffA);
            PG8_WAIT_V(8); PG8_WAIT_L(0); PG8_BAR; PG8_MMA(1, 0, At, B0); PG8_MMA(1, 1, At, B1); PG8_BAR; PG8_SCHED;
            } else {
            PG8_LDB(B0, 0, 0); PG8_SCHED; PG8_LDA(At, 0, 0); PG8_STAGE(PG8_SA(1, 1), a1 + hstep, voffA);
            PG8_WAIT_L(8); PG8_BAR; PG8_WAIT_L(0); PG8_MMA(0, 0, At, B0); PG8_BAR; PG8_SCHED;
            PG8_LDB(B1, 0, 1); PG8_STAGE(PG8_SB(0, 0), b2, voffB);
            PG8_BAR; PG8_WAIT_L(0); PG8_MMA(0, 1, At, B1); PG8_BAR;
            PG8_LDA(At, 0, 1); PG8_STAGE(PG8_SA(0, 0), a2, voffA);
            PG8_BAR; PG8_WAIT_L(0); PG8_MMA(1, 0, At, B0); PG8_BAR; PG8_SCHED;
            PG8_STAGE(PG8_SB(0, 1), b2 + hstep, voffB);
            PG8_WAIT_V(6); PG8_BAR; PG8_MMA(1, 1, At, B1); PG8_BAR;
            PG8_LDB(B0, 1, 0); PG8_SCHED; PG8_LDA(At, 1, 0); PG8_STAGE(PG8_SA(0, 1), a2 + hstep, voffA);
            PG8_WAIT_L(8); PG8_BAR; PG8_WAIT_L(0); PG8_MMA(0, 0, At, B0); PG8_BAR; PG8_SCHED;
            PG8_LDB(B1, 1, 1); PG8_STAGE(PG8_SB(1, 0), b3, voffB);
            PG8_BAR; PG8_WAIT_L(0); PG8_MMA(0, 1, At, B1); PG8_BAR;
            PG8_LDA(At, 1, 1); PG8_STAGE(PG8_SA(1, 0), a3, voffA);
            PG8_BAR; PG8_WAIT_L(0); PG8_MMA(1, 0, At, B0); PG8_BAR; PG8_SCHED;
            PG8_STAGE(PG8_SB(1, 1), b3 + hstep, voffB);
            PG8_WAIT_V(6); PG8_BAR; PG8_MMA(1, 1, At, B1); PG8_BAR;
            }
        }
        if constexpr (ALIGN_EPI) { if (wr == 0) PG8_BAR; }
        if constexpr (!Epi::AFTER_DRAIN) { E(acc, cur, wr, wc, fr, fq); S.done(cur); }
        if (!has_next) break;
#pragma unroll
        for (int a = 0; a < 2; ++a)
#pragma unroll
            for (int b = 0; b < 2; ++b)
#pragma unroll
                for (int m = 0; m < 4; ++m)
#pragma unroll
                    for (int n = 0; n < 2; ++n) acc[a][b][m][n] = (f32x4){0.f, 0.f, 0.f, 0.f};
        cur = nxt; cA = nA; cB = nB; ++ui;
        if constexpr (ALIGN_EPI) { if (wr == 1) PG8_BAR; }
    }
    PG8_WAIT_V(0);
    if constexpr (!ALIGN_EPI) { if (wr == 0) PG8_BAR; }
    PG8_BAR;
    if constexpr (Epi::AFTER_DRAIN) { E.fused(acc, cur, wr, wc, fr, fq, lds, wid, lane); S.done(cur); }
#undef PG8_SA
#undef PG8_SB
#undef PG8_STAGE
#undef PG8_LDA
#undef PG8_LDB
#undef PG8_MMA
#undef PG8_WAIT_V
#undef PG8_WAIT_L
#undef PG8_BAR
#undef PG8_SCHED
}
}

#define LAS __attribute__((address_space(3)))
typedef unsigned short bf16;
typedef float f32x4 __attribute__((ext_vector_type(4)));
typedef float f32x2 __attribute__((ext_vector_type(2)));
typedef short bf16x8 __attribute__((ext_vector_type(8)));
typedef unsigned u32x4 __attribute__((ext_vector_type(4)));
typedef unsigned u32x2 __attribute__((ext_vector_type(2)));

constexpr int NWAVES = 8, NTHR = 512;
constexpr int DM = 1024, MP = 16384, MS = 1024, M = MP + MS, DIN = 2576, NZ = 2560, FF = 4096;
constexpr float EPS = 1e-6f;
constexpr size_t MiB = 1u << 20;
constexpr size_t W_IN = 0, W_OUT = W_IN + (size_t)NZ * DM * 2, W_FF1 = W_OUT + (size_t)DM * DM * 2, W_FF2 = W_FF1 + (size_t)FF * DM * 2,
                 W_LR = W_FF2 + (size_t)FF * DM * 2, W_RG = W_LR + 16 * DM * 2, LAYER_W = W_RG + 8 * 128 * 64 * 2;
constexpr size_t WS_W = 1 * MiB, WS_H = 49 * MiB, WS_GO = 83 * MiB, WS_BIG = 117 * MiB, WS_Z = WS_BIG, WS_MIX = WS_BIG + 85 * MiB, WS_DS = WS_BIG + 119 * MiB, WS_DEC = WS_BIG + 135 * MiB, WS_LR = 253 * MiB, WS_CA = 254 * MiB + 256 * 1024, WS_END = 256 * MiB;
static_assert(WS_W + 2 * LAYER_W <= WS_H, "weights fit");
static_assert((size_t)M * DM * 2 == 34 * MiB && (size_t)M * NZ * 2 == 85 * MiB && (size_t)M * FF * 2 == 136 * MiB, "sizes");
constexpr size_t OUT_GLA_P = 17825792, OUT_RG_P = 18350080, OUT_CV_P = 18358272, OUT_GLA_S = 18382848, OUT_RG_S = 20480000, OUT_CV_S = 20512768, OUT_TOTAL = 20611072;
constexpr int LDS_BYTES = 147456;

struct Args { const float* in[23]; float* out; unsigned char* ws; };
enum { I_XP = 0, I_XS, I_SGLA, I_SRG, I_SCV, I_GPRE, I_WIN, I_WLR2, I_BLR, I_GNORM, I_CW, I_CB, I_WA, I_BA, I_WX, I_BX, I_LAM, I_WOUT, I_GPOST, I_GPREFF, I_WFF1, I_WFF2, I_GPOSTFF };

#define LDS_BAR() do { asm volatile("s_waitcnt lgkmcnt(0)" ::: "memory"); __builtin_amdgcn_s_barrier(); asm volatile("" ::: "memory"); } while (0)
#define LDS_WAIT() asm volatile("s_waitcnt lgkmcnt(0)" ::: "memory")

__device__ __forceinline__ unsigned pk2(float lo, float hi) { return pg8::cvt_pk_bf16(lo, hi); }
__device__ __forceinline__ unsigned short f2bf(float f) { return (unsigned short)(pk2(f, 0.f) & 0xffffu); }
__device__ __forceinline__ float bf2f(unsigned short u) { return __uint_as_float(((unsigned)u) << 16); }
__device__ __forceinline__ float blo(unsigned w) { return __uint_as_float(w << 16); }
__device__ __forceinline__ float bhi(unsigned w) { return __uint_as_float(w & 0xffff0000u); }
__device__ __forceinline__ void unpack8(u32x4 v, float (&f)[8]) { f[0] = blo(v.x); f[1] = bhi(v.x); f[2] = blo(v.y); f[3] = bhi(v.y); f[4] = blo(v.z); f[5] = bhi(v.z); f[6] = blo(v.w); f[7] = bhi(v.w); }
__device__ __forceinline__ u32x4 pack8(const float (&f)[8]) { u32x4 o; o.x = pk2(f[0], f[1]); o.y = pk2(f[2], f[3]); o.z = pk2(f[4], f[5]); o.w = pk2(f[6], f[7]); return o; }
__device__ __forceinline__ float wave_sum(float v) {
#pragma unroll
    for (int o = 1; o < 64; o <<= 1) v += __shfl_xor(v, o);
    return v;
}
__device__ __forceinline__ float sigm(float x) { return __builtin_amdgcn_rcpf(1.f + __expf(-x)); }
__device__ __forceinline__ float gelu_tanh(float x) { const float u = 0.7978845608028654f * (x + 0.044715f * x * x * x); const float e = __expf(-2.f * fabsf(u)); float th = (1.f - e) * __builtin_amdgcn_rcpf(1.f + e); th = u < 0.f ? -th : th; return 0.5f * x * (1.f + th); }
__device__ __forceinline__ const float* xrow_in(const Args& A, int m) { return m < MP ? A.in[I_XP] + (size_t)m * DM : A.in[I_XS] + (size_t)(m - MP) * DM; }

__device__ __forceinline__ void p0_transpose_item(const float* W, int ldw, int col0, int K, bf16* WT, int row_off, LAS float* scr, int kb, int nb, int lane) {
    const int k0 = 64 * kb, n0 = 32 * nb;
#pragma unroll 8
    for (int i = 0; i < 32; ++i) { const int kk = 2 * i + (lane >> 5); scr[kk * 33 + (lane & 31)] = W[(size_t)(k0 + kk) * ldw + col0 + n0 + (lane & 31)]; }
    LDS_WAIT(); asm volatile("" ::: "memory");
    const int c = lane & 7;
#pragma unroll
    for (int j = 0; j < 4; ++j) { const int n = (lane >> 3) + 8 * j; const LAS float* s = scr + (8 * c) * 33 + n;
        u32x4 o; o.x = pk2(s[0 * 33], s[1 * 33]); o.y = pk2(s[2 * 33], s[3 * 33]); o.z = pk2(s[4 * 33], s[5 * 33]); o.w = pk2(s[6 * 33], s[7 * 33]);
        *(u32x4*)(WT + (size_t)(row_off + n0 + n) * K + k0 + 8 * c) = o; }
    LDS_WAIT(); asm volatile("" ::: "memory");
}

template <bool HAS_GO, bool HAS_H>
__device__ __forceinline__ void row_op(const float* xs, const bf16* go, const float* part, const f32x4 (&ga)[4], float* xo, const f32x4 (&gb)[4], bf16* hb, int lane) {
    f32x4 x[4];
#pragma unroll
    for (int j = 0; j < 4; ++j) x[j] = *(const f32x4*)(xs + 4 * lane + 256 * j);
    if (HAS_GO) {
        f32x4 f[4]; float ss = 0.f;
#pragma unroll
        for (int j = 0; j < 4; ++j) {
            if (part) { f[j] = *(const f32x4*)(part + 4 * lane + 256 * j);
#pragma unroll
                for (int ks = 1; ks < 8; ++ks) f[j] = f[j] + *(const f32x4*)(part + ((size_t)ks << 20) + 4 * lane + 256 * j); }
            else { const u32x2 wv = *(const u32x2*)(go + 4 * lane + 256 * j); f[j] = (f32x4){blo(wv.x), bhi(wv.x), blo(wv.y), bhi(wv.y)}; }
            ss += (f[j].x * f[j].x + f[j].y * f[j].y) + (f[j].z * f[j].z + f[j].w * f[j].w); }
        const float rstd = rsqrtf(wave_sum(ss) * (1.f / DM) + EPS);
#pragma unroll
        for (int j = 0; j < 4; ++j) { x[j] = x[j] + f[j] * rstd * ga[j]; *(f32x4*)(xo + 4 * lane + 256 * j) = x[j]; }
    }
    if (HAS_H) {
        float s2 = 0.f;
#pragma unroll
        for (int j = 0; j < 4; ++j) s2 += (x[j].x * x[j].x + x[j].y * x[j].y) + (x[j].z * x[j].z + x[j].w * x[j].w);
        const float r2 = rsqrtf(wave_sum(s2) * (1.f / DM) + EPS);
#pragma unroll
        for (int j = 0; j < 4; ++j) { const f32x4 hv = x[j] * r2 * gb[j]; u32x2 o; o.x = pk2(hv.x, hv.y); o.y = pk2(hv.z, hv.w); *(u32x2*)(hb + 4 * lane + 256 * j) = o; }
    }
}
__device__ __forceinline__ void load_g(const float* g, int lane, f32x4 (&v)[4]) {
#pragma unroll
    for (int j = 0; j < 4; ++j) v[j] = *(const f32x4*)(g + 4 * lane + 256 * j);
}

template <int MODE>
__device__ __forceinline__ void gla_item(LAS unsigned char* L, const Args& A, int l, int b, int h, int c) {
    const int tid = opaque_tid(), w = __builtin_amdgcn_readfirstlane(tid >> 6), lane = tid & 63, r = lane & 15, q = lane >> 4;
    const int t = tid >> 3, oct = tid & 7, o8 = oct * 8, tsw = t ^ (oct << 3);
    LAS bf16* QT = (LAS bf16*)(L + 0); LAS bf16* KT = (LAS bf16*)(L + 9216); LAS bf16* KHT = (LAS bf16*)(L + 18432); LAS bf16* ATT = (LAS bf16*)(L + 27648);
    LAS bf16* VT = (LAS bf16*)(L + 36864); LAS bf16* ST = (LAS bf16*)(L + 55296); LAS bf16* GS = (LAS bf16*)(L + 73728);
    LAS float* LRS = (LAS float*)(L + 91136); LAS float* WL = (LAS float*)(L + 95232); LAS float* SEG = (LAS float*)(L + 99328);
    LAS float* SSQ = (LAS float*)(L + 101376); LAS float* BL = (LAS float*)(L + 101888);
    constexpr bool SMP = (MODE == 0), DO_OUT = (MODE != 1), DO_S = (MODE != 2);
    const int ntok = SMP ? 32 : 64, row0 = SMP ? MP + b * 32 : b * 2048 + c * 64;
    const int item = (b * 4 + h) * 32 + c;
    const bf16* Z = (const bf16*)(A.ws + WS_Z); bf16* MIX = (bf16*)(A.ws + WS_MIX); const float* LR = (const float*)(A.ws + WS_LR);
    bf16* DS = (bf16*)(A.ws + WS_DS) + (size_t)item * 8192; float* DEC = (float*)(A.ws + WS_DEC) + (size_t)item * 64;
    const bool valid = t < ntok;
    const u32x4 z4 = (u32x4){0u, 0u, 0u, 0u};
    const bf16* zr = Z + (size_t)(row0 + t) * NZ;
    u32x4 rq = z4, rk, rv0, rv1, rg0 = z4, rg1 = z4; f32x2 rl;
    rk = valid ? *(const u32x4*)(zr + 256 + h * 64 + o8) : z4;
    rv0 = valid ? *(const u32x4*)(zr + 512 + h * 128 + o8) : z4; rv1 = valid ? *(const u32x4*)(zr + 512 + h * 128 + 64 + o8) : z4;
    rl = valid ? *(const f32x2*)(LR + (size_t)(row0 + t) * 16 + oct * 2) : (f32x2){0.f, 0.f};
    if (DO_OUT) { rq = valid ? *(const u32x4*)(zr + h * 64 + o8) : z4; rg0 = valid ? *(const u32x4*)(zr + 1024 + h * 128 + o8) : z4; rg1 = valid ? *(const u32x4*)(zr + 1024 + h * 128 + 64 + o8) : z4; }
    f32x4 S[4];
#pragma unroll
    for (int n = 0; n < 4; ++n) S[n] = (f32x4){0.f, 0.f, 0.f, 0.f};
    if (MODE == 0) { const float* s0 = A.in[I_SGLA] + ((size_t)(l * 32 + b) * 4 + h) * 8192;
#pragma unroll
        for (int n = 0; n < 4; ++n) S[n] = *(const f32x4*)(s0 + (16 * n + r) * 128 + 16 * w + q * 4);
#pragma unroll
        for (int n = 0; n < 4; ++n)
#pragma unroll
            for (int i = 0; i < 4; ++i) ST[(16 * w + q * 4 + i) * 72 + 16 * n + r] = f2bf(S[n][i]);
    }
    if (MODE == 2) {
#pragma unroll
        for (int k = 0; k < 2; ++k) { const int idx = tid + 512 * k, row = idx >> 3, c8 = (idx & 7) * 8; *(LAS u32x4*)(ST + row * 72 + c8) = *(const u32x4*)(DS + row * 64 + c8); }
    }
    { const int idx = tid * 2, j = idx >> 6, d = idx & 63; const float* src = A.in[I_WLR2] + (size_t)(l * 16 + j) * 256 + h * 64 + d; WL[j * 64 + d] = src[0]; WL[j * 64 + d + 1] = src[1]; }
    float blr[8];
#pragma unroll
    for (int dd = 0; dd < 8; ++dd) blr[dd] = A.in[I_BLR][l * 256 + h * 64 + o8 + dd];
    const int mi = w >> 1;
    LRS[t * 16 + oct * 2] = rl.x; LRS[t * 16 + oct * 2 + 1] = rl.y;
    LDS_BAR();
    float la[8];
    {
        float lrv[16];
#pragma unroll
        for (int j4 = 0; j4 < 4; ++j4) { const f32x4 v = *(const LAS f32x4*)(LRS + t * 16 + j4 * 4); lrv[j4 * 4] = v.x; lrv[j4 * 4 + 1] = v.y; lrv[j4 * 4 + 2] = v.z; lrv[j4 * 4 + 3] = v.w; }
#pragma unroll
        for (int dd = 0; dd < 8; ++dd) la[dd] = blr[dd];
#pragma unroll
        for (int j = 0; j < 16; ++j) { const f32x4 w0 = *(const LAS f32x4*)(WL + j * 64 + o8), w1 = *(const LAS f32x4*)(WL + j * 64 + o8 + 4);
            la[0] += lrv[j] * w0.x; la[1] += lrv[j] * w0.y; la[2] += lrv[j] * w0.z; la[3] += lrv[j] * w0.w;
            la[4] += lrv[j] * w1.x; la[5] += lrv[j] * w1.y; la[6] += lrv[j] * w1.z; la[7] += lrv[j] * w1.w; }
#pragma unroll
        for (int dd = 0; dd < 8; ++dd) { const float x = la[dd]; const float ls = fminf(x, 0.f) - __logf(1.f + __expf(-fabsf(x))); la[dd] = valid ? ls * (1.f / 16.f) : 0.f; }
#pragma unroll
        for (int dd = 0; dd < 8; ++dd) { float v = la[dd]; float u = __shfl_up(v, 8); if (lane >= 8) v += u; u = __shfl_up(v, 16); if (lane >= 16) v += u; u = __shfl_up(v, 32); if (lane >= 32) v += u; la[dd] = v; }
        if ((lane >> 3) == 7) { *(LAS f32x4*)(SEG + w * 64 + o8) = (f32x4){la[0], la[1], la[2], la[3]}; *(LAS f32x4*)(SEG + w * 64 + o8 + 4) = (f32x4){la[4], la[5], la[6], la[7]}; }
    }
    LDS_BAR();
    float bl[8];
    {
        float pre[8];
#pragma unroll
        for (int dd = 0; dd < 8; ++dd) { pre[dd] = 0.f; bl[dd] = 0.f; }
#pragma unroll
        for (int ww = 0; ww < 8; ++ww) { const f32x4 s0 = *(const LAS f32x4*)(SEG + ww * 64 + o8), s1 = *(const LAS f32x4*)(SEG + ww * 64 + o8 + 4);
            const float m = ww < w ? 1.f : 0.f;
            pre[0] += m * s0.x; pre[1] += m * s0.y; pre[2] += m * s0.z; pre[3] += m * s0.w; pre[4] += m * s1.x; pre[5] += m * s1.y; pre[6] += m * s1.z; pre[7] += m * s1.w;
            bl[0] += s0.x; bl[1] += s0.y; bl[2] += s0.z; bl[3] += s0.w; bl[4] += s1.x; bl[5] += s1.y; bl[6] += s1.z; bl[7] += s1.w; }
#pragma unroll
        for (int dd = 0; dd < 8; ++dd) la[dd] += pre[dd];
    }
    {
        float kf[8]; unpack8(rk, kf);
        if (DO_OUT) { float qf[8], qt[8], kt[8]; unpack8(rq, qf);
#pragma unroll
            for (int dd = 0; dd < 8; ++dd) { qt[dd] = qf[dd] * 0.125f * __expf(la[dd]); kt[dd] = kf[dd] * __expf(-la[dd]); }
            *(LAS u32x4*)(QT + t * 72 + o8) = pack8(qt); *(LAS u32x4*)(KT + t * 72 + o8) = pack8(kt);
            *(LAS u32x4*)(GS + t * 136 + o8) = rg0; *(LAS u32x4*)(GS + t * 136 + 64 + o8) = rg1; }
        if (DO_S) {
#pragma unroll
            for (int dd = 0; dd < 8; ++dd) KHT[(o8 + dd) * 72 + tsw] = f2bf(kf[dd] * __expf(bl[dd] - la[dd]));
            if (t == 0) {
#pragma unroll
                for (int dd = 0; dd < 8; ++dd) BL[o8 + dd] = __expf(bl[dd]);
            } }
        const unsigned vw[8] = {rv0.x, rv0.y, rv0.z, rv0.w, rv1.x, rv1.y, rv1.z, rv1.w};
#pragma unroll
        for (int e2 = 0; e2 < 8; ++e2) { const int e = (e2 < 4 ? 0 : 64) + o8 + (e2 & 3) * 2; VT[e * 72 + tsw] = (bf16)(vw[e2] & 0xffffu); VT[(e + 1) * 72 + tsw] = (bf16)(vw[e2] >> 16); }
    }
    LDS_BAR();
    const int swr = (r >> 3);
    f32x4 O[4];
    if (DO_OUT) {
#pragma unroll
        for (int jj = 0; jj < 2; ++jj) { const int nj = 2 * (w & 1) + jj; f32x4 acc = (f32x4){0.f, 0.f, 0.f, 0.f};
#pragma unroll
            for (int ks = 0; ks < 2; ++ks) { const bf16x8 a = *(const LAS bf16x8*)(QT + (16 * mi + r) * 72 + ks * 32 + q * 8), bb = *(const LAS bf16x8*)(KT + (16 * nj + r) * 72 + ks * 32 + q * 8);
                acc = __builtin_amdgcn_mfma_f32_16x16x32_bf16(a, bb, acc, 0, 0, 0); }
#pragma unroll
            for (int i = 0; i < 4; ++i) { const int row = 16 * mi + q * 4 + i, col = 16 * nj + r; ATT[row * 72 + col] = f2bf(col <= row ? acc[i] : 0.f); } }
        LDS_BAR();
#pragma unroll
        for (int n = 0; n < 4; ++n) O[n] = (f32x4){0.f, 0.f, 0.f, 0.f};
#pragma unroll
        for (int ks = 0; ks < 2; ++ks) { const bf16x8 a = *(const LAS bf16x8*)(QT + (16 * mi + r) * 72 + ks * 32 + q * 8);
#pragma unroll
            for (int n = 0; n < 4; ++n) { const bf16x8 bb = *(const LAS bf16x8*)(ST + (16 * (4 * (w & 1) + n) + r) * 72 + ks * 32 + q * 8); O[n] = __builtin_amdgcn_mfma_f32_16x16x32_bf16(a, bb, O[n], 0, 0, 0); } }
#pragma unroll
        for (int ks = 0; ks < 2; ++ks) { const bf16x8 a = *(const LAS bf16x8*)(ATT + (16 * mi + r) * 72 + ks * 32 + q * 8);
#pragma unroll
            for (int n = 0; n < 4; ++n) { const int sw = ((2 * n + swr) & 7) << 3; const bf16x8 bb = *(const LAS bf16x8*)(VT + (16 * (4 * (w & 1) + n) + r) * 72 + ((ks * 32 + q * 8) ^ sw)); O[n] = __builtin_amdgcn_mfma_f32_16x16x32_bf16(a, bb, O[n], 0, 0, 0); } }
    }
    if (DO_S) {
#pragma unroll
        for (int n = 0; n < 4; ++n) { const float dec = BL[16 * n + r]; S[n] = S[n] * dec; }
#pragma unroll
        for (int ks = 0; ks < 2; ++ks) { const int swa = ((2 * w + swr) & 7) << 3; const bf16x8 a = *(const LAS bf16x8*)(VT + (16 * w + r) * 72 + ((ks * 32 + q * 8) ^ swa));
#pragma unroll
            for (int n = 0; n < 4; ++n) { const int sw = ((2 * n + swr) & 7) << 3; const bf16x8 bb = *(const LAS bf16x8*)(KHT + (16 * n + r) * 72 + ((ks * 32 + q * 8) ^ sw)); S[n] = __builtin_amdgcn_mfma_f32_16x16x32_bf16(a, bb, S[n], 0, 0, 0); } }
    }
    if (DO_OUT) {
#pragma unroll
        for (int i = 0; i < 4; ++i) { float s = 0.f;
#pragma unroll
            for (int n = 0; n < 4; ++n) s += O[n][i] * O[n][i];
            s += __shfl_xor(s, 1); s += __shfl_xor(s, 2); s += __shfl_xor(s, 4); s += __shfl_xor(s, 8);
            if (r == 0) SSQ[(16 * mi + q * 4 + i) * 2 + (w & 1)] = s; }
    }
    LDS_BAR();
    if (MODE == 1) {
#pragma unroll
        for (int n = 0; n < 4; ++n)
#pragma unroll
            for (int i = 0; i < 4; ++i) ST[(16 * w + q * 4 + i) * 72 + 16 * n + r] = f2bf(S[n][i]);
        if (tid < 64) DEC[tid] = BL[tid];
    }
    if (DO_OUT) {
        float gn[4];
#pragma unroll
        for (int n = 0; n < 4; ++n) gn[n] = A.in[I_GNORM][l * 128 + 16 * (4 * (w & 1) + n) + r];
#pragma unroll
        for (int i = 0; i < 4; ++i) { const int row = 16 * mi + q * 4 + i; const float rstd = __builtin_amdgcn_rsqf((SSQ[row * 2] + SSQ[row * 2 + 1]) * (1.f / 128.f) + EPS);
#pragma unroll
            for (int n = 0; n < 4; ++n) { const int e = 16 * (4 * (w & 1) + n) + r; const float gv = bf2f(GS[row * 136 + e]); GS[row * 136 + e] = f2bf(O[n][i] * rstd * gn[n] * gv * sigm(gv)); } }
    }
    LDS_BAR();
    if (DO_OUT) { if (valid) { bf16* mr = MIX + (size_t)(row0 + t) * DM + h * 128 + o8;
        *(u32x4*)(mr) = *(const LAS u32x4*)(GS + t * 136 + o8); *(u32x4*)(mr + 64) = *(const LAS u32x4*)(GS + t * 136 + 64 + o8); } }
    if (MODE == 1) {
#pragma unroll
        for (int k = 0; k < 2; ++k) { const int idx = tid + 512 * k, row = idx >> 3, c8 = (idx & 7) * 8; *(u32x4*)(DS + row * 64 + c8) = *(const LAS u32x4*)(ST + row * 72 + c8); }
    }
    if (MODE == 0) { float* so = A.out + OUT_GLA_S + ((size_t)(l * 32 + b) * 4 + h) * 8192;
#pragma unroll
        for (int n = 0; n < 4; ++n) *(f32x4*)(so + (16 * n + r) * 128 + 16 * w + q * 4) = S[n]; }
    LDS_BAR();
}

__device__ __forceinline__ void gla_scan(const Args& A, int l, int gt, int NGT) {
    unsigned* DS32 = (unsigned*)(A.ws + WS_DS); const float* DEC = (const float*)(A.ws + WS_DEC);
    for (int e = gt; e < 32 * 4096; e += NGT) {
        const int bh = e >> 12, p = e & 4095, dk0 = (2 * p) & 63, dv = p >> 5;
        float s0 = 0.f, s1 = 0.f;
        unsigned* dp = DS32 + (size_t)bh * 32 * 4096 + p; const float* dc = DEC + (size_t)bh * 32 * 64 + dk0;
#pragma unroll 8
        for (int c = 0; c < 32; ++c) { const unsigned wv = dp[(size_t)c * 4096]; const f32x2 d = *(const f32x2*)(dc + c * 64);
            dp[(size_t)c * 4096] = pk2(s0, s1); s0 = d.x * s0 + blo(wv); s1 = d.y * s1 + bhi(wv); }
        float* so = A.out + OUT_GLA_P + ((size_t)(l * 8) * 4 + bh) * 8192;
        so[dk0 * 128 + dv] = s0; so[(dk0 + 1) * 128 + dv] = s1;
    }
}

template <int MODE>
__device__ __forceinline__ void rg_item(LAS unsigned char* L, const Args& A, int l, int smp, int b, int c) {
    const int tid = opaque_tid(), w = __builtin_amdgcn_readfirstlane(tid >> 6), lane = tid & 63, r = lane & 15, q = lane >> 4, tl = lane >> 3, oct = lane & 7;
    const int ch0 = w * 64;
    LAS bf16* XR = (LAS bf16*)(L + w * 18432);
    LAS bf16* XCB = XR + 67 * 64;
    const int ntok = smp ? 32 : 64, row0 = smp ? MP + b * 32 : b * 2048 + c * 64, nbt = smp ? 32 : 8;
    const bf16* Z = (const bf16*)(A.ws + WS_Z); bf16* MIX = (bf16*)(A.ws + WS_MIX);
    float* CA = (float*)(A.ws + WS_CA); float* CU = CA + 8 * 32 * 512;
    const u32x4 z4 = (u32x4){0u, 0u, 0u, 0u};
    LDS_BAR();
    if (lane < 24) { const int j = lane >> 3; u32x4 v = z4;
        if (c > 0) v = *(const u32x4*)(Z + (size_t)(row0 - 3 + j) * NZ + 1536 + ch0 + oct * 8);
        else if (smp) { const float* sp = A.in[I_SCV] + ((size_t)(l * 32 + b) * 3 + j) * 512 + ch0 + oct * 8; const f32x4 a0 = *(const f32x4*)sp, a1 = *(const f32x4*)(sp + 4);
            v.x = pk2(a0.x, a0.y); v.y = pk2(a0.z, a0.w); v.z = pk2(a1.x, a1.y); v.w = pk2(a1.z, a1.w); }
        *(LAS u32x4*)(XR + j * 64 + oct * 8) = v; }
#pragma unroll
    for (int s = 0; s < 8; ++s) { const int t = s * 8 + tl; const u32x4 v = (t < ntok) ? *(const u32x4*)(Z + (size_t)(row0 + t) * NZ + 1536 + ch0 + oct * 8) : z4; *(LAS u32x4*)(XR + (3 + t) * 64 + oct * 8) = v; }
    LDS_WAIT(); asm volatile("" ::: "memory");
    {
        float cw[4][8], cb[8];
#pragma unroll
        for (int dd = 0; dd < 8; ++dd) { cb[dd] = A.in[I_CB][l * 512 + ch0 + oct * 8 + dd];
#pragma unroll
            for (int j = 0; j < 4; ++j) cw[j][dd] = A.in[I_CW][(l * 4 + j) * 512 + ch0 + oct * 8 + dd]; }
#pragma unroll
        for (int s = 0; s < 8; ++s) { const int t = s * 8 + tl; float xc[8];
#pragma unroll
            for (int dd = 0; dd < 8; ++dd) xc[dd] = cb[dd];
#pragma unroll
            for (int j = 0; j < 4; ++j) { float xf[8]; unpack8(*(const LAS u32x4*)(XR + (t + j) * 64 + oct * 8), xf);
#pragma unroll
                for (int dd = 0; dd < 8; ++dd) xc[dd] += cw[j][dd] * xf[dd]; }
            *(LAS u32x4*)(XCB + t * 72 + oct * 8) = pack8(xc); }
    }
    if (MODE == 2 && (smp || c == 31)) {
#pragma unroll
        for (int j = 0; j < 3; ++j) A.out[(smp ? OUT_CV_S : OUT_CV_P) + ((size_t)(l * nbt + b) * 3 + j) * 512 + ch0 + lane] = bf2f(XR[(ntok + j) * 64 + lane]);
    }
    LDS_WAIT(); asm volatile("" ::: "memory");
    const bf16* wrg = (const bf16*)(A.ws + WS_W + (size_t)l * LAYER_W + W_RG) + (size_t)w * 128 * 64;
    bf16x8 Bf[8][2];
#pragma unroll
    for (int n = 0; n < 8; ++n)
#pragma unroll
        for (int ks = 0; ks < 2; ++ks) Bf[n][ks] = *(const bf16x8*)(wrg + (16 * n + r) * 64 + ks * 32 + q * 8);
    float ba_[4], bx_[4], sp_[4], hc[4], At[4], Ut[4];
#pragma unroll
    for (int n = 0; n < 4; ++n) { const int ch = l * 512 + ch0 + 16 * n + r; ba_[n] = A.in[I_BA][ch]; bx_[n] = A.in[I_BX][ch];
        const float lam = A.in[I_LAM][ch]; sp_[n] = 8.f * (fmaxf(-lam, 0.f) + __logf(1.f + __expf(-fabsf(lam)))); At[n] = 1.f; Ut[n] = 0.f; hc[n] = 0.f; }
    if (MODE == 2) {
        if (smp) {
#pragma unroll
            for (int n = 0; n < 4; ++n) hc[n] = A.in[I_SRG][(size_t)(l * 32 + b) * 512 + ch0 + 16 * n + r];
        } else {
            for (int cc = 0; cc < c; ++cc) {
#pragma unroll
                for (int n = 0; n < 4; ++n) { const int ix = (b * 32 + cc) * 512 + ch0 + 16 * n + r; hc[n] = CA[ix] * hc[n] + CU[ix]; } }
        }
    }
    const int nm = ntok >> 4;
    for (int m = 0; m < nm; ++m) {
        unsigned short grv[4][4];
        if (MODE == 2) {
#pragma unroll
            for (int n = 0; n < 4; ++n)
#pragma unroll
                for (int i = 0; i < 4; ++i) grv[n][i] = Z[(size_t)(row0 + 16 * m + 4 * q + i) * NZ + 2048 + ch0 + 16 * n + r];
        }
        f32x4 acc[8];
#pragma unroll
        for (int k = 0; k < 8; ++k) acc[k] = (f32x4){0.f, 0.f, 0.f, 0.f};
#pragma unroll
        for (int ks = 0; ks < 2; ++ks) { const bf16x8 a = *(const LAS bf16x8*)(XCB + (16 * m + r) * 72 + ks * 32 + q * 8);
#pragma unroll
            for (int k = 0; k < 8; ++k) acc[k] = __builtin_amdgcn_mfma_f32_16x16x32_bf16(a, Bf[k][ks], acc[k], 0, 0, 0); }
#pragma unroll
        for (int n = 0; n < 4; ++n) {
            float av[4], uv[4]; float Aq = 1.f, Uq = 0.f;
#pragma unroll
            for (int i = 0; i < 4; ++i) { const float rr = sigm(acc[n][i] + ba_[n]), ii = sigm(acc[4 + n][i] + bx_[n]);
                const float a = __expf(-rr * sp_[n]); const float xcv = bf2f(XCB[(16 * m + 4 * q + i) * 72 + 16 * n + r]);
                const float u = __builtin_amdgcn_sqrtf(fmaxf(1.f - a * a, 0.f)) * ii * xcv;
                av[i] = a; uv[i] = u; Uq = a * Uq + u; Aq = a * Aq; }
            { const float A1 = __shfl_up(Aq, 16), U1 = __shfl_up(Uq, 16); if (q >= 1) { Uq = Aq * U1 + Uq; Aq = Aq * A1; } }
            { const float A2 = __shfl_up(Aq, 32), U2 = __shfl_up(Uq, 32); if (q >= 2) { Uq = Aq * U2 + Uq; Aq = Aq * A2; } }
            const float Am = __shfl(Aq, 48 + r), Um = __shfl(Uq, 48 + r);
            if (MODE == 1) { Ut[n] = Am * Ut[n] + Um; At[n] = Am * At[n]; }
            else {
                const float Aex = __shfl_up(Aq, 16), Uex = __shfl_up(Uq, 16);
                float hin = (q == 0) ? hc[n] : Aex * hc[n] + Uex;
#pragma unroll
                for (int i = 0; i < 4; ++i) { hin = av[i] * hin + uv[i]; XR[(16 * m + 4 * q + i) * 64 + 16 * n + r] = f2bf(hin * gelu_tanh(bf2f(grv[n][i]))); }
                hc[n] = Am * hc[n] + Um;
            }
        }
    }
    if (MODE == 1) { if (q == 0) {
#pragma unroll
        for (int n = 0; n < 4; ++n) { const int ix = (b * 32 + c) * 512 + ch0 + 16 * n + r; CA[ix] = At[n]; CU[ix] = Ut[n]; } } }
    else {
        LDS_WAIT(); asm volatile("" ::: "memory");
#pragma unroll
        for (int s = 0; s < 8; ++s) { const int t = s * 8 + tl; if (t < ntok) *(u32x4*)(MIX + (size_t)(row0 + t) * DM + 512 + ch0 + oct * 8) = *(const LAS u32x4*)(XR + t * 64 + oct * 8); }
        if ((smp || c == 31) && q == 0) {
#pragma unroll
            for (int n = 0; n < 4; ++n) A.out[(smp ? OUT_RG_S : OUT_RG_P) + (size_t)(l * nbt + b) * 512 + ch0 + 16 * n + r] = hc[n]; }
    }
    LDS_BAR();
}

__global__ void __launch_bounds__(NTHR) fwd_megakernel(Args A) {
    extern __shared__ __attribute__((aligned(16))) unsigned char lds_raw[];
    cg::grid_group grid = cg::this_grid();
    LAS unsigned char* L = (LAS unsigned char*)lds_raw;
    const int G = gridDim.x, blk = blockIdx.x, NGW = G * NWAVES;
#define PHASE_IDS() const int tid = opaque_tid(), lane = tid & 63, wave = __builtin_amdgcn_readfirstlane(tid >> 6), gw = blk * NWAVES + wave; (void)tid; (void)lane; (void)gw
    unsigned char* ws = A.ws;
    bf16* H = (bf16*)(ws + WS_H); bf16* GO = (bf16*)(ws + WS_GO); bf16* Zb = (bf16*)(ws + WS_Z); bf16* MIX = (bf16*)(ws + WS_MIX); bf16* HMID = (bf16*)(ws + WS_BIG);
    float* LR = (float*)(ws + WS_LR);

    {
        PHASE_IDS();
        LAS float* scr = (LAS float*)(L + wave * 16384);
        for (int it = gw; it < 2 * 5888; it += NGW) {
            const int l = it / 5888; int r = it % 5888; bf16* wl = (bf16*)(ws + WS_W + (size_t)l * LAYER_W);
            const float* win = A.in[I_WIN] + (size_t)l * DM * DIN;
            if (r < 768) { p0_transpose_item(win, DIN, 0, DM, wl + W_IN / 2, 0, scr, r / 48, r % 48, lane); }
            else if (r < 1280) { r -= 768; p0_transpose_item(win, DIN, 1552, DM, wl + W_IN / 2, 1536, scr, r / 32, r % 32, lane); }
            else if (r < 1792) { r -= 1280; p0_transpose_item(A.in[I_WOUT] + (size_t)l * DM * DM, DM, 0, DM, wl + W_OUT / 2, 0, scr, r / 32, r % 32, lane); }
            else if (r < 3840) { r -= 1792; p0_transpose_item(A.in[I_WFF1] + (size_t)l * DM * FF, FF, 0, DM, wl + W_FF1 / 2, 0, scr, r / 128, r % 128, lane); }
            else { r -= 3840; p0_transpose_item(A.in[I_WFF2] + (size_t)l * FF * DM, DM, 0, FF, wl + W_FF2 / 2, 0, scr, r / 32, r % 32, lane); }
        }
        const int gt = blk * NTHR + tid, NGT = G * NTHR;
        for (int idx = gt; idx < 2 * 16 * 1024; idx += NGT) { const int l = idx >> 14, j = (idx >> 10) & 15, k = idx & 1023;
            ((bf16*)(ws + WS_W + (size_t)l * LAYER_W + W_LR))[j * 1024 + k] = f2bf(A.in[I_WIN][(size_t)l * DM * DIN + (size_t)k * DIN + 1536 + j]); }
        for (int idx = gt; idx < 2 * 8 * 128 * 64; idx += NGT) { const int l = idx >> 16, g = (idx >> 13) & 7, n = (idx >> 6) & 127, k = idx & 63;
            const float v = n < 64 ? A.in[I_WA][((size_t)(l * 8 + g) * 64 + k) * 64 + n] : A.in[I_WX][((size_t)(l * 8 + g) * 64 + k) * 64 + n - 64];
            ((bf16*)(ws + WS_W + (size_t)l * LAYER_W + W_RG))[(g * 128 + n) * 64 + k] = f2bf(v); }
        f32x4 gz[4], gb[4];
#pragma unroll
        for (int j = 0; j < 4; ++j) gz[j] = (f32x4){0.f, 0.f, 0.f, 0.f};
        load_g(A.in[I_GPRE], lane, gb);
        for (int m = gw; m < M; m += NGW) row_op<false, true>(xrow_in(A, m), nullptr, nullptr, gz, nullptr, gb, H + (size_t)m * DM, lane);
    }
    grid.sync();

#pragma unroll
    for (int l = 0; l < 2; ++l) {
        const bf16* wl = (const bf16*)(ws + WS_W + (size_t)l * LAYER_W);
        {
            const bf16* Hin = (l == 0) ? H : MIX;
            pg8::Gemm g{Hin, wl + W_IN / 2, M, NZ, DM}; pg8::StaticOrder S; S.init(M, NZ, DM, G, blk);
            pg8::EpiBf16<0> E{Zb, NZ, nullptr};
            pg8::gemm_phase<pg8::EpiBf16<0>, pg8::StaticOrder, true, true>(L, g, S, E);
            PHASE_IDS();
            const int r = lane & 15, q = lane >> 4; const bf16* wlr = wl + W_LR / 2;
            for (int grp = gw; grp < M / 16; grp += NGW) {
                f32x4 acc = (f32x4){0.f, 0.f, 0.f, 0.f};
                const bf16* ap = Hin + (size_t)(grp * 16 + r) * DM + q * 8; const bf16* bp = wlr + r * DM + q * 8;
#pragma unroll 4
                for (int k0 = 0; k0 < DM; k0 += 32) { const bf16x8 av = *(const bf16x8*)(ap + k0), bv = *(const bf16x8*)(bp + k0); acc = __builtin_amdgcn_mfma_f32_16x16x32_bf16(av, bv, acc, 0, 0, 0); }
#pragma unroll
                for (int i = 0; i < 4; ++i) LR[(size_t)(grp * 16 + q * 4 + i) * 16 + r] = acc[i];
            }
        }
        grid.sync();
        for (int it = blk; it < 1408; it += G) {
            if (it < 256) rg_item<1>(L, A, l, 0, it >> 5, it & 31);
            else if (it < 1280) { const int j = it - 256; gla_item<1>(L, A, l, j >> 7, (j >> 5) & 3, j & 31); }
            else { const int j = it - 1280; gla_item<0>(L, A, l, j >> 2, j & 3, 0); }
        }
        grid.sync();
        { PHASE_IDS(); gla_scan(A, l, blk * NTHR + tid, G * NTHR); }
        for (int it = blk; it < 288; it += G) { const int smp = it >= 256 ? 1 : 0; rg_item<2>(L, A, l, smp, smp ? it - 256 : it >> 5, smp ? 0 : it & 31); }
        grid.sync();
        for (int it = blk; it < 1024; it += G) gla_item<2>(L, A, l, it >> 7, (it >> 5) & 3, it & 31);
        grid.sync();
        {
            pg8::Gemm g{MIX, wl + W_OUT / 2, M, DM, DM}; pg8::SplitOrder S; S.init(DM, G, blk, 8);
            pg8::EpiBf16<0> E{GO, DM, (float*)(ws + WS_Z)};
            pg8::gemm_phase<pg8::EpiBf16<0>, pg8::SplitOrder, true, true>(L, g, S, E);
        }
        grid.sync();
        {
            PHASE_IDS();
            f32x4 ga[4], gb[4]; load_g(A.in[I_GPOST] + l * DM, lane, ga); load_g(A.in[I_GPREFF] + l * DM, lane, gb);
            for (int m = gw; m < M; m += NGW) { const float* xs = (l == 0) ? xrow_in(A, m) : A.out + (size_t)m * DM;
                row_op<true, true>(xs, GO + (size_t)m * DM, m >= MP ? (const float*)(ws + WS_Z) + (size_t)(m - MP) * DM : nullptr, ga, A.out + (size_t)m * DM, gb, H + (size_t)m * DM, lane); }
        }
        grid.sync();
        {
            pg8::Gemm g{H, wl + W_FF1 / 2, M, FF, DM}; pg8::StaticOrder S; S.init(M, FF, DM, G, blk);
            pg8::EpiBf16<2> E{HMID, FF, nullptr};
            pg8::gemm_phase<pg8::EpiBf16<2>, pg8::StaticOrder, true, true>(L, g, S, E);
        }
        grid.sync();
        {
            pg8::Gemm g{HMID, wl + W_FF2 / 2, M, DM, FF}; pg8::SplitOrder S; S.init(FF, G, blk, 8);
            pg8::EpiBf16<0> E{GO, DM, (float*)(ws + WS_H)};
            pg8::gemm_phase<pg8::EpiBf16<0>, pg8::SplitOrder, true, true>(L, g, S, E);
        }
        grid.sync();
        {
            PHASE_IDS();
            f32x4 ga[4], gb[4]; load_g(A.in[I_GPOSTFF] + l * DM, lane, ga); load_g(A.in[I_GPRE] + DM, lane, gb);
            if (l == 0) { for (int m = gw; m < M; m += NGW) row_op<true, true>(A.out + (size_t)m * DM, GO + (size_t)m * DM, m >= MP ? (const float*)(ws + WS_H) + (size_t)(m - MP) * DM : nullptr, ga, A.out + (size_t)m * DM, gb, MIX + (size_t)m * DM, lane); grid.sync(); }
            else { for (int m = gw; m < M; m += NGW) row_op<true, false>(A.out + (size_t)m * DM, GO + (size_t)m * DM, m >= MP ? (const float*)(ws + WS_H) + (size_t)(m - MP) * DM : nullptr, ga, A.out + (size_t)m * DM, gb, nullptr, lane); }
        }
    }
}

extern "C" void kernel_launch(void* const* d_in, const int* in_sizes, int n_in, void* d_out, int out_size, void* d_ws, size_t ws_size, hipStream_t stream) {
    static int grid_blocks = 0;
    if (grid_blocks == 0) {
        if (n_in != 23 || (size_t)out_size != OUT_TOTAL || ws_size < WS_END) { fprintf(stderr, "kernel_launch: unexpected shapes n_in=%d out=%d ws=%zu\n", n_in, out_size, ws_size); grid_blocks = -1; return; }
        int dev = 0, cus = 0, per_cu = 0;
        hipGetDevice(&dev);
        hipDeviceGetAttribute(&cus, hipDeviceAttributeMultiprocessorCount, dev);
        hipFuncSetAttribute((const void*)fwd_megakernel, hipFuncAttributeMaxDynamicSharedMemorySize, LDS_BYTES);
        hipOccupancyMaxActiveBlocksPerMultiprocessor(&per_cu, (const void*)fwd_megakernel, NTHR, LDS_BYTES);
        if (per_cu < 1) { fprintf(stderr, "kernel_launch: occupancy query says %d blocks/CU\n", per_cu); per_cu = 1; }
        (void)hipGetLastError();
        grid_blocks = cus * per_cu;
    }
    if (grid_blocks < 0) return;
    Args a{};
    for (int i = 0; i < 23; ++i) a.in[i] = (const float*)d_in[i];
    a.out = (float*)d_out; a.ws = (unsigned char*)d_ws;
    void* args[] = {&a};
    hipError_t e = hipLaunchCooperativeKernel((const void*)fwd_megakernel, dim3(grid_blocks), dim3(NTHR), args, LDS_BYTES, stream);
    if (e != hipSuccess) fprintf(stderr, "cooperative launch failed: %s (grid %d)\n", hipGetErrorString(e), grid_blocks);
}
```

```cpp
#include <hip/hip_runtime.h>
#include <hip/hip_cooperative_groups.h>
#include <cstdio>
#include <cstdint>
namespace cg = cooperative_groups;
#define PROBE_K (-1)
#define SEC_BEGIN(k) unsigned long long sec_t0_ = 0; if (PROBE_K == (k)) sec_t0_ = __builtin_amdgcn_s_memrealtime()
#define SEC_MARK(k) do { if (PROBE_K == (k)) sec_t0_ = __builtin_amdgcn_s_memrealtime(); } while (0)
#define SEC_END(k) do { if (PROBE_K == (k)) { const unsigned long long dt_ = __builtin_amdgcn_s_memrealtime() - sec_t0_; const unsigned long long t1_ = __builtin_amdgcn_s_memrealtime(); while (__builtin_amdgcn_s_memrealtime() - t1_ < dt_) __builtin_amdgcn_s_sleep(2); } } while (0)
__device__ __forceinline__ int opaque_tid() { int t = threadIdx.x; asm volatile("" : "+v"(t)); return t; }
namespace pg8 {
#define PG8_LAS __attribute__((address_space(3)))
typedef unsigned short bf16_t;
typedef short bf16x8 __attribute__((ext_vector_type(8)));
typedef float f32x4 __attribute__((ext_vector_type(4)));
typedef unsigned u32x4 __attribute__((ext_vector_type(4)));
constexpr int BM = 256, BK = 64, HALF = 128, HTB = HALF * BK * 2  , STAGE_BYTES = 8 * HTB, NXCD = 8, WGM = 8;

__host__ __device__ __forceinline__ int lds_byte(int r, int c) { const int st = (r >> 4) * 2 + (c >> 5), rr = r & 15, cc = c & 31, ob = rr * 64 + cc * 2; return st * 1024 + (ob ^ (((ob >> 9) & 1) << 5)); }
__host__ __device__ __forceinline__ void stage_rc(int b, int& R, int& C) { const int st = b / 1024, sb = b % 1024, swz = sb ^ (((sb >> 9) & 1) << 5); R = (st >> 1) * 16 + swz / 64; C = (st & 1) * 32 + (swz % 64) / 2; }
__host__ __device__ __forceinline__ int perm32(int rho) { const int n = rho >> 4, i = rho & 15; return 8 * (i >> 2) + 4 * n + (i & 3); }

struct Unit { int pm, pn, k0, nt, ks; };
struct Gemm { const bf16_t* A; const bf16_t* Bt; int M, N, K; };

struct StaticOrder {
    int nM, nN, nwg, G, c, ntf;
    __host__ __device__ void init(int M, int N, int K, int G_, int c_) { nM = M / BM; nN = N / BM; nwg = nM * nN; G = G_; c = c_; ntf = K / BK; }
    __host__ __device__ void map(int wgid, Unit& u) const { { const int q = nwg / NXCD, r = nwg % NXCD, xcd = wgid % NXCD, off = wgid / NXCD; wgid = (xcd < r ? xcd * (q + 1) : r * (q + 1) + (xcd - r) * q) + off; }
        const int nig = WGM * nN, gid = wgid / nig, fm = gid * WGM, gsz = (nM - fm) < WGM ? (nM - fm) : WGM;
        u.pm = fm + ((wgid % nig) % gsz); u.pn = (wgid % nig) / gsz; u.k0 = 0; u.nt = ntf; u.ks = -1; }
    __host__ __device__ bool next(int i, Unit& u) const { const long L = (long)i * G + c; if (L >= nwg) return false; map((int)L, u); return true; }
    __device__ __forceinline__ void a_ready(const Unit&) const {}
    __device__ __forceinline__ void done(const Unit&) const {}
};
struct SplitOrder {
    StaticOrder P; int nsplit, ntsub;
    __host__ __device__ void init(int K, int G_, int c_, int nsplit_) { P.init(16384, 1024, K, G_, c_); nsplit = nsplit_; ntsub = K / BK / nsplit_; }
    __host__ __device__ bool next(int i, Unit& u) const { const long L = (long)i * P.G + P.c; if (L < 256) { P.map((int)L, u); return true; }
        const int s = (int)(L - 256); if (s >= 16 * nsplit) return false; const int su = s / nsplit, ks = s % nsplit; u.pm = 64 + (su >> 2); u.pn = su & 3; u.k0 = ks * ntsub * BK; u.nt = ntsub; u.ks = ks; return true; }
    __device__ __forceinline__ void a_ready(const Unit&) const {}
    __device__ __forceinline__ void done(const Unit&) const {}
};


__device__ __forceinline__ unsigned cvt_pk_bf16(float lo, float hi) { unsigned r; asm volatile("v_cvt_pk_bf16_f32 %0, %1, %2" : "=v"(r) : "v"(lo), "v"(hi)); return r; }
template <int ACT> struct EpiBf16 {
    static constexpr bool PERM = true, AFTER_DRAIN = false;
    bf16_t* O; int ldc; float* part;
    __device__ __forceinline__ void operator()(const f32x4 (&acc)[2][2][4][2], const Unit& u, int wr, int wc, int fr, int fq) const {
        const int row0 = u.pm * BM + wr * 64 + fr; const int col0 = u.pn * BM + wc * 32 + 8 * fq;
        if (u.ks >= 0) {
#pragma unroll
            for (int ai = 0; ai < 2; ++ai)
#pragma unroll
                for (int m = 0; m < 4; ++m) { bf16_t* rowp = (bf16_t*)part + ((size_t)u.ks << 20) + (size_t)(row0 - 16384 + ai * HALF + m * 16) * 1024 + col0;
#pragma unroll
                    for (int bj = 0; bj < 2; ++bj) { const f32x4 v0 = acc[ai][bj][m][0], v1 = acc[ai][bj][m][1]; u32x4 w; w.x = cvt_pk_bf16(v0[0], v0[1]); w.y = cvt_pk_bf16(v0[2], v0[3]); w.z = cvt_pk_bf16(v1[0], v1[1]); w.w = cvt_pk_bf16(v1[2], v1[3]); *(u32x4*)(rowp + bj * HALF) = w; } }
            return;
        }
#pragma unroll
        for (int ai = 0; ai < 2; ++ai)
#pragma unroll
            for (int m = 0; m < 4; ++m) { bf16_t* rowp = O + (size_t)(row0 + ai * HALF + m * 16) * ldc + col0;
#pragma unroll
                for (int bj = 0; bj < 2; ++bj) { f32x4 v0 = acc[ai][bj][m][0], v1 = acc[ai][bj][m][1];
                    if (ACT == 2) {
#pragma unroll
                        for (int e = 0; e < 4; ++e) { float a = fmaxf(v0[e], 0.f), b = fmaxf(v1[e], 0.f); v0[e] = a * a; v1[e] = b * b; }
                    }
                    u32x4 w; w.x = cvt_pk_bf16(v0[0], v0[1]); w.y = cvt_pk_bf16(v0[2], v0[3]); w.z = cvt_pk_bf16(v1[0], v1[1]); w.w = cvt_pk_bf16(v1[2], v1[3]);
                    *(u32x4*)(rowp + bj * HALF) = w; } }
    }
};

template <class Epi, class Sched, bool ALIGN_EPI = false, bool SP2 = false>
__device__ __forceinline__ void gemm_phase(PG8_LAS unsigned char* lds, const Gemm g, const Sched& S, const Epi& E) {
    const int tid = opaque_tid(), wid = __builtin_amdgcn_readfirstlane(tid >> 6), lane = tid & 63, wr = wid >> 2, wc = wid & 3, fr = lane & 15, fq = lane >> 4;
    const int K = g.K;
    unsigned voffA[2], voffB[2];
#pragma unroll
    for (int i = 0; i < 2; ++i) { int R, C; stage_rc(tid * 16 + i * 8192, R, C); const int Rb = Epi::PERM ? ((R & ~31) + perm32(R & 31)) : R;
        voffA[i] = (unsigned)(R * K + C) * 2u; voffB[i] = (unsigned)(Rb * K + C) * 2u; }
    const size_t kstep = (size_t)(BK * 2);
    const size_t hstep = (size_t)HALF * K * 2;
    const size_t tstep = 2 * hstep;
    const unsigned ldsw = (unsigned)wid * 1024u;
    const int aoff = lds_byte(wr * 64 + fr, fq * 8), boff = lds_byte(wc * 32 + fr, fq * 8);
#define PG8_SA(b, h) (((b) * 2 + (h)) * HTB)
#define PG8_SB(b, h) ((4 + (b) * 2 + (h)) * HTB)
#define PG8_STAGE(bufoff, gbase, voff) do { _Pragma("unroll") for (int _i = 0; _i < 2; ++_i) \
        __builtin_amdgcn_global_load_lds((const unsigned*)((const char*)(gbase) + (voff)[_i]), (PG8_LAS unsigned*)(lds + (bufoff) + ldsw + _i * 8192), 16, 0, 0); } while (0)
#define PG8_LDA(dst, b, h) do { _Pragma("unroll") for (int m = 0; m < 4; ++m) _Pragma("unroll") for (int k = 0; k < 2; ++k) dst[m][k] = *(const PG8_LAS bf16x8*)(lds + PG8_SA(b, h) + aoff + m * 2048 + k * 1024); } while (0)
#define PG8_LDB(dst, b, h) do { _Pragma("unroll") for (int n = 0; n < 2; ++n) _Pragma("unroll") for (int k = 0; k < 2; ++k) dst[n][k] = *(const PG8_LAS bf16x8*)(lds + PG8_SB(b, h) + boff + n * 2048 + k * 1024); } while (0)
#define PG8_MMA(ai, bj, At, Bt) do { __builtin_amdgcn_s_setprio(1); _Pragma("unroll") for (int m = 0; m < 4; ++m) _Pragma("unroll") for (int n = 0; n < 2; ++n) _Pragma("unroll") for (int k = 0; k < 2; ++k) \
        acc[ai][bj][m][n] = __builtin_amdgcn_mfma_f32_16x16x32_bf16(Bt[n][k], At[m][k], acc[ai][bj][m][n], 0, 0, 0); __builtin_amdgcn_s_setprio(0); } while (0)
#define PG8_WAIT_V(n) asm volatile("s_waitcnt vmcnt(" #n ")" ::: "memory")
#define PG8_WAIT_L(n) asm volatile("s_waitcnt lgkmcnt(" #n ")" ::: "memory")
#define PG8_BAR __builtin_amdgcn_s_barrier()
#define PG8_SCHED __builtin_amdgcn_sched_barrier(0)
    Unit cur, nxt; int ui = 0;
    if (!S.next(0, cur)) return;
    f32x4 acc[2][2][4][2];
#pragma unroll
    for (int a = 0; a < 2; ++a)
#pragma unroll
        for (int b = 0; b < 2; ++b)
#pragma unroll
            for (int m = 0; m < 4; ++m)
#pragma unroll
                for (int n = 0; n < 2; ++n) acc[a][b][m][n] = (f32x4){0.f, 0.f, 0.f, 0.f};
    bf16x8 At[4][2], B0[2][2], B1[2][2];
    const char* cA = (const char*)g.A + (size_t)cur.pm * tstep + (size_t)cur.k0 * 2; const char* cB = (const char*)g.Bt + (size_t)cur.pn * tstep + (size_t)cur.k0 * 2;
    S.a_ready(cur);
    if constexpr (SP2) {
        PG8_STAGE(PG8_SB(0, 0), cB, voffB); PG8_STAGE(PG8_SB(0, 1), cB + hstep, voffB); PG8_STAGE(PG8_SA(0, 0), cA, voffA); PG8_STAGE(PG8_SA(0, 1), cA + hstep, voffA);
        if (wr == 1) PG8_BAR;
        PG8_WAIT_V(2); PG8_BAR;
        PG8_STAGE(PG8_SB(1, 0), cB + kstep, voffB); PG8_STAGE(PG8_SA(1, 0), cA + kstep, voffA); PG8_STAGE(PG8_SB(1, 1), cB + hstep + kstep, voffB);
        PG8_WAIT_V(6); PG8_BAR;
    } else {
        PG8_STAGE(PG8_SB(0, 0), cB, voffB); PG8_STAGE(PG8_SA(0, 0), cA, voffA); PG8_STAGE(PG8_SB(0, 1), cB + hstep, voffB); PG8_STAGE(PG8_SA(0, 1), cA + hstep, voffA);
        if (wr == 1) PG8_BAR;
        PG8_WAIT_V(4); PG8_BAR;
        PG8_STAGE(PG8_SB(1, 0), cB + kstep, voffB); PG8_STAGE(PG8_SA(1, 0), cA + kstep, voffA); PG8_STAGE(PG8_SB(1, 1), cB + hstep + kstep, voffB);
        PG8_WAIT_V(6); PG8_BAR;
    }
    for (;;) {
        const bool has_next = S.next(ui + 1, nxt);
        const char* nA = has_next ? (const char*)g.A + (size_t)nxt.pm * tstep + (size_t)nxt.k0 * 2 : cA; const char* nB = has_next ? (const char*)g.Bt + (size_t)nxt.pn * tstep + (size_t)nxt.k0 * 2 : cB;
        const int nt = cur.nt;
        for (int t = 0; t < nt; t += 2) {
            const bool last = (t == nt - 2);
            const char* a1 = cA + (size_t)(t + 1) * kstep;
            const char* a2 = last ? nA : cA + (size_t)(t + 2) * kstep; const char* b2 = last ? nB : cB + (size_t)(t + 2) * kstep;
            const char* a3 = a2 + kstep; const char* b3 = b2 + kstep;
            if (last && has_next) S.a_ready(nxt);
            if constexpr (SP2) {
            PG8_LDB(B0, 0, 0); PG8_LDB(B1, 0, 1); PG8_SCHED; PG8_LDA(At, 0, 0); PG8_STAGE(PG8_SA(1, 1), a1 + hstep, voffA);
            PG8_WAIT_V(8); PG8_WAIT_L(0); PG8_BAR; PG8_MMA(0, 0, At, B0); PG8_MMA(0, 1, At, B1); PG8_BAR; PG8_SCHED;
            PG8_LDA(At, 0, 1); PG8_STAGE(PG8_SB(0, 0), b2, voffB); PG8_STAGE(PG8_SB(0, 1), b2 + hstep, voffB); PG8_STAGE(PG8_SA(0, 0), a2, voffA);
            PG8_WAIT_V(8); PG8_WAIT_L(0); PG8_BAR; PG8_MMA(1, 0, At, B0); PG8_MMA(1, 1, At, B1); PG8_BAR; PG8_SCHED;
            PG8_LDB(B0, 1, 0); PG8_LDB(B1, 1, 1); PG8_SCHED; PG8_LDA(At, 1, 0); PG8_STAGE(PG8_SA(0, 1), a2 + hstep, voffA);
            PG8_WAIT_V(8); PG8_WAIT_L(0); PG8_BAR; PG8_MMA(0, 0, At, B0); PG8_MMA(0, 1, At, B1); PG8_BAR; PG8_SCHED;
            PG8_LDA(At, 1, 1); PG8_STAGE(PG8_SB(1, 0), b3, voffB); PG8_STAGE(PG8_SB(1, 1), b3 + hstep, voffB); PG8_STAGE(PG8_SA(1, 0), a3, voffA);
            PG8_WAIT_V(8); PG8_WAIT_L(0); PG8_BAR; PG8_MMA(1, 0, At, B0); PG8_MMA(1, 1, At, B1); PG8_BAR; PG8_SCHED;
            } else {
            PG8_LDB(B0, 0, 0); PG8_SCHED; PG8_LDA(At, 0, 0); PG8_STAGE(PG8_SA(1, 1), a1 + hstep, voffA);
            PG8_WAIT_L(8); PG8_BAR; PG8_WAIT_L(0); PG8_MMA(0, 0, At, B0); PG8_BAR; PG8_SCHED;
            PG8_LDB(B1, 0, 1); PG8_STAGE(PG8_SB(0, 0), b2, voffB);
            PG8_BAR; PG8_WAIT_L(0); PG8_MMA(0, 1, At, B1); PG8_BAR;
            PG8_LDA(At, 0, 1); PG8_STAGE(PG8_SA(0, 0), a2, voffA);
            PG8_BAR; PG8_WAIT_L(0); PG8_MMA(1, 0, At, B0); PG8_BAR; PG8_SCHED;
            PG8_STAGE(PG8_SB(0, 1), b2 + hstep, voffB);
            PG8_WAIT_V(6); PG8_BAR; PG8_MMA(1, 1, At, B1); PG8_BAR;
            PG8_LDB(B0, 1, 0); PG8_SCHED; PG8_LDA(At, 1, 0); PG8_STAGE(PG8_SA(0, 1), a2 + hstep, voffA);
            PG8_WAIT_L(8); PG8_BAR; PG8_WAIT_L(0); PG8_MMA(0, 0, At, B0); PG8_BAR; PG8_SCHED;
            PG8_LDB(B1, 1, 1); PG8_STAGE(PG8_SB(1, 0), b3, voffB);
            PG8_BAR; PG8_WAIT_L(0); PG8_MMA(0, 1, At, B1); PG8_BAR;
            PG8_LDA(At, 1, 1); PG8_STAGE(PG8_SA(1, 0), a3, voffA);
            PG8_BAR; PG8_WAIT_L(0); PG8_MMA(1, 0, At, B0); PG8_BAR; PG8_SCHED;
            PG8_STAGE(PG8_SB(1, 1), b3 + hstep, voffB);
            PG8_WAIT_V(6); PG8_BAR; PG8_MMA(1, 1, At, B1); PG8_BAR;
            }
        }
        if constexpr (ALIGN_EPI) { if (wr == 0) PG8_BAR; }
        if constexpr (!Epi::AFTER_DRAIN) { E(acc, cur, wr, wc, fr, fq); S.done(cur); }
        if (!has_next) break;
#pragma unroll
        for (int a = 0; a < 2; ++a)
#pragma unroll
            for (int b = 0; b < 2; ++b)
#pragma unroll
                for (int m = 0; m < 4; ++m)
#pragma unroll
                    for (int n = 0; n < 2; ++n) acc[a][b][m][n] = (f32x4){0.f, 0.f, 0.f, 0.f};
        cur = nxt; cA = nA; cB = nB; ++ui;
        if constexpr (ALIGN_EPI) { if (wr == 1) PG8_BAR; }
    }
    PG8_WAIT_V(0);
    if constexpr (!ALIGN_EPI) { if (wr == 0) PG8_BAR; }
    PG8_BAR;
    if constexpr (Epi::AFTER_DRAIN) { E.fused(acc, cur, wr, wc, fr, fq, lds, wid, lane); S.done(cur); }
#undef PG8_SA
#undef PG8_SB
#undef PG8_STAGE
#undef PG8_LDA
#undef PG8_LDB
#undef PG8_MMA
#undef PG8_WAIT_V
#undef PG8_WAIT_L
#undef PG8_BAR
#undef PG8_SCHED
}
}

#define LAS __attribute__((address_space(3)))
typedef unsigned short bf16;
typedef float f32x4 __attribute__((ext_vector_type(4)));
typedef float f32x2 __attribute__((ext_vector_type(2)));
typedef short bf16x8 __attribute__((ext_vector_type(8)));
typedef unsigned u32x4 __attribute__((ext_vector_type(4)));
typedef unsigned u32x2 __attribute__((ext_vector_type(2)));

constexpr int NWAVES = 8, NTHR = 512;
constexpr int DM = 1024, MP = 16384, MS = 1024, M = MP + MS, DIN = 2576, NZ = 2560, FF = 4096;
constexpr float EPS = 1e-6f;
constexpr size_t MiB = 1u << 20;
constexpr size_t W_IN = 0, W_OUT = W_IN + (size_t)NZ * DM * 2, W_FF1 = W_OUT + (size_t)DM * DM * 2, W_FF2 = W_FF1 + (size_t)FF * DM * 2,
                 W_LR = W_FF2 + (size_t)FF * DM * 2, W_RG = W_LR + 16 * DM * 2, LAYER_W = W_RG + 8 * 128 * 64 * 2;
constexpr size_t WS_W = 1 * MiB, WS_H = 49 * MiB, WS_GO = 83 * MiB, WS_BIG = 117 * MiB, WS_Z = WS_BIG, WS_MIX = WS_BIG + 85 * MiB, WS_DS = WS_BIG + 119 * MiB, WS_DEC = WS_BIG + 135 * MiB, WS_LR = 253 * MiB, WS_CA = 254 * MiB + 256 * 1024, WS_HIN = 255 * MiB + 256 * 1024, WS_END = 256 * MiB;
static_assert(WS_W + 2 * LAYER_W <= WS_H, "weights fit");
static_assert((size_t)M * DM * 2 == 34 * MiB && (size_t)M * NZ * 2 == 85 * MiB && (size_t)M * FF * 2 == 136 * MiB, "sizes");
constexpr size_t OUT_GLA_P = 17825792, OUT_RG_P = 18350080, OUT_CV_P = 18358272, OUT_GLA_S = 18382848, OUT_RG_S = 20480000, OUT_CV_S = 20512768, OUT_TOTAL = 20611072;
constexpr int LDS_BYTES = 147456 + 256, LDS_BARW = 147456;

struct Args { const float* in[23]; float* out; unsigned char* ws; };
enum { I_XP = 0, I_XS, I_SGLA, I_SRG, I_SCV, I_GPRE, I_WIN, I_WLR2, I_BLR, I_GNORM, I_CW, I_CB, I_WA, I_BA, I_WX, I_BX, I_LAM, I_WOUT, I_GPOST, I_GPREFF, I_WFF1, I_WFF2, I_GPOSTFF };

#define LDS_BAR() do { asm volatile("s_waitcnt lgkmcnt(0)" ::: "memory"); __builtin_amdgcn_s_barrier(); asm volatile("" ::: "memory"); } while (0)
#define LDS_WAIT() asm volatile("s_waitcnt lgkmcnt(0)" ::: "memory")

__device__ __forceinline__ unsigned pk2(float lo, float hi) { return pg8::cvt_pk_bf16(lo, hi); }
__device__ __forceinline__ unsigned short f2bf(float f) { return (unsigned short)(pk2(f, 0.f) & 0xffffu); }
__device__ __forceinline__ float bf2f(unsigned short u) { return __uint_as_float(((unsigned)u) << 16); }
__device__ __forceinline__ float blo(unsigned w) { return __uint_as_float(w << 16); }
__device__ __forceinline__ float bhi(unsigned w) { return __uint_as_float(w & 0xffff0000u); }
__device__ __forceinline__ void unpack8(u32x4 v, float (&f)[8]) { f[0] = blo(v.x); f[1] = bhi(v.x); f[2] = blo(v.y); f[3] = bhi(v.y); f[4] = blo(v.z); f[5] = bhi(v.z); f[6] = blo(v.w); f[7] = bhi(v.w); }
__device__ __forceinline__ u32x4 pack8(const float (&f)[8]) { u32x4 o; o.x = pk2(f[0], f[1]); o.y = pk2(f[2], f[3]); o.z = pk2(f[4], f[5]); o.w = pk2(f[6], f[7]); return o; }
__device__ __forceinline__ float wave_sum(float v) {
#pragma unroll
    for (int o = 1; o < 64; o <<= 1) v += __shfl_xor(v, o);
    return v;
}
__device__ __forceinline__ float sigm(float x) { return __builtin_amdgcn_rcpf(1.f + __expf(-x)); }
__device__ __forceinline__ float gelu_tanh(float x) { const float u = 0.7978845608028654f * (x + 0.044715f * x * x * x); const float e = __expf(-2.f * fabsf(u)); float th = (1.f - e) * __builtin_amdgcn_rcpf(1.f + e); th = u < 0.f ? -th : th; return 0.5f * x * (1.f + th); }
__device__ __forceinline__ const float* xrow_in(const Args& A, int m) { return m < MP ? A.in[I_XP] + (size_t)m * DM : A.in[I_XS] + (size_t)(m - MP) * DM; }

__device__ __forceinline__ void p0_transpose_item(const float* W, int ldw, int col0, int K, bf16* WT, int row_off, LAS float* scr, int kb, int nb, int lane) {
    const int k0 = 64 * kb, n0 = 64 * nb;
    f32x4 v[16];
#pragma unroll
    for (int i = 0; i < 16; ++i) v[i] = *(const f32x4*)(W + (size_t)(k0 + 4 * i + (lane >> 4)) * ldw + col0 + n0 + (lane & 15) * 4);
#pragma unroll
    for (int i = 0; i < 16; ++i) { LAS float* d = scr + (4 * i + (lane >> 4)) * 65 + (lane & 15) * 4; d[0] = v[i].x; d[1] = v[i].y; d[2] = v[i].z; d[3] = v[i].w; }
    LDS_WAIT(); asm volatile("" ::: "memory");
    const int c = lane & 7;
#pragma unroll
    for (int j = 0; j < 8; ++j) { const int n = (lane >> 3) + 8 * j; const LAS float* s = scr + (8 * c) * 65 + n;
        u32x4 o; o.x = pk2(s[0 * 65], s[1 * 65]); o.y = pk2(s[2 * 65], s[3 * 65]); o.z = pk2(s[4 * 65], s[5 * 65]); o.w = pk2(s[6 * 65], s[7 * 65]);
        *(u32x4*)(WT + (size_t)(row_off + n0 + n) * K + k0 + 8 * c) = o; }
    LDS_WAIT(); asm volatile("" ::: "memory");
}

__device__ __forceinline__ void convert_layer_weights(LAS unsigned char* L, const Args& A, int l, int w0, int nw, int wave, int lane, int r_begin = 0, int r_end = 2944) {
    LAS float* scr = (LAS float*)(L + wave * 16640);
    bf16* wl = (bf16*)(A.ws + WS_W + (size_t)l * LAYER_W);
    const float* win = A.in[I_WIN] + (size_t)l * DM * DIN;
    for (int it = r_begin + w0; it < r_end; it += nw) { int r = it;
        if (r < 384) { p0_transpose_item(win, DIN, 0, DM, wl + W_IN / 2, 0, scr, r / 24, r % 24, lane); }
        else if (r < 640) { r -= 384; p0_transpose_item(win, DIN, 1552, DM, wl + W_IN / 2, 1536, scr, r / 16, r % 16, lane); }
        else if (r < 896) { r -= 640; p0_transpose_item(A.in[I_WOUT] + (size_t)l * DM * DM, DM, 0, DM, wl + W_OUT / 2, 0, scr, r / 16, r % 16, lane); }
        else if (r < 1920) { r -= 896; p0_transpose_item(A.in[I_WFF1] + (size_t)l * DM * FF, FF, 0, DM, wl + W_FF1 / 2, 0, scr, r / 64, r % 64, lane); }
        else { r -= 1920; p0_transpose_item(A.in[I_WFF2] + (size_t)l * FF * DM, DM, 0, FF, wl + W_FF2 / 2, 0, scr, r / 16, r % 16, lane); }
    }
}

template <bool HAS_GO, bool HAS_H>
__device__ __forceinline__ void row_op(const float* xs, const bf16* go, const float* part, const f32x4 (&ga)[4], float* xo, const f32x4 (&gb)[4], bf16* hb, int lane) {
    f32x4 x[4];
#pragma unroll
    for (int j = 0; j < 4; ++j) x[j] = *(const f32x4*)(xs + 4 * lane + 256 * j);
    if (HAS_GO) {
        f32x4 f[4]; float ss = 0.f;
#pragma unroll
        for (int j = 0; j < 4; ++j) {
            if (part) { const bf16* pb = (const bf16*)part; f[j] = (f32x4){0.f, 0.f, 0.f, 0.f};
#pragma unroll
                for (int ks = 0; ks < 8; ++ks) { const u32x2 wv = *(const u32x2*)(pb + ((size_t)ks << 20) + 4 * lane + 256 * j); f[j] = f[j] + (f32x4){blo(wv.x), bhi(wv.x), blo(wv.y), bhi(wv.y)}; } }
            else { const u32x2 wv = *(const u32x2*)(go + 4 * lane + 256 * j); f[j] = (f32x4){blo(wv.x), bhi(wv.x), blo(wv.y), bhi(wv.y)}; }
            ss += (f[j].x * f[j].x + f[j].y * f[j].y) + (f[j].z * f[j].z + f[j].w * f[j].w); }
        const float rstd = rsqrtf(wave_sum(ss) * (1.f / DM) + EPS);
#pragma unroll
        for (int j = 0; j < 4; ++j) { x[j] = x[j] + f[j] * rstd * ga[j]; *(f32x4*)(xo + 4 * lane + 256 * j) = x[j]; }
    }
    if (HAS_H) {
        float s2 = 0.f;
#pragma unroll
        for (int j = 0; j < 4; ++j) s2 += (x[j].x * x[j].x + x[j].y * x[j].y) + (x[j].z * x[j].z + x[j].w * x[j].w);
        const float r2 = rsqrtf(wave_sum(s2) * (1.f / DM) + EPS);
#pragma unroll
        for (int j = 0; j < 4; ++j) { const f32x4 hv = x[j] * r2 * gb[j]; u32x2 o; o.x = pk2(hv.x, hv.y); o.y = pk2(hv.z, hv.w); *(u32x2*)(hb + 4 * lane + 256 * j) = o; }
    }
}
template <bool HAS_GO, bool HAS_H, int NR>
__device__ __forceinline__ void row_opN(const float* xs, size_t xrs, const bf16* go, const f32x4 (&ga)[4], float* xo, const f32x4 (&gb)[4], bf16* hb, size_t rs, int lane, int nv) {
    f32x4 xv[NR][4]; u32x2 gv[NR][4];
#pragma unroll
    for (int rr = 0; rr < NR; ++rr) if (rr < nv) {
#pragma unroll
        for (int j = 0; j < 4; ++j) { xv[rr][j] = *(const f32x4*)(xs + rr * xrs + 4 * lane + 256 * j); if (HAS_GO) gv[rr][j] = *(const u32x2*)(go + rr * rs + 4 * lane + 256 * j); }
    }
#pragma unroll
    for (int rr = 0; rr < NR; ++rr) if (rr < nv) {
        f32x4 x[4]; float s2 = 0.f;
        if (HAS_GO) { f32x4 f[4]; float ss = 0.f;
#pragma unroll
            for (int j = 0; j < 4; ++j) { const u32x2 wv = gv[rr][j]; f[j] = (f32x4){blo(wv.x), bhi(wv.x), blo(wv.y), bhi(wv.y)}; ss += (f[j].x * f[j].x + f[j].y * f[j].y) + (f[j].z * f[j].z + f[j].w * f[j].w); }
            const float rstd = rsqrtf(wave_sum(ss) * (1.f / DM) + EPS);
#pragma unroll
            for (int j = 0; j < 4; ++j) { x[j] = xv[rr][j] + f[j] * rstd * ga[j]; *(f32x4*)(xo + rr * rs + 4 * lane + 256 * j) = x[j]; }
        } else {
#pragma unroll
            for (int j = 0; j < 4; ++j) x[j] = xv[rr][j];
        }
        if (HAS_H) {
#pragma unroll
            for (int j = 0; j < 4; ++j) s2 += (x[j].x * x[j].x + x[j].y * x[j].y) + (x[j].z * x[j].z + x[j].w * x[j].w);
            const float r2 = rsqrtf(wave_sum(s2) * (1.f / DM) + EPS);
#pragma unroll
            for (int j = 0; j < 4; ++j) { const f32x4 hv = x[j] * r2 * gb[j]; u32x2 o; o.x = pk2(hv.x, hv.y); o.y = pk2(hv.z, hv.w); *(u32x2*)(hb + rr * rs + 4 * lane + 256 * j) = o; } }
    }
}
__device__ __forceinline__ void load_g(const float* g, int lane, f32x4 (&v)[4]) {
#pragma unroll
    for (int j = 0; j < 4; ++j) v[j] = *(const f32x4*)(g + 4 * lane + 256 * j);
}

struct GlaPipe { u32x4 rk, rv0, rv1; f32x2 rl; float blr[8]; int hprev, jn; };
template <int MODE, bool PIPE = false>
__device__ __forceinline__ void gla_item(LAS unsigned char* L, const Args& A, int l, int b, int h, int c, GlaPipe* P = nullptr) {
    const int tid = opaque_tid(), w = __builtin_amdgcn_readfirstlane(tid >> 6), lane = tid & 63, r = lane & 15, q = lane >> 4;
    const int t = tid >> 3, oct = tid & 7, o8 = oct * 8, tsw = t ^ (oct << 3);
    LAS bf16* QT = (LAS bf16*)(L + 0); LAS bf16* KT = (LAS bf16*)(L + 9216); LAS bf16* KHT = (LAS bf16*)(L + 18432); LAS bf16* ATT = (LAS bf16*)(L + 27648);
    LAS bf16* VT = (LAS bf16*)(L + 36864); LAS bf16* ST = (LAS bf16*)(L + 55296); LAS bf16* GS = (LAS bf16*)(L + 73728);
    LAS float* LRS = (LAS float*)(L + 91136); LAS float* WL = (LAS float*)(L + 95232); LAS float* SEG = (LAS float*)(L + 99328);
    LAS float* SSQ = (LAS float*)(L + 101376); LAS float* BL = (LAS float*)(L + 101888);
    constexpr bool SMP = (MODE == 0), DO_OUT = (MODE != 1), DO_S = (MODE != 2);
    const int ntok = SMP ? 32 : 64, row0 = SMP ? MP + b * 32 : b * 2048 + c * 64;
    const int item = (b * 4 + h) * 32 + c;
    const bf16* Z = (const bf16*)(A.ws + WS_Z); bf16* MIX = (bf16*)(A.ws + WS_MIX); const float* LR = (const float*)(A.ws + WS_LR);
    bf16* DS = (bf16*)(A.ws + WS_DS) + (size_t)item * 8192; float* DEC = (float*)(A.ws + WS_DEC) + (size_t)item * 64;
    const bool valid = t < ntok;
    const u32x4 z4 = (u32x4){0u, 0u, 0u, 0u};
    const bf16* zr = Z + (size_t)(row0 + t) * NZ;
    u32x4 rq = z4, rk, rv0, rv1, rg0 = z4, rg1 = z4; f32x2 rl;
    if (PIPE) { rk = P->rk; rv0 = P->rv0; rv1 = P->rv1; rl = P->rl; }
    else {
    rk = valid ? *(const u32x4*)(zr + 256 + h * 64 + o8) : z4;
    rv0 = valid ? *(const u32x4*)(zr + 512 + h * 128 + o8) : z4; rv1 = valid ? *(const u32x4*)(zr + 512 + h * 128 + 64 + o8) : z4;
    rl = valid ? *(const f32x2*)(LR + (size_t)(row0 + t) * 16 + oct * 2) : (f32x2){0.f, 0.f};
    }
    if (DO_OUT) { rq = valid ? *(const u32x4*)(zr + h * 64 + o8) : z4; rg0 = valid ? *(const u32x4*)(zr + 1024 + h * 128 + o8) : z4; rg1 = valid ? *(const u32x4*)(zr + 1024 + h * 128 + 64 + o8) : z4; }
    f32x4 S[4];
#pragma unroll
    for (int n = 0; n < 4; ++n) S[n] = (f32x4){0.f, 0.f, 0.f, 0.f};
    if (MODE == 0) { const float* s0 = A.in[I_SGLA] + ((size_t)(l * 32 + b) * 4 + h) * 8192;
#pragma unroll
        for (int n = 0; n < 4; ++n) S[n] = *(const f32x4*)(s0 + (16 * n + r) * 128 + 16 * w + q * 4);
#pragma unroll
        for (int n = 0; n < 4; ++n)
#pragma unroll
            for (int i = 0; i < 4; ++i) ST[(16 * w + q * 4 + i) * 72 + 16 * n + r] = f2bf(S[n][i]);
    }
    if (MODE == 2) {
#pragma unroll
        for (int k = 0; k < 2; ++k) { const int idx = tid + 512 * k, row = idx >> 3, c8 = (idx & 7) * 8; *(LAS u32x4*)(ST + row * 72 + c8) = *(const u32x4*)(DS + row * 64 + c8); }
    }
    { const int idx = tid * 2, j = idx >> 6, d = idx & 63; const float* src = A.in[I_WLR2] + (size_t)(l * 16 + j) * 256 + h * 64 + d; WL[j * 64 + d] = src[0]; WL[j * 64 + d + 1] = src[1]; }
    float blr[8];
#pragma unroll
    for (int dd = 0; dd < 8; ++dd) blr[dd] = A.in[I_BLR][l * 256 + h * 64 + o8 + dd];
    const int mi = w >> 1;
    LRS[t * 16 + oct * 2] = rl.x; LRS[t * 16 + oct * 2 + 1] = rl.y;
    LDS_BAR();
    float la[8];
    {
        float lrv[16];
#pragma unroll
        for (int j4 = 0; j4 < 4; ++j4) { const f32x4 v = *(const LAS f32x4*)(LRS + t * 16 + j4 * 4); lrv[j4 * 4] = v.x; lrv[j4 * 4 + 1] = v.y; lrv[j4 * 4 + 2] = v.z; lrv[j4 * 4 + 3] = v.w; }
#pragma unroll
        for (int dd = 0; dd < 8; ++dd) la[dd] = blr[dd];
#pragma unroll
        for (int j = 0; j < 16; ++j) { const f32x4 w0 = *(const LAS f32x4*)(WL + j * 64 + o8), w1 = *(const LAS f32x4*)(WL + j * 64 + o8 + 4);
            la[0] += lrv[j] * w0.x; la[1] += lrv[j] * w0.y; la[2] += lrv[j] * w0.z; la[3] += lrv[j] * w0.w;
            la[4] += lrv[j] * w1.x; la[5] += lrv[j] * w1.y; la[6] += lrv[j] * w1.z; la[7] += lrv[j] * w1.w; }
#pragma unroll
        for (int dd = 0; dd < 8; ++dd) { const float x = la[dd]; const float ls = fminf(x, 0.f) - __logf(1.f + __expf(-fabsf(x))); la[dd] = valid ? ls * (1.f / 16.f) : 0.f; }
#pragma unroll
        for (int dd = 0; dd < 8; ++dd) { float v = la[dd]; float u = __shfl_up(v, 8); if (lane >= 8) v += u; u = __shfl_up(v, 16); if (lane >= 16) v += u; u = __shfl_up(v, 32); if (lane >= 32) v += u; la[dd] = v; }
        if ((lane >> 3) == 7) { *(LAS f32x4*)(SEG + w * 64 + o8) = (f32x4){la[0], la[1], la[2], la[3]}; *(LAS f32x4*)(SEG + w * 64 + o8 + 4) = (f32x4){la[4], la[5], la[6], la[7]}; }
    }
    LDS_BAR();
    float bl[8];
    {
        float pre[8];
#pragma unroll
        for (int dd = 0; dd < 8; ++dd) { pre[dd] = 0.f; bl[dd] = 0.f; }
#pragma unroll
        for (int ww = 0; ww < 8; ++ww) { const f32x4 s0 = *(const LAS f32x4*)(SEG + ww * 64 + o8), s1 = *(const LAS f32x4*)(SEG + ww * 64 + o8 + 4);
            const float m = ww < w ? 1.f : 0.f;
            pre[0] += m * s0.x; pre[1] += m * s0.y; pre[2] += m * s0.z; pre[3] += m * s0.w; pre[4] += m * s1.x; pre[5] += m * s1.y; pre[6] += m * s1.z; pre[7] += m * s1.w;
            bl[0] += s0.x; bl[1] += s0.y; bl[2] += s0.z; bl[3] += s0.w; bl[4] += s1.x; bl[5] += s1.y; bl[6] += s1.z; bl[7] += s1.w; }
#pragma unroll
        for (int dd = 0; dd < 8; ++dd) la[dd] += pre[dd];
    }
    {
        float kf[8]; unpack8(rk, kf);
        if (DO_OUT) { float qf[8], qt[8], kt[8]; unpack8(rq, qf);
#pragma unroll
            for (int dd = 0; dd < 8; ++dd) { qt[dd] = qf[dd] * 0.125f * __expf(la[dd]); kt[dd] = kf[dd] * __expf(-la[dd]); }
            *(LAS u32x4*)(QT + t * 72 + o8) = pack8(qt); *(LAS u32x4*)(KT + t * 72 + o8) = pack8(kt);
            *(LAS u32x4*)(GS + t * 136 + o8) = rg0; *(LAS u32x4*)(GS + t * 136 + 64 + o8) = rg1; }
        if (DO_S) {
#pragma unroll
            for (int dd = 0; dd < 8; ++dd) KHT[(o8 + dd) * 72 + tsw] = f2bf(kf[dd] * __expf(bl[dd] - la[dd]));
            if (t == 0) {
#pragma unroll
                for (int dd = 0; dd < 8; ++dd) BL[o8 + dd] = __expf(bl[dd]);
            } }
        const unsigned vw[8] = {rv0.x, rv0.y, rv0.z, rv0.w, rv1.x, rv1.y, rv1.z, rv1.w};
#pragma unroll
        for (int e2 = 0; e2 < 8; ++e2) { const int e = (e2 < 4 ? 0 : 64) + o8 + (e2 & 3) * 2; VT[e * 72 + tsw] = (bf16)(vw[e2] & 0xffffu); VT[(e + 1) * 72 + tsw] = (bf16)(vw[e2] >> 16); }
    }
    if (PIPE) { if (P->jn >= 0) { const int jn = P->jn, hn = (jn >> 5) & 3; const bf16* zn = Z + (size_t)((jn >> 7) * 2048 + (jn & 31) * 64 + t) * NZ;
        P->rk = *(const u32x4*)(zn + 256 + hn * 64 + o8); P->rv0 = *(const u32x4*)(zn + 512 + hn * 128 + o8); P->rv1 = *(const u32x4*)(zn + 512 + hn * 128 + 64 + o8);
        P->rl = *(const f32x2*)(LR + (size_t)((jn >> 7) * 2048 + (jn & 31) * 64 + t) * 16 + oct * 2); } }
    LDS_BAR();
    const int swr = (r >> 3);
    f32x4 O[4];
    if (DO_OUT) {
#pragma unroll
        for (int jj = 0; jj < 2; ++jj) { const int nj = 2 * (w & 1) + jj; f32x4 acc = (f32x4){0.f, 0.f, 0.f, 0.f};
#pragma unroll
            for (int ks = 0; ks < 2; ++ks) { const bf16x8 a = *(const LAS bf16x8*)(QT + (16 * mi + r) * 72 + ks * 32 + q * 8), bb = *(const LAS bf16x8*)(KT + (16 * nj + r) * 72 + ks * 32 + q * 8);
                acc = __builtin_amdgcn_mfma_f32_16x16x32_bf16(a, bb, acc, 0, 0, 0); }
#pragma unroll
            for (int i = 0; i < 4; ++i) { const int row = 16 * mi + q * 4 + i, col = 16 * nj + r; ATT[row * 72 + col] = f2bf(col <= row ? acc[i] : 0.f); } }
        LDS_BAR();
#pragma unroll
        for (int n = 0; n < 4; ++n) O[n] = (f32x4){0.f, 0.f, 0.f, 0.f};
#pragma unroll
        for (int ks = 0; ks < 2; ++ks) { const bf16x8 a = *(const LAS bf16x8*)(QT + (16 * mi + r) * 72 + ks * 32 + q * 8);
#pragma unroll
            for (int n = 0; n < 4; ++n) { const bf16x8 bb = *(const LAS bf16x8*)(ST + (16 * (4 * (w & 1) + n) + r) * 72 + ks * 32 + q * 8); O[n] = __builtin_amdgcn_mfma_f32_16x16x32_bf16(a, bb, O[n], 0, 0, 0); } }
#pragma unroll
        for (int ks = 0; ks < 2; ++ks) { const bf16x8 a = *(const LAS bf16x8*)(ATT + (16 * mi + r) * 72 + ks * 32 + q * 8);
#pragma unroll
            for (int n = 0; n < 4; ++n) { const int sw = ((2 * n + swr) & 7) << 3; const bf16x8 bb = *(const LAS bf16x8*)(VT + (16 * (4 * (w & 1) + n) + r) * 72 + ((ks * 32 + q * 8) ^ sw)); O[n] = __builtin_amdgcn_mfma_f32_16x16x32_bf16(a, bb, O[n], 0, 0, 0); } }
    }
    if (DO_S) {
#pragma unroll
        for (int n = 0; n < 4; ++n) { const float dec = BL[16 * n + r]; S[n] = S[n] * dec; }
#pragma unroll
        for (int ks = 0; ks < 2; ++ks) { const int swa = ((2 * w + swr) & 7) << 3; const bf16x8 a = *(const LAS bf16x8*)(VT + (16 * w + r) * 72 + ((ks * 32 + q * 8) ^ swa));
#pragma unroll
            for (int n = 0; n < 4; ++n) { const int sw = ((2 * n + swr) & 7) << 3; const bf16x8 bb = *(const LAS bf16x8*)(KHT + (16 * n + r) * 72 + ((ks * 32 + q * 8) ^ sw)); S[n] = __builtin_amdgcn_mfma_f32_16x16x32_bf16(a, bb, S[n], 0, 0, 0); } }
    }
    if (DO_OUT) {
#pragma unroll
        for (int i = 0; i < 4; ++i) { float s = 0.f;
#pragma unroll
            for (int n = 0; n < 4; ++n) s += O[n][i] * O[n][i];
            s += __shfl_xor(s, 1); s += __shfl_xor(s, 2); s += __shfl_xor(s, 4); s += __shfl_xor(s, 8);
            if (r == 0) SSQ[(16 * mi + q * 4 + i) * 2 + (w & 1)] = s; }
    }
    LDS_BAR();
    if (MODE == 1) {
#pragma unroll
        for (int n = 0; n < 4; ++n)
#pragma unroll
            for (int i = 0; i < 4; ++i) ST[(16 * w + q * 4 + i) * 72 + 16 * n + r] = f2bf(S[n][i]);
        if (tid < 64) DEC[tid] = BL[tid];
    }
    if (DO_OUT) {
        float gn[4];
#pragma unroll
        for (int n = 0; n < 4; ++n) gn[n] = A.in[I_GNORM][l * 128 + 16 * (4 * (w & 1) + n) + r];
#pragma unroll
        for (int i = 0; i < 4; ++i) { const int row = 16 * mi + q * 4 + i; const float rstd = __builtin_amdgcn_rsqf((SSQ[row * 2] + SSQ[row * 2 + 1]) * (1.f / 128.f) + EPS);
#pragma unroll
            for (int n = 0; n < 4; ++n) { const int e = 16 * (4 * (w & 1) + n) + r; const float gv = bf2f(GS[row * 136 + e]); GS[row * 136 + e] = f2bf(O[n][i] * rstd * gn[n] * gv * sigm(gv)); } }
    }
    LDS_BAR();
    if (DO_OUT) { if (valid) { bf16* mr = MIX + (size_t)(row0 + t) * DM + h * 128 + o8;
        *(u32x4*)(mr) = *(const LAS u32x4*)(GS + t * 136 + o8); *(u32x4*)(mr + 64) = *(const LAS u32x4*)(GS + t * 136 + 64 + o8); } }
    if (MODE == 1) {
#pragma unroll
        for (int k = 0; k < 2; ++k) { const int idx = tid + 512 * k, row = idx >> 3, c8 = (idx & 7) * 8; *(u32x4*)(DS + row * 64 + c8) = *(const LAS u32x4*)(ST + row * 72 + c8); }
    }
    if (MODE == 0) { float* so = A.out + OUT_GLA_S + ((size_t)(l * 32 + b) * 4 + h) * 8192;
#pragma unroll
        for (int n = 0; n < 4; ++n) *(f32x4*)(so + (16 * n + r) * 128 + 16 * w + q * 4) = S[n]; }
    LDS_BAR();
}

template <int MODE>
__device__ __forceinline__ void gla_loop(LAS unsigned char* L, const Args& A, int l, int j0, int jstride, int jend) {
    if (j0 >= jend) return;
    const int tid = opaque_tid(), w = __builtin_amdgcn_readfirstlane(tid >> 6), lane = tid & 63, r = lane & 15, q = lane >> 4;
    const int t2 = tid >> 3, c8 = (tid & 7) * 8;
    const int o8 = w * 8;
    LAS bf16* QT = (LAS bf16*)(L + 0); LAS bf16* KT = (LAS bf16*)(L + 9216); LAS bf16* KHT = (LAS bf16*)(L + 18432); LAS bf16* ATT = (LAS bf16*)(L + 27648);
    LAS bf16* VT = (LAS bf16*)(L + 36864); LAS bf16* ST = (LAS bf16*)(L + 55296); LAS bf16* GS = (LAS bf16*)(L + 73728);
    LAS float* LRS = (LAS float*)(L + 91136); LAS bf16* VRAW = (LAS bf16*)(L + 102144); LAS float* WL = (LAS float*)(L + 95232); LAS float* SSQ = (LAS float*)(L + 101376); LAS float* BL = (LAS float*)(L + 101888);
    constexpr bool SMP = (MODE == 0), DO_OUT = (MODE != 1), DO_S = (MODE != 2);
    constexpr int ntok = SMP ? 32 : 64;
    const bf16* Z = (const bf16*)(A.ws + WS_Z); bf16* MIX = (bf16*)(A.ws + WS_MIX); const float* LR = (const float*)(A.ws + WS_LR);
    const bool valid = lane < ntok;
    const u32x4 z4 = (u32x4){0u, 0u, 0u, 0u};
    const int mi = w >> 1, swr = r >> 3; (void)swr;
    u32x4 rq = z4, rk = z4, rv0 = z4, rv1 = z4, rg0 = z4, rg1 = z4, sd0 = z4, sd1 = z4;
#define GLA_ROW0(j) (SMP ? MP + ((j) >> 2) * 32 : ((j) >> 7) * 2048 + ((j) & 31) * 64)
#define GLA_HEAD(j) (SMP ? ((j) & 3) : (((j) >> 5) & 3))
#define GLA_LOAD(j) do { const int h_ = GLA_HEAD(j); const bf16* zr = Z + (size_t)(GLA_ROW0(j) + t2) * NZ; \
        if (t2 < ntok) { rk = *(const u32x4*)(zr + 256 + h_ * 64 + c8); rv0 = *(const u32x4*)(zr + 512 + h_ * 128 + c8); rv1 = *(const u32x4*)(zr + 512 + h_ * 128 + 64 + c8); \
            rl2 = *(const f32x2*)(LR + (size_t)(GLA_ROW0(j) + t2) * 16 + (tid & 7) * 2); \
            if (DO_OUT) { rq = *(const u32x4*)(zr + h_ * 64 + c8); rg0 = *(const u32x4*)(zr + 1024 + h_ * 128 + c8); rg1 = *(const u32x4*)(zr + 1024 + h_ * 128 + 64 + c8); } } \
        if (MODE == 2) { const bf16* ds_ = (const bf16*)(A.ws + WS_DS) + (size_t)(j) * 8192; sd0 = *(const u32x4*)(ds_ + t2 * 64 + c8); sd1 = *(const u32x4*)(ds_ + (64 + t2) * 64 + c8); } } while (0)
    f32x2 rl2 = (f32x2){0.f, 0.f};
    GLA_LOAD(j0);
    int hprev = -1;
    float blr[8], gn[4];
#pragma unroll
    for (int dd = 0; dd < 8; ++dd) blr[dd] = 0.f;
#pragma unroll
    for (int n = 0; n < 4; ++n) gn[n] = A.in[I_GNORM][l * 128 + 16 * (4 * (w & 1) + n) + r];
    for (int j = j0; j < jend; j += jstride) {
        SEC_BEGIN(21); SEC_MARK(21);
        const int h = GLA_HEAD(j), row0 = GLA_ROW0(j), b = SMP ? (j >> 2) : (j >> 7);
        if (h != hprev) { hprev = h;
#pragma unroll
            for (int dd = 0; dd < 8; ++dd) blr[dd] = A.in[I_BLR][l * 256 + h * 64 + o8 + dd];
            { const int idx = tid * 2, jj = idx >> 6, d = idx & 63; const float* src = A.in[I_WLR2] + (size_t)(l * 16 + jj) * 256 + h * 64 + d; WL[jj * 64 + d] = src[0]; WL[jj * 64 + d + 1] = src[1]; }
            LDS_BAR(); }
        f32x4 S[4];
#pragma unroll
        for (int n = 0; n < 4; ++n) S[n] = (f32x4){0.f, 0.f, 0.f, 0.f};
        if (MODE == 0) { const float* s0 = A.in[I_SGLA] + ((size_t)(l * 32 + b) * 4 + h) * 8192;
#pragma unroll
            for (int n = 0; n < 4; ++n) S[n] = *(const f32x4*)(s0 + (16 * n + r) * 128 + 16 * w + q * 4);
#pragma unroll
            for (int n = 0; n < 4; ++n)
#pragma unroll
                for (int i = 0; i < 4; ++i) ST[(16 * w + q * 4 + i) * 72 + 16 * n + r] = f2bf(S[n][i]);
        }
        if (MODE == 2) { *(LAS u32x4*)(ST + t2 * 72 + c8) = sd0; *(LAS u32x4*)(ST + (64 + t2) * 72 + c8) = sd1; }
        *(LAS u32x4*)(KT + t2 * 72 + c8) = rk; *(LAS u32x4*)(VRAW + t2 * 136 + c8) = rv0; *(LAS u32x4*)(VRAW + t2 * 136 + 64 + c8) = rv1; *(LAS f32x2*)(LRS + t2 * 16 + (tid & 7) * 2) = rl2;
        if (DO_OUT) { *(LAS u32x4*)(QT + t2 * 72 + c8) = rq; *(LAS u32x4*)(GS + t2 * 136 + c8) = rg0; *(LAS u32x4*)(GS + t2 * 136 + 64 + c8) = rg1; }
        if (j + jstride < jend) GLA_LOAD(j + jstride);
        LDS_BAR();
        f32x4 rl[4];
#pragma unroll
        for (int k = 0; k < 4; ++k) rl[k] = *(const LAS f32x4*)(LRS + lane * 16 + 4 * k);
        const u32x4 kx = *(const LAS u32x4*)(KT + lane * 72 + o8), v0 = *(const LAS u32x4*)(VRAW + lane * 136 + o8), v1 = *(const LAS u32x4*)(VRAW + lane * 136 + 64 + o8);
        u32x4 qx = z4; if (DO_OUT) qx = *(const LAS u32x4*)(QT + lane * 72 + o8);
        float la[8], bl[8];
        {
            const float lrv[16] = {rl[0].x, rl[0].y, rl[0].z, rl[0].w, rl[1].x, rl[1].y, rl[1].z, rl[1].w, rl[2].x, rl[2].y, rl[2].z, rl[2].w, rl[3].x, rl[3].y, rl[3].z, rl[3].w};
#pragma unroll
            for (int dd = 0; dd < 8; ++dd) la[dd] = blr[dd];
#pragma unroll
            for (int jj = 0; jj < 16; ++jj) { const f32x4 w0 = *(const LAS f32x4*)(WL + jj * 64 + o8), w1 = *(const LAS f32x4*)(WL + jj * 64 + o8 + 4);
                la[0] += lrv[jj] * w0.x; la[1] += lrv[jj] * w0.y; la[2] += lrv[jj] * w0.z; la[3] += lrv[jj] * w0.w;
                la[4] += lrv[jj] * w1.x; la[5] += lrv[jj] * w1.y; la[6] += lrv[jj] * w1.z; la[7] += lrv[jj] * w1.w; }
#pragma unroll
            for (int dd = 0; dd < 8; ++dd) { const float x = la[dd]; const float ls = fminf(x, 0.f) - __logf(1.f + __expf(-fabsf(x))); la[dd] = valid ? ls * (1.f / 16.f) : 0.f; }
#pragma unroll
            for (int dd = 0; dd < 8; ++dd) { float v = la[dd];
#pragma unroll
                for (int o = 1; o < 64; o <<= 1) { const float u = __shfl_up(v, o); if (lane >= o) v += u; }
                la[dd] = v; bl[dd] = __shfl(v, 63); }
        }
        {
            float kf[8]; unpack8(kx, kf);
            if (DO_OUT) { float qf[8], qt[8], kt[8]; unpack8(qx, qf);
#pragma unroll
                for (int dd = 0; dd < 8; ++dd) { qt[dd] = qf[dd] * 0.125f * __expf(la[dd]); kt[dd] = kf[dd] * __expf(-la[dd]); }
                *(LAS u32x4*)(QT + lane * 72 + o8) = pack8(qt); *(LAS u32x4*)(KT + lane * 72 + o8) = pack8(kt);
}
            if (DO_S) {
#pragma unroll
                for (int dd = 0; dd < 8; ++dd) KHT[(o8 + dd) * 72 + lane] = f2bf(kf[dd] * __expf(bl[dd] - la[dd]));
                if (lane == 0) {
#pragma unroll
                    for (int dd = 0; dd < 8; ++dd) BL[o8 + dd] = __expf(bl[dd]);
                } }
            const unsigned vw[8] = {v0.x, v0.y, v0.z, v0.w, v1.x, v1.y, v1.z, v1.w};
#pragma unroll
            for (int e2 = 0; e2 < 8; ++e2) { const int e = (e2 < 4 ? 0 : 64) + o8 + (e2 & 3) * 2; VT[e * 72 + lane] = (bf16)(vw[e2] & 0xffffu); VT[(e + 1) * 72 + lane] = (bf16)(vw[e2] >> 16); }
        }
        SEC_END(21); SEC_MARK(22);
        LDS_BAR();
        f32x4 O[4];
        if (DO_OUT) {
#pragma unroll
            for (int jj = 0; jj < 2; ++jj) { const int nj = 2 * (w & 1) + jj; f32x4 acc = (f32x4){0.f, 0.f, 0.f, 0.f};
#pragma unroll
                for (int ks = 0; ks < 2; ++ks) { const bf16x8 a = *(const LAS bf16x8*)(QT + (16 * mi + r) * 72 + ks * 32 + q * 8), bb = *(const LAS bf16x8*)(KT + (16 * nj + r) * 72 + ks * 32 + q * 8);
                    acc = __builtin_amdgcn_mfma_f32_16x16x32_bf16(a, bb, acc, 0, 0, 0); }
#pragma unroll
                for (int i = 0; i < 4; ++i) { const int row = 16 * mi + q * 4 + i, col = 16 * nj + r; ATT[row * 72 + col] = f2bf(col <= row ? acc[i] : 0.f); } }
            LDS_BAR();
#pragma unroll
            for (int n = 0; n < 4; ++n) O[n] = (f32x4){0.f, 0.f, 0.f, 0.f};
#pragma unroll
            for (int ks = 0; ks < 2; ++ks) { const bf16x8 a = *(const LAS bf16x8*)(QT + (16 * mi + r) * 72 + ks * 32 + q * 8);
#pragma unroll
                for (int n = 0; n < 4; ++n) { const bf16x8 bb = *(const LAS bf16x8*)(ST + (16 * (4 * (w & 1) + n) + r) * 72 + ks * 32 + q * 8); O[n] = __builtin_amdgcn_mfma_f32_16x16x32_bf16(a, bb, O[n], 0, 0, 0); } }
#pragma unroll
            for (int ks = 0; ks < 2; ++ks) { const bf16x8 a = *(const LAS bf16x8*)(ATT + (16 * mi + r) * 72 + ks * 32 + q * 8);
#pragma unroll
                for (int n = 0; n < 4; ++n) { const bf16x8 bb = *(const LAS bf16x8*)(VT + (16 * (4 * (w & 1) + n) + r) * 72 + ks * 32 + q * 8); O[n] = __builtin_amdgcn_mfma_f32_16x16x32_bf16(a, bb, O[n], 0, 0, 0); } }
        }
        if (DO_S) {
#pragma unroll
            for (int n = 0; n < 4; ++n) { const float dec = BL[16 * n + r]; S[n] = S[n] * dec; }
#pragma unroll
            for (int ks = 0; ks < 2; ++ks) { const bf16x8 a = *(const LAS bf16x8*)(VT + (16 * w + r) * 72 + ks * 32 + q * 8);
#pragma unroll
                for (int n = 0; n < 4; ++n) { const bf16x8 bb = *(const LAS bf16x8*)(KHT + (16 * n + r) * 72 + ks * 32 + q * 8); S[n] = __builtin_amdgcn_mfma_f32_16x16x32_bf16(a, bb, S[n], 0, 0, 0); } }
        }
        if (DO_OUT) {
#pragma unroll
            for (int i = 0; i < 4; ++i) { float s = 0.f;
#pragma unroll
                for (int n = 0; n < 4; ++n) s += O[n][i] * O[n][i];
                s += __shfl_xor(s, 1); s += __shfl_xor(s, 2); s += __shfl_xor(s, 4); s += __shfl_xor(s, 8);
                if (r == 0) SSQ[(16 * mi + q * 4 + i) * 2 + (w & 1)] = s; }
        }
        LDS_BAR();
        SEC_END(22); SEC_MARK(23);
        if (MODE == 1) {
#pragma unroll
            for (int n = 0; n < 4; ++n)
#pragma unroll
                for (int i = 0; i < 4; ++i) ST[(16 * w + q * 4 + i) * 72 + 16 * n + r] = f2bf(S[n][i]);
            if (tid < 64) ((float*)(A.ws + WS_DEC))[(size_t)j * 64 + tid] = BL[tid];
        }
        if (DO_OUT) {
#pragma unroll
            for (int i = 0; i < 4; ++i) { const int row = 16 * mi + q * 4 + i; const float rstd = __builtin_amdgcn_rsqf((SSQ[row * 2] + SSQ[row * 2 + 1]) * (1.f / 128.f) + EPS);
#pragma unroll
                for (int n = 0; n < 4; ++n) { const int e = 16 * (4 * (w & 1) + n) + r; const float gv = bf2f(GS[row * 136 + e]); GS[row * 136 + e] = f2bf(O[n][i] * rstd * gn[n] * gv * sigm(gv)); } }
        }
        LDS_BAR();
        if (DO_OUT) { if (t2 < ntok) { bf16* mr = MIX + (size_t)(row0 + t2) * DM + h * 128 + c8;
            *(u32x4*)(mr) = *(const LAS u32x4*)(GS + t2 * 136 + c8); *(u32x4*)(mr + 64) = *(const LAS u32x4*)(GS + t2 * 136 + 64 + c8); } }
        if (MODE == 1) { bf16* DS = (bf16*)(A.ws + WS_DS) + (size_t)j * 8192;
            *(u32x4*)(DS + t2 * 64 + c8) = *(const LAS u32x4*)(ST + t2 * 72 + c8); *(u32x4*)(DS + (64 + t2) * 64 + c8) = *(const LAS u32x4*)(ST + (64 + t2) * 72 + c8); }
        if (MODE == 0) { float* so = A.out + OUT_GLA_S + ((size_t)(l * 32 + b) * 4 + h) * 8192;
#pragma unroll
            for (int n = 0; n < 4; ++n) *(f32x4*)(so + (16 * n + r) * 128 + 16 * w + q * 4) = S[n]; }
        LDS_BAR();
        SEC_END(23);
    }
#undef GLA_LOAD
#undef GLA_ROW0
#undef GLA_HEAD
}

__device__ __forceinline__ void gla_scan(const Args& A, int l, int gt, int NGT) {
    unsigned* DS32 = (unsigned*)(A.ws + WS_DS); const float* DEC = (const float*)(A.ws + WS_DEC);
    for (int e = gt; e < 32 * 4096; e += NGT) {
        const int bh = e >> 12, p = e & 4095, dk0 = (2 * p) & 63, dv = p >> 5;
        float s0 = 0.f, s1 = 0.f;
        unsigned* dp = DS32 + (size_t)bh * 32 * 4096 + p; const float* dc = DEC + (size_t)bh * 32 * 64 + dk0;
        unsigned wv[32]; f32x2 dd[32];
#pragma unroll
        for (int c = 0; c < 32; ++c) { wv[c] = dp[(size_t)c * 4096]; dd[c] = *(const f32x2*)(dc + c * 64); }
#pragma unroll
        for (int c = 0; c < 32; ++c) { dp[(size_t)c * 4096] = pk2(s0, s1); s0 = dd[c].x * s0 + blo(wv[c]); s1 = dd[c].y * s1 + bhi(wv[c]); }
        float* so = A.out + OUT_GLA_P + ((size_t)(l * 8) * 4 + bh) * 8192;
        so[dk0 * 128 + dv] = s0; so[(dk0 + 1) * 128 + dv] = s1;
    }
}

__device__ __forceinline__ void rg_prefix(const Args& A, int l, int gt, int NGT) {
    const float* CA = (const float*)(A.ws + WS_CA); const float* CU = CA + 8 * 32 * 512; float* HIN = (float*)(A.ws + WS_HIN);
    for (int e = gt; e < 8 * 512; e += NGT) { const int b = e >> 9, ch = e & 511; float ca[32], cu[32];
#pragma unroll
        for (int c = 0; c < 32; ++c) { ca[c] = CA[(b * 32 + c) * 512 + ch]; cu[c] = CU[(b * 32 + c) * 512 + ch]; }
        float h = 0.f;
#pragma unroll
        for (int c = 0; c < 32; ++c) { HIN[(b * 32 + c) * 512 + ch] = h; h = ca[c] * h + cu[c]; }
        A.out[OUT_RG_P + (size_t)(l * 8 + b) * 512 + ch] = h; }
}

__device__ __forceinline__ void rg_item(LAS unsigned char* L, const Args& A, int l, int smp, int b, int c) {
    const int tid = opaque_tid(), w = __builtin_amdgcn_readfirstlane(tid >> 6), lane = tid & 63, r = lane & 15, q = lane >> 4, tl = lane >> 3, oct = lane & 7;
    const int ch0 = w * 64;
    LAS bf16* XR = (LAS bf16*)(L + w * 18432);
    LAS bf16* XCB = XR + 67 * 64;
    const int ntok = smp ? 32 : 64, row0 = smp ? MP + b * 32 : b * 2048 + c * 64, nbt = smp ? 32 : 8;
    const bf16* Z = (const bf16*)(A.ws + WS_Z);
    bf16* LG = (bf16*)(A.ws + WS_H); bf16* UG = LG + (size_t)M * 512;
    float* CA = (float*)(A.ws + WS_CA); float* CU = CA + 8 * 32 * 512;
    const u32x4 z4 = (u32x4){0u, 0u, 0u, 0u};
    u32x4 xh = z4, xv[8];
    if (lane < 24) { const int j = lane >> 3;
        if (c > 0) xh = *(const u32x4*)(Z + (size_t)(row0 - 3 + j) * NZ + 1536 + ch0 + oct * 8);
        else if (smp) { const float* sp = A.in[I_SCV] + ((size_t)(l * 32 + b) * 3 + j) * 512 + ch0 + oct * 8; const f32x4 a0 = *(const f32x4*)sp, a1 = *(const f32x4*)(sp + 4);
            xh.x = pk2(a0.x, a0.y); xh.y = pk2(a0.z, a0.w); xh.z = pk2(a1.x, a1.y); xh.w = pk2(a1.z, a1.w); } }
#pragma unroll
    for (int s = 0; s < 8; ++s) { const int t = s * 8 + tl; xv[s] = (t < ntok) ? *(const u32x4*)(Z + (size_t)(row0 + t) * NZ + 1536 + ch0 + oct * 8) : z4; }
    f32x4 cwv[4][2], cbv[2];
#pragma unroll
    for (int hh = 0; hh < 2; ++hh) { cbv[hh] = *(const f32x4*)(A.in[I_CB] + l * 512 + ch0 + oct * 8 + 4 * hh);
#pragma unroll
        for (int j = 0; j < 4; ++j) cwv[j][hh] = *(const f32x4*)(A.in[I_CW] + (l * 4 + j) * 512 + ch0 + oct * 8 + 4 * hh); }
    const bf16* wrg = (const bf16*)(A.ws + WS_W + (size_t)l * LAYER_W + W_RG) + (size_t)w * 128 * 64;
    bf16x8 Bf[8][2];
#pragma unroll
    for (int n = 0; n < 8; ++n)
#pragma unroll
        for (int ks = 0; ks < 2; ++ks) Bf[n][ks] = *(const bf16x8*)(wrg + (16 * n + r) * 64 + ks * 32 + q * 8);
    float ba_[4], bx_[4], sp_[4], At[4], Ut[4];
#pragma unroll
    for (int n = 0; n < 4; ++n) { const int ch = l * 512 + ch0 + 16 * n + r; ba_[n] = A.in[I_BA][ch]; bx_[n] = A.in[I_BX][ch]; sp_[n] = A.in[I_LAM][ch]; At[n] = 1.f; Ut[n] = 0.f; }
    LDS_BAR();
    if (lane < 24) *(LAS u32x4*)(XR + (lane >> 3) * 64 + oct * 8) = xh;
#pragma unroll
    for (int s = 0; s < 8; ++s) *(LAS u32x4*)(XR + (3 + s * 8 + tl) * 64 + oct * 8) = xv[s];
    LDS_WAIT(); asm volatile("" ::: "memory");
#pragma unroll
    for (int s = 0; s < 8; ++s) { const int t = s * 8 + tl; float xc[8] = {cbv[0].x, cbv[0].y, cbv[0].z, cbv[0].w, cbv[1].x, cbv[1].y, cbv[1].z, cbv[1].w};
#pragma unroll
        for (int j = 0; j < 4; ++j) { float xf[8]; unpack8(*(const LAS u32x4*)(XR + (t + j) * 64 + oct * 8), xf);
            xc[0] += cwv[j][0].x * xf[0]; xc[1] += cwv[j][0].y * xf[1]; xc[2] += cwv[j][0].z * xf[2]; xc[3] += cwv[j][0].w * xf[3];
            xc[4] += cwv[j][1].x * xf[4]; xc[5] += cwv[j][1].y * xf[5]; xc[6] += cwv[j][1].z * xf[6]; xc[7] += cwv[j][1].w * xf[7]; }
        *(LAS u32x4*)(XCB + t * 72 + oct * 8) = pack8(xc); }
    if (smp || c == 31) {
#pragma unroll
        for (int j = 0; j < 3; ++j) A.out[(smp ? OUT_CV_S : OUT_CV_P) + ((size_t)(l * nbt + b) * 3 + j) * 512 + ch0 + lane] = bf2f(XR[(ntok + j) * 64 + lane]);
    }
    LDS_WAIT(); asm volatile("" ::: "memory");
#pragma unroll
    for (int n = 0; n < 4; ++n) { const float lam = sp_[n]; sp_[n] = 8.f * (fmaxf(-lam, 0.f) + __logf(1.f + __expf(-fabsf(lam)))); }
    const int nm = ntok >> 4;
    unsigned upk[4][4][2];
#pragma unroll
    for (int m = 0; m < 4; ++m) {
#pragma unroll
        for (int n = 0; n < 4; ++n) { upk[m][n][0] = 0u; upk[m][n][1] = 0u; }
        if (m < nm) {
            f32x4 acc[8];
#pragma unroll
            for (int k = 0; k < 8; ++k) acc[k] = (f32x4){0.f, 0.f, 0.f, 0.f};
#pragma unroll
            for (int ks = 0; ks < 2; ++ks) { const bf16x8 a = *(const LAS bf16x8*)(XCB + (16 * m + r) * 72 + ks * 32 + q * 8);
#pragma unroll
                for (int k = 0; k < 8; ++k) acc[k] = __builtin_amdgcn_mfma_f32_16x16x32_bf16(a, Bf[k][ks], acc[k], 0, 0, 0); }
#pragma unroll
            for (int n = 0; n < 4; ++n) {
                float uv[4]; float Aq = 1.f, Uq = 0.f;
#pragma unroll
                for (int i = 0; i < 4; ++i) { const float p1 = 1.f + __expf(-(acc[n][i] + ba_[n])), p2 = 1.f + __expf(-(acc[4 + n][i] + bx_[n])), pinv = __builtin_amdgcn_rcpf(p1 * p2);
                    const float rr = p2 * pinv, ii = p1 * pinv;
                    const unsigned short lgb = f2bf(-rr * sp_[n]); const float lg = bf2f(lgb);
                    const float a = __expf(lg); const float xcv = bf2f(XCB[(16 * m + 4 * q + i) * 72 + 16 * n + r]);
                    const float u = bf2f(f2bf(__builtin_amdgcn_sqrtf(fmaxf(1.f - a * a, 0.f)) * ii * xcv));
                    XR[(16 * m + 4 * q + i) * 64 + 16 * n + r] = lgb;
                    uv[i] = u; Uq = a * Uq + u; Aq = a * Aq; }
                upk[m][n][0] = pk2(uv[0], uv[1]); upk[m][n][1] = pk2(uv[2], uv[3]);
                { const float A1 = __shfl_up(Aq, 16), U1 = __shfl_up(Uq, 16); if (q >= 1) { Uq = Aq * U1 + Uq; Aq = Aq * A1; } }
                { const float A2 = __shfl_up(Aq, 32), U2 = __shfl_up(Uq, 32); if (q >= 2) { Uq = Aq * U2 + Uq; Aq = Aq * A2; } }
                const float Am = __shfl(Aq, 48 + r), Um = __shfl(Uq, 48 + r);
                Ut[n] = Am * Ut[n] + Um; At[n] = Am * At[n];
            }
        }
    }
    if (!smp && q == 0) {
#pragma unroll
        for (int n = 0; n < 4; ++n) { const int ix = (b * 32 + c) * 512 + ch0 + 16 * n + r; CA[ix] = At[n]; CU[ix] = Ut[n]; } }
    LDS_WAIT(); asm volatile("" ::: "memory");
#pragma unroll
    for (int s = 0; s < 8; ++s) { const int t = s * 8 + tl; if (t < ntok) *(u32x4*)(LG + (size_t)(row0 + t) * 512 + ch0 + oct * 8) = *(const LAS u32x4*)(XR + t * 64 + oct * 8); }
    LDS_WAIT(); asm volatile("" ::: "memory");
#pragma unroll
    for (int m = 0; m < 4; ++m)
#pragma unroll
        for (int n = 0; n < 4; ++n) { LAS bf16* p = XR + (16 * m + 4 * q) * 64 + 16 * n + r;
            p[0] = (bf16)(upk[m][n][0] & 0xffffu); p[64] = (bf16)(upk[m][n][0] >> 16); p[128] = (bf16)(upk[m][n][1] & 0xffffu); p[192] = (bf16)(upk[m][n][1] >> 16); }
    LDS_WAIT(); asm volatile("" ::: "memory");
#pragma unroll
    for (int s = 0; s < 8; ++s) { const int t = s * 8 + tl; if (t < ntok) *(u32x4*)(UG + (size_t)(row0 + t) * 512 + ch0 + oct * 8) = *(const LAS u32x4*)(XR + t * 64 + oct * 8); }
    LDS_BAR();
}

__device__ __forceinline__ void rg_out(const Args& A, int l, int smp, int b, int c) {
    const int tid = opaque_tid(), w = __builtin_amdgcn_readfirstlane(tid >> 6), lane = tid & 63;
    const int ch = w * 64 + lane, ntok = smp ? 32 : 64, row0 = smp ? MP + b * 32 : b * 2048 + c * 64;
    const bf16* Z = (const bf16*)(A.ws + WS_Z); bf16* MIX = (bf16*)(A.ws + WS_MIX);
    const bf16* LG = (const bf16*)(A.ws + WS_H); const bf16* UG = LG + (size_t)M * 512;
    float h = smp ? A.in[I_SRG][(size_t)(l * 32 + b) * 512 + ch] : ((const float*)(A.ws + WS_HIN))[(b * 32 + c) * 512 + ch];
    for (int t0 = 0; t0 < ntok; t0 += 16) {
        bf16 lgv[16], uvv[16], grv[16];
#pragma unroll
        for (int k = 0; k < 16; ++k) { const size_t row = (size_t)(row0 + t0 + k); lgv[k] = LG[row * 512 + ch]; uvv[k] = UG[row * 512 + ch]; grv[k] = Z[row * NZ + 2048 + ch]; }
#pragma unroll
        for (int k = 0; k < 16; ++k) { h = __expf(bf2f(lgv[k])) * h + bf2f(uvv[k]); MIX[(size_t)(row0 + t0 + k) * DM + 512 + ch] = f2bf(h * gelu_tanh(bf2f(grv[k]))); }
    }
    if (smp) A.out[OUT_RG_S + (size_t)(l * 32 + b) * 512 + ch] = h;
}

#define XB_TMO      128
#define XB_XCNT(j)  (256  + 64 * (j))
#define XB_XSUB(j)  (1280 + 64 * (j))
#define XB_XGEN(j)  (2304 + 64 * (j))
#define XB_TOP      3328
#define XB_TOPGEN   3392
#define XCD_BAR_WORDS 3456
#define XB_SPIN_CAP (1u << 18)

__device__ __forceinline__ unsigned xb_ld(unsigned* p)              { return __hip_atomic_load(p, __ATOMIC_RELAXED, __HIP_MEMORY_SCOPE_AGENT); }
__device__ __forceinline__ unsigned xb_add(unsigned* p, unsigned v) { return __hip_atomic_fetch_add(p, v, __ATOMIC_RELAXED, __HIP_MEMORY_SCOPE_AGENT); }
__device__ __forceinline__ unsigned xb_xcc_id() { return (unsigned)__builtin_amdgcn_s_getreg((3 << 11) | 20) & 0xFu; }
#define XB_SPIN(cond, bar) do { unsigned _sp = 0; while (cond) { __builtin_amdgcn_s_sleep(1); \
    if ((++_sp & 255u) == 0u) { if (xb_ld(&(bar)[XB_TMO])) break; if (_sp > XB_SPIN_CAP) { atomicAdd(&(bar)[XB_TMO], 1u); break; } } } } while (0)

struct XcdBarrier {
    unsigned* bar; unsigned x;
    volatile LAS unsigned* st;
};

__device__ __forceinline__ XcdBarrier xcd_barrier_post(unsigned* bar, volatile LAS unsigned* st) {
    XcdBarrier b; b.bar = bar; b.x = xb_xcc_id(); b.st = st;
    if (threadIdx.x == 0) (void)xb_add(&bar[XB_XCNT(b.x)], 1u);
    return b;
}
__device__ __forceinline__ void xcd_barrier_complete(unsigned* bar, unsigned x, unsigned& nloc, unsigned& nx) {
    const unsigned G = gridDim.x * gridDim.y * gridDim.z;
    unsigned sum, cnt, mine, sp = 0u;
    for (;;) {
        sum = 0u; cnt = 0u; mine = 0u;
#pragma unroll
        for (unsigned j = 0; j < 16; ++j) { const unsigned c = xb_ld(&bar[XB_XCNT(j)]); sum += c; cnt += (c > 0u) ? 1u : 0u; mine = (j == x) ? c : mine; }
        if (sum == G) break;
        __builtin_amdgcn_s_sleep(1);
        if ((++sp & 255u) == 0u) { if (xb_ld(&bar[XB_TMO])) break; if (sp > XB_SPIN_CAP) { atomicAdd(&bar[XB_TMO], 1u); break; } }
    }
    nloc = mine > 0u ? mine : 1u; nx = cnt > 0u ? cnt : 1u;
}

__device__ __forceinline__ void xcd_barrier(const XcdBarrier& b) {
    asm volatile("s_waitcnt vmcnt(0)" ::: "memory");
    __syncthreads();
    if (threadIdx.x == 0) {
        unsigned* bar = b.bar;
        __builtin_amdgcn_s_waitcnt(0);
        unsigned nloc = b.st[0], nx = b.st[1];
        if (nloc == 0u) { xcd_barrier_complete(bar, b.x, nloc, nx); b.st[0] = nloc; b.st[1] = nx; }
        const unsigned old = xb_add(&bar[XB_XSUB(b.x)], 1u);
        const unsigned gen = old / nloc;
        if (old + 1u == (gen + 1u) * nloc) {
            __builtin_amdgcn_fence(__ATOMIC_RELEASE, "agent");
            asm volatile("s_waitcnt vmcnt(0)" ::: "memory");
            const unsigned og = xb_add(&bar[XB_TOP], 1u);
            const unsigned tg = og / nx;
            if (og + 1u == (tg + 1u) * nx) xb_add(&bar[XB_TOPGEN], 1u);
            else XB_SPIN(xb_ld(&bar[XB_TOPGEN]) == tg, bar);
            __builtin_amdgcn_fence(__ATOMIC_ACQUIRE, "agent");
            xb_add(&bar[XB_XGEN(b.x)], 1u);
            asm volatile("s_waitcnt vmcnt(0)" ::: "memory");
        } else {
            XB_SPIN(xb_ld(&bar[XB_XGEN(b.x)]) == gen, bar);
            __builtin_amdgcn_fence(__ATOMIC_ACQUIRE, "agent");
            asm volatile("s_waitcnt vmcnt(0)" ::: "memory");
        }
    }
    __syncthreads();
}

__global__ void __launch_bounds__(NTHR) fwd_megakernel(Args A) {
    extern __shared__ __attribute__((aligned(16))) unsigned char lds_raw[];
    cg::grid_group grid = cg::this_grid();
    unsigned long long pb_t0 = 0; if (PROBE_K >= 0) pb_t0 = __builtin_amdgcn_s_memrealtime();
#define PB_SPIN() do { const unsigned long long dt_ = __builtin_amdgcn_s_memrealtime() - pb_t0; const unsigned long long t1_ = __builtin_amdgcn_s_memrealtime(); while (__builtin_amdgcn_s_memrealtime() - t1_ < dt_) __builtin_amdgcn_s_sleep(4); } while (0)
#define SYNC(k) do { if (PROBE_K == (k)) PB_SPIN(); xcd_barrier(xbar); if (PROBE_K >= 0) pb_t0 = __builtin_amdgcn_s_memrealtime(); } while (0)
    LAS unsigned char* L = (LAS unsigned char*)lds_raw;
    if (threadIdx.x < 2) ((volatile LAS unsigned*)(L + LDS_BARW))[threadIdx.x] = 0u;
    __syncthreads();
    if (A.ws == nullptr) grid.sync();
    const XcdBarrier xbar = xcd_barrier_post((unsigned*)A.ws, (volatile LAS unsigned*)(L + LDS_BARW));
    const int G = gridDim.x, blk = blockIdx.x, NGW = G * NWAVES;
#define ROW_LOOP(m) for (int ri_ = 0, m = 0; ri_ < (NGW == 2048 ? (gw < 1024 ? 8 : 9) : (M - gw + NGW - 1) / NGW) && ((m = (NGW == 2048 ? (gw < 1024 ? (ri_ == 0 ? MP + gw : gw * 7 + ri_ - 1) : 7168 + (gw - 1024) * 9 + ri_) : gw + ri_ * NGW)), true); ++ri_)
#define ROWS_IN_FLIGHT 4
#define ROW_PASS2(HAS_H_, XS, PT, HB) do { if (NGW != 2048) { ROW_LOOP(m) row_op<true, HAS_H_>(XS(m), GO + (size_t)m * DM, PT(m), ga, A.out + (size_t)m * DM, gb, (HB) + (size_t)m * DM, lane); } else { \
        if (gw < 1024) { const int ms_ = MP + gw; row_op<true, HAS_H_>(XS(ms_), GO + (size_t)ms_ * DM, PT(ms_), ga, A.out + (size_t)ms_ * DM, gb, (HB) + (size_t)ms_ * DM, lane); } \
        const int nr_ = gw < 1024 ? 7 : 9, r0_ = gw < 1024 ? gw * 7 : 7168 + (gw - 1024) * 9; \
        _Pragma("unroll 1") for (int i_ = 0; i_ < nr_; i_ += ROWS_IN_FLIGHT) { const size_t o_ = (size_t)(r0_ + i_) * DM; row_opN<true, HAS_H_, ROWS_IN_FLIGHT>(XS(r0_ + i_), DM, GO + o_, ga, A.out + o_, gb, (HB) + o_, DM, lane, nr_ - i_); } } } while (0)
#define PHASE_IDS() const int tid = opaque_tid(), lane = tid & 63, wave = __builtin_amdgcn_readfirstlane(tid >> 6), gw = blk * NWAVES + wave; (void)tid; (void)lane; (void)gw
    unsigned char* ws = A.ws;
    bf16* H = (bf16*)(ws + WS_H); bf16* GO = (bf16*)(ws + WS_GO); bf16* Zb = (bf16*)(ws + WS_Z); bf16* MIX = (bf16*)(ws + WS_MIX); bf16* HMID = (bf16*)(ws + WS_BIG);
    float* LR = (float*)(ws + WS_LR);

    {
        PHASE_IDS();
        convert_layer_weights(L, A, 0, gw, NGW, wave, lane, 0, (G == 256) ? 640 : 2944);
        if (G != 256) convert_layer_weights(L, A, 1, gw, NGW, wave, lane);
        const int gt = blk * NTHR + tid, NGT = G * NTHR;
        for (int idx = gt; idx < 2 * 16 * 1024; idx += NGT) { const int l = idx >> 14, j = (idx >> 10) & 15, k = idx & 1023;
            ((bf16*)(ws + WS_W + (size_t)l * LAYER_W + W_LR))[j * 1024 + k] = f2bf(A.in[I_WIN][(size_t)l * DM * DIN + (size_t)k * DIN + 1536 + j]); }
        for (int idx = gt; idx < 2 * 8 * 128 * 64; idx += NGT) { const int l = idx >> 16, g = (idx >> 13) & 7, n = (idx >> 6) & 127, k = idx & 63;
            const float v = n < 64 ? A.in[I_WA][((size_t)(l * 8 + g) * 64 + k) * 64 + n] : A.in[I_WX][((size_t)(l * 8 + g) * 64 + k) * 64 + n - 64];
            ((bf16*)(ws + WS_W + (size_t)l * LAYER_W + W_RG))[(g * 128 + n) * 64 + k] = f2bf(v); }
        f32x4 gz[4], gb[4];
#pragma unroll
        for (int j = 0; j < 4; ++j) gz[j] = (f32x4){0.f, 0.f, 0.f, 0.f};
        load_g(A.in[I_GPRE], lane, gb);
        if (NGW != 2048) { for (int m = gw; m < M; m += NGW) row_op<false, true>(xrow_in(A, m), nullptr, nullptr, gz, nullptr, gb, H + (size_t)m * DM, lane); }
        else {
            _Pragma("unroll 1") for (int k0 = 0; k0 < 8; k0 += 4) { const size_t o_ = (size_t)(gw + 2048 * k0) * DM; row_opN<false, true, 4>(A.in[I_XP] + o_, (size_t)2048 * DM, nullptr, gz, nullptr, gb, H + o_, (size_t)2048 * DM, lane, 4); }
            if (gw < 1024) row_op<false, true>(A.in[I_XS] + (size_t)gw * DM, nullptr, nullptr, gz, nullptr, gb, H + (size_t)(MP + gw) * DM, lane);
        }
    }
    SYNC(0);

#pragma unroll
    for (int l = 0; l < 2; ++l) {
        const bf16* wl = (const bf16*)(ws + WS_W + (size_t)l * LAYER_W);
        {
            const bf16* Hin = (l == 0) ? H : MIX;
            pg8::Gemm g{Hin, wl + W_IN / 2, M, NZ, DM}; pg8::StaticOrder S; S.init(M, NZ, DM, G, blk);
            pg8::EpiBf16<0> E{Zb, NZ, nullptr};
            pg8::gemm_phase<pg8::EpiBf16<0>, pg8::StaticOrder, true, true>(L, g, S, E);
            PHASE_IDS();
            const int r = lane & 15, q = lane >> 4; const bf16* wlr = wl + W_LR / 2;
            const int lr_first = (G == 256) ? 168 : 0, lr_nw = (G - lr_first) * NWAVES;
            for (int grp = (blk >= lr_first ? (blk - lr_first) * NWAVES + wave : M), cnt_ = 0; grp < M / 16 && cnt_ < 64; grp += lr_nw, ++cnt_) {
                f32x4 acc = (f32x4){0.f, 0.f, 0.f, 0.f};
                const bf16* ap = Hin + (size_t)(grp * 16 + r) * DM + q * 8; const bf16* bp = wlr + r * DM + q * 8;
#pragma unroll 8
                for (int k0 = 0; k0 < DM; k0 += 32) { const bf16x8 av = *(const bf16x8*)(ap + k0), bv = *(const bf16x8*)(bp + k0); acc = __builtin_amdgcn_mfma_f32_16x16x32_bf16(av, bv, acc, 0, 0, 0); }
#pragma unroll
                for (int i = 0; i < 4; ++i) LR[(size_t)(grp * 16 + q * 4 + i) * 16 + r] = acc[i];
            }
            if (l == 0 && G == 256 && blk >= 168) convert_layer_weights(L, A, 0, (blk - 168) * NWAVES + wave, 88 * NWAVES, wave, lane, 640, 2944);
        }
        SYNC(1);
        for (int it = blk; it < 1408; it += G) {
            if (it < 256) rg_item(L, A, l, 0, it >> 5, it & 31);
            else if (it < 1280) { continue; }
            else { const int j = it - 1280; gla_item<0>(L, A, l, j >> 2, j & 3, 0); }
        }
        {
            PHASE_IDS(); GlaPipe P; P.hprev = -1; P.jn = -1; P.rl = (f32x2){0.f, 0.f}; P.rk = (u32x4){0u,0u,0u,0u}; P.rv0 = P.rk; P.rv1 = P.rk;
#pragma unroll
            for (int dd = 0; dd < 8; ++dd) P.blr[dd] = 0.f;
            const int nmine = (G == 256 && blk >= 128 && blk < 160) ? 3 : (G == 256 && blk >= 160 && blk < 192) ? 5 : 4;
#define PA_ITEM(k) ((G == 256 && (k) == 4) ? (blk - 32) + 768 : blk + G * (k))
            { const int t = tid >> 3, oct = tid & 7, o8 = oct * 8, j = blk, hn = (j >> 5) & 3; const size_t rown = (size_t)((j >> 7) * 2048 + (j & 31) * 64 + t);
              const bf16* zn = (const bf16*)(ws + WS_Z) + rown * NZ;
              P.rk = *(const u32x4*)(zn + 256 + hn * 64 + o8); P.rv0 = *(const u32x4*)(zn + 512 + hn * 128 + o8); P.rv1 = *(const u32x4*)(zn + 512 + hn * 128 + 64 + o8);
              P.rl = *(const f32x2*)(LR + rown * 16 + oct * 2); }
            for (int k = 0; k < nmine; ++k) { const int j = PA_ITEM(k); if (j >= 1024) break; const int jn = (k + 1 < nmine) ? PA_ITEM(k + 1) : 1024; P.jn = (jn < 1024) ? jn : -1; gla_item<1, true>(L, A, l, j >> 7, (j >> 5) & 3, j & 31, &P); }
        }
        for (int s = blk; s < 160; s += G) if (s >= 128) rg_item(L, A, l, 1, s - 128, 0);
        SYNC(2);
        { PHASE_IDS(); gla_scan(A, l, blk * NTHR + tid, G * NTHR); rg_prefix(A, l, blk * NTHR + tid, G * NTHR); }
        SYNC(3);
        for (int it = blk; it < 256; it += G) rg_out(A, l, 0, it >> 5, it & 31);
        for (int s = blk; s < 160; s += G) if (s >= 128) rg_out(A, l, 1, s - 128, 0);
        gla_loop<2>(L, A, l, blk, G, 1024);
        SYNC(4);
        {
            pg8::Gemm g{MIX, wl + W_OUT / 2, M, DM, DM}; pg8::SplitOrder S; S.init(DM, G, blk, 8);
            pg8::EpiBf16<0> E{GO, DM, (float*)(ws + WS_Z)};
            pg8::gemm_phase<pg8::EpiBf16<0>, pg8::SplitOrder, true, true>(L, g, S, E);
        }
        SYNC(5);
        {
            PHASE_IDS();
            f32x4 ga[4], gb[4]; load_g(A.in[I_GPOST] + l * DM, lane, ga); load_g(A.in[I_GPREFF] + l * DM, lane, gb);
#define XS4(m) ((l == 0) ? xrow_in(A, (m)) : (const float*)(A.out + (size_t)(m) * DM))
#define PT4(m) ((m) >= MP ? (const float*)((const bf16*)(ws + WS_Z) + (size_t)((m) - MP) * DM) : (const float*)nullptr)
            ROW_PASS2(true, XS4, PT4, H);
        }
        SYNC(6);
        {
            pg8::Gemm g{H, wl + W_FF1 / 2, M, FF, DM}; pg8::StaticOrder S; S.init(M, FF, DM, G, blk);
            pg8::EpiBf16<2> E{HMID, FF, nullptr};
            pg8::gemm_phase<pg8::EpiBf16<2>, pg8::StaticOrder, true, true>(L, g, S, E);
            if (l == 0 && G == 256 && blk >= 64) { PHASE_IDS(); convert_layer_weights(L, A, 1, (blk - 64) * NWAVES + wave, 192 * NWAVES, wave, lane); }
        }
        SYNC(7);
        {
            pg8::Gemm g{HMID, wl + W_FF2 / 2, M, DM, FF}; pg8::SplitOrder S; S.init(FF, G, blk, 8);
            pg8::EpiBf16<0> E{GO, DM, (float*)(ws + WS_H)};
            pg8::gemm_phase<pg8::EpiBf16<0>, pg8::SplitOrder, true, true>(L, g, S, E);
        }
        SYNC(8);
        {
            PHASE_IDS();
            f32x4 ga[4], gb[4]; load_g(A.in[I_GPOSTFF] + l * DM, lane, ga); load_g(A.in[I_GPRE] + DM, lane, gb);
#define XS7(m) ((const float*)(A.out + (size_t)(m) * DM))
#define PT7(m) ((m) >= MP ? (const float*)((const bf16*)(ws + WS_H) + (size_t)((m) - MP) * DM) : (const float*)nullptr)
            if (l == 0) { ROW_PASS2(true, XS7, PT7, MIX); SYNC(9); }
            else { ROW_PASS2(false, XS7, PT7, MIX); }
        }
    }
    if (PROBE_K == 9) PB_SPIN();
    if (PROBE_K == 100) { for (int i = 0; i < 20; ++i) xcd_barrier(xbar); }
}

extern "C" void kernel_launch(void* const* d_in, const int* in_sizes, int n_in, void* d_out, int out_size, void* d_ws, size_t ws_size, hipStream_t stream) {
    static int grid_blocks = 0;
    if (grid_blocks == 0) {
        if (n_in != 23 || (size_t)out_size != OUT_TOTAL || ws_size < WS_END) { fprintf(stderr, "kernel_launch: unexpected shapes n_in=%d out=%d ws=%zu\n", n_in, out_size, ws_size); grid_blocks = -1; return; }
        int dev = 0, cus = 0, per_cu = 0;
        hipGetDevice(&dev);
        hipDeviceGetAttribute(&cus, hipDeviceAttributeMultiprocessorCount, dev);
        hipFuncSetAttribute((const void*)fwd_megakernel, hipFuncAttributeMaxDynamicSharedMemorySize, LDS_BYTES);
        hipOccupancyMaxActiveBlocksPerMultiprocessor(&per_cu, (const void*)fwd_megakernel, NTHR, LDS_BYTES);
        if (per_cu < 1) { fprintf(stderr, "kernel_launch: occupancy query says %d blocks/CU\n", per_cu); per_cu = 1; }
        (void)hipGetLastError();
        grid_blocks = cus * per_cu;
    }
    if (grid_blocks < 0) return;
    if (hipMemsetAsync(d_ws, 0, 16384, stream) != hipSuccess) { fprintf(stderr, "kernel_launch: memset failed\n"); return; }
    Args a{};
    for (int i = 0; i < 23; ++i) a.in[i] = (const float*)d_in[i];
    a.out = (float*)d_out; a.ws = (unsigned char*)d_ws;
    void* args[] = {&a};
    hipError_t e = hipLaunchCooperativeKernel((const void*)fwd_megakernel, dim3(grid_blocks), dim3(NTHR), args, LDS_BYTES, stream);
    if (e != hipSuccess) fprintf(stderr, "cooperative launch failed: %s (grid %d)\n", hipGetErrorString(e), grid_blocks);
}
```

```cpp
#include <hip/hip_runtime.h>
#include <hip/hip_cooperative_groups.h>
#include <cstdio>
#include <cstdint>
namespace cg = cooperative_groups;
#define PROBE_K (-1)
#define SEC_BEGIN(k) unsigned long long sec_t0_ = 0; if (PROBE_K == (k)) sec_t0_ = __builtin_amdgcn_s_memrealtime()
#define SEC_MARK(k) do { if (PROBE_K == (k)) sec_t0_ = __builtin_amdgcn_s_memrealtime(); } while (0)
#define SEC_END(k) do { if (PROBE_K == (k)) { const unsigned long long dt_ = __builtin_amdgcn_s_memrealtime() - sec_t0_; const unsigned long long t1_ = __builtin_amdgcn_s_memrealtime(); while (__builtin_amdgcn_s_memrealtime() - t1_ < dt_) __builtin_amdgcn_s_sleep(2); } } while (0)
__device__ __forceinline__ int opaque_tid() { int t = threadIdx.x; asm volatile("" : "+v"(t)); return t; }
namespace pg8 {
#define PG8_LAS __attribute__((address_space(3)))
typedef unsigned short bf16_t;
typedef short bf16x8 __attribute__((ext_vector_type(8)));
typedef float f32x4 __attribute__((ext_vector_type(4)));
typedef unsigned u32x4 __attribute__((ext_vector_type(4)));
constexpr int BM = 256, BK = 64, HALF = 128, HTB = HALF * BK * 2  , STAGE_BYTES = 8 * HTB, NXCD = 8, WGM = 8;

__host__ __device__ __forceinline__ int lds_byte(int r, int c) { const int st = (r >> 4) * 2 + (c >> 5), rr = r & 15, cc = c & 31, ob = rr * 64 + cc * 2; return st * 1024 + (ob ^ (((ob >> 9) & 1) << 5)); }
__host__ __device__ __forceinline__ void stage_rc(int b, int& R, int& C) { const int st = b / 1024, sb = b % 1024, swz = sb ^ (((sb >> 9) & 1) << 5); R = (st >> 1) * 16 + swz / 64; C = (st & 1) * 32 + (swz % 64) / 2; }
__host__ __device__ __forceinline__ int perm32(int rho) { const int n = rho >> 4, i = rho & 15; return 8 * (i >> 2) + 4 * n + (i & 3); }

struct Unit { int pm, pn, k0, nt, ks; };
struct Gemm { const bf16_t* A; const bf16_t* Bt; int M, N, K; };

struct StaticOrder {
    int nM, nN, nwg, G, c, ntf;
    __host__ __device__ void init(int M, int N, int K, int G_, int c_) { nM = M / BM; nN = N / BM; nwg = nM * nN; G = G_; c = c_; ntf = K / BK; }
    __host__ __device__ void map(int wgid, Unit& u) const { { const int q = nwg / NXCD, r = nwg % NXCD, xcd = wgid % NXCD, off = wgid / NXCD; wgid = (xcd < r ? xcd * (q + 1) : r * (q + 1) + (xcd - r) * q) + off; }
        const int nig = WGM * nN, gid = wgid / nig, fm = gid * WGM, gsz = (nM - fm) < WGM ? (nM - fm) : WGM;
        u.pm = fm + ((wgid % nig) % gsz); u.pn = (wgid % nig) / gsz; u.k0 = 0; u.nt = ntf; u.ks = -1; }
    __host__ __device__ bool next(int i, Unit& u) const { const long L = (long)i * G + c; if (L >= nwg) return false; map((int)L, u); return true; }
    __device__ __forceinline__ void a_ready(const Unit&) const {}
    __device__ __forceinline__ void done(const Unit&) const {}
};
struct SplitOrder {
    StaticOrder P; int nsplit, ntsub;
    __host__ __device__ void init(int K, int G_, int c_, int nsplit_) { P.init(16384, 1024, K, G_, c_); nsplit = nsplit_; ntsub = K / BK / nsplit_; }
    __host__ __device__ bool next(int i, Unit& u) const { const long L = (long)i * P.G + P.c; if (L < 256) { P.map((int)L, u); return true; }
        const int s = (int)(L - 256); if (s >= 16 * nsplit) return false; const int su = s / nsplit, ks = s % nsplit; u.pm = 64 + (su >> 2); u.pn = su & 3; u.k0 = ks * ntsub * BK; u.nt = ntsub; u.ks = ks; return true; }
    __device__ __forceinline__ void a_ready(const Unit&) const {}
    __device__ __forceinline__ void done(const Unit&) const {}
};


__device__ __forceinline__ unsigned cvt_pk_bf16(float lo, float hi) { unsigned r; asm volatile("v_cvt_pk_bf16_f32 %0, %1, %2" : "=v"(r) : "v"(lo), "v"(hi)); return r; }
template <int ACT> struct EpiBf16 {
    static constexpr bool PERM = true, AFTER_DRAIN = false;
    bf16_t* O; int ldc; float* part;
    __device__ __forceinline__ void operator()(const f32x4 (&acc)[2][2][4][2], const Unit& u, int wr, int wc, int fr, int fq) const {
        const int row0 = u.pm * BM + wr * 64 + fr; const int col0 = u.pn * BM + wc * 32 + 8 * fq;
        if (u.ks >= 0) {
#pragma unroll
            for (int ai = 0; ai < 2; ++ai)
#pragma unroll
                for (int m = 0; m < 4; ++m) { bf16_t* rowp = (bf16_t*)part + ((size_t)u.ks << 20) + (size_t)(row0 - 16384 + ai * HALF + m * 16) * 1024 + col0;
#pragma unroll
                    for (int bj = 0; bj < 2; ++bj) { const f32x4 v0 = acc[ai][bj][m][0], v1 = acc[ai][bj][m][1]; u32x4 w; w.x = cvt_pk_bf16(v0[0], v0[1]); w.y = cvt_pk_bf16(v0[2], v0[3]); w.z = cvt_pk_bf16(v1[0], v1[1]); w.w = cvt_pk_bf16(v1[2], v1[3]); *(u32x4*)(rowp + bj * HALF) = w; } }
            return;
        }
#pragma unroll
        for (int ai = 0; ai < 2; ++ai)
#pragma unroll
            for (int m = 0; m < 4; ++m) { bf16_t* rowp = O + (size_t)(row0 + ai * HALF + m * 16) * ldc + col0;
#pragma unroll
                for (int bj = 0; bj < 2; ++bj) { f32x4 v0 = acc[ai][bj][m][0], v1 = acc[ai][bj][m][1];
                    if (ACT == 2) {
#pragma unroll
                        for (int e = 0; e < 4; ++e) { float a = fmaxf(v0[e], 0.f), b = fmaxf(v1[e], 0.f); v0[e] = a * a; v1[e] = b * b; }
                    }
                    u32x4 w; w.x = cvt_pk_bf16(v0[0], v0[1]); w.y = cvt_pk_bf16(v0[2], v0[3]); w.z = cvt_pk_bf16(v1[0], v1[1]); w.w = cvt_pk_bf16(v1[2], v1[3]);
                    *(u32x4*)(rowp + bj * HALF) = w; } }
    }
};

template <class Epi, class Sched, bool ALIGN_EPI = false, bool SP2 = false>
__device__ __forceinline__ void gemm_phase(PG8_LAS unsigned char* lds, const Gemm g, const Sched& S, const Epi& E) {
    const int tid = opaque_tid(), wid = __builtin_amdgcn_readfirstlane(tid >> 6), lane = tid & 63, wr = wid >> 2, wc = wid & 3, fr = lane & 15, fq = lane >> 4;
    const int K = g.K;
    unsigned voffA[2], voffB[2];
#pragma unroll
    for (int i = 0; i < 2; ++i) { int R, C; stage_rc(tid * 16 + i * 8192, R, C); const int Rb = Epi::PERM ? ((R & ~31) + perm32(R & 31)) : R;
        voffA[i] = (unsigned)(R * K + C) * 2u; voffB[i] = (unsigned)(Rb * K + C) * 2u; }
    const size_t kstep = (size_t)(BK * 2);
    const size_t hstep = (size_t)HALF * K * 2;
    const size_t tstep = 2 * hstep;
    const unsigned ldsw = (unsigned)wid * 1024u;
    const int aoff = lds_byte(wr * 64 + fr, fq * 8), boff = lds_byte(wc * 32 + fr, fq * 8);
#define PG8_SA(b, h) (((b) * 2 + (h)) * HTB)
#define PG8_SB(b, h) ((4 + (b) * 2 + (h)) * HTB)
#define PG8_STAGE(bufoff, gbase, voff) do { _Pragma("unroll") for (int _i = 0; _i < 2; ++_i) \
        __builtin_amdgcn_global_load_lds((const unsigned*)((const char*)(gbase) + (voff)[_i]), (PG8_LAS unsigned*)(lds + (bufoff) + ldsw + _i * 8192), 16, 0, 0); } while (0)
#define PG8_LDA(dst, b, h) do { _Pragma("unroll") for (int m = 0; m < 4; ++m) _Pragma("unroll") for (int k = 0; k < 2; ++k) dst[m][k] = *(const PG8_LAS bf16x8*)(lds + PG8_SA(b, h) + aoff + m * 2048 + k * 1024); } while (0)
#define PG8_LDB(dst, b, h) do { _Pragma("unroll") for (int n = 0; n < 2; ++n) _Pragma("unroll") for (int k = 0; k < 2; ++k) dst[n][k] = *(const PG8_LAS bf16x8*)(lds + PG8_SB(b, h) + boff + n * 2048 + k * 1024); } while (0)
#define PG8_MMA(ai, bj, At, Bt) do { __builtin_amdgcn_s_setprio(1); _Pragma("unroll") for (int m = 0; m < 4; ++m) _Pragma("unroll") for (int n = 0; n < 2; ++n) _Pragma("unroll") for (int k = 0; k < 2; ++k) \
        acc[ai][bj][m][n] = __builtin_amdgcn_mfma_f32_16x16x32_bf16(Bt[n][k], At[m][k], acc[ai][bj][m][n], 0, 0, 0); __builtin_amdgcn_s_setprio(0); } while (0)
#define PG8_WAIT_V(n) asm volatile("s_waitcnt vmcnt(" #n ")" ::: "memory")
#define PG8_WAIT_L(n) asm volatile("s_waitcnt lgkmcnt(" #n ")" ::: "memory")
#define PG8_BAR __builtin_amdgcn_s_barrier()
#define PG8_SCHED __builtin_amdgcn_sched_barrier(0)
    Unit cur, nxt; int ui = 0;
    if (!S.next(0, cur)) return;
    f32x4 acc[2][2][4][2];
#pragma unroll
    for (int a = 0; a < 2; ++a)
#pragma unroll
        for (int b = 0; b < 2; ++b)
#pragma unroll
            for (int m = 0; m < 4; ++m)
#pragma unroll
                for (int n = 0; n < 2; ++n) acc[a][b][m][n] = (f32x4){0.f, 0.f, 0.f, 0.f};
    bf16x8 At[4][2], B0[2][2], B1[2][2];
    const char* cA = (const char*)g.A + (size_t)cur.pm * tstep + (size_t)cur.k0 * 2; const char* cB = (const char*)g.Bt + (size_t)cur.pn * tstep + (size_t)cur.k0 * 2;
    S.a_ready(cur);
    if constexpr (SP2) {
        PG8_STAGE(PG8_SB(0, 0), cB, voffB); PG8_STAGE(PG8_SB(0, 1), cB + hstep, voffB); PG8_STAGE(PG8_SA(0, 0), cA, voffA); PG8_STAGE(PG8_SA(0, 1), cA + hstep, voffA);
        if (wr == 1) PG8_BAR;
        PG8_WAIT_V(2); PG8_BAR;
        PG8_STAGE(PG8_SB(1, 0), cB + kstep, voffB); PG8_STAGE(PG8_SA(1, 0), cA + kstep, voffA); PG8_STAGE(PG8_SB(1, 1), cB + hstep + kstep, voffB);
        PG8_WAIT_V(6); PG8_BAR;
    } else {
        PG8_STAGE(PG8_SB(0, 0), cB, voffB); PG8_STAGE(PG8_SA(0, 0), cA, voffA); PG8_STAGE(PG8_SB(0, 1), cB + hstep, voffB); PG8_STAGE(PG8_SA(0, 1), cA + hstep, voffA);
        if (wr == 1) PG8_BAR;
        PG8_WAIT_V(4); PG8_BAR;
        PG8_STAGE(PG8_SB(1, 0), cB + kstep, voffB); PG8_STAGE(PG8_SA(1, 0), cA + kstep, voffA); PG8_STAGE(PG8_SB(1, 1), cB + hstep + kstep, voffB);
        PG8_WAIT_V(6); PG8_BAR;
    }
    for (;;) {
        const bool has_next = S.next(ui + 1, nxt);
        const char* nA = has_next ? (const char*)g.A + (size_t)nxt.pm * tstep + (size_t)nxt.k0 * 2 : cA; const char* nB = has_next ? (const char*)g.Bt + (size_t)nxt.pn * tstep + (size_t)nxt.k0 * 2 : cB;
        const int nt = cur.nt;
        for (int t = 0; t < nt; t += 2) {
            const bool last = (t == nt - 2);
            const char* a1 = cA + (size_t)(t + 1) * kstep;
            const char* a2 = last ? nA : cA + (size_t)(t + 2) * kstep; const char* b2 = last ? nB : cB + (size_t)(t + 2) * kstep;
            const char* a3 = a2 + kstep; const char* b3 = b2 + kstep;
            if (last && has_next) S.a_ready(nxt);
            if constexpr (SP2) {
            PG8_LDB(B0, 0, 0); PG8_LDB(B1, 0, 1); PG8_SCHED; PG8_LDA(At, 0, 0); PG8_STAGE(PG8_SA(1, 1), a1 + hstep, voffA);
            PG8_WAIT_V(8); PG8_WAIT_L(0); PG8_BAR; PG8_MMA(0, 0, At, B0); PG8_MMA(0, 1, At, B1); PG8_BAR; PG8_SCHED;
            PG8_LDA(At, 0, 1); PG8_STAGE(PG8_SB(0, 0), b2, voffB); PG8_STAGE(PG8_SB(0, 1), b2 + hstep, voffB); PG8_STAGE(PG8_SA(0, 0), a2, voffA);
            PG8_WAIT_V(8); PG8_WAIT_L(0); PG8_BAR; PG8_MMA(1, 0, At, B0); PG8_MMA(1, 1, At, B1); PG8_BAR; PG8_SCHED;
            PG8_LDB(B0, 1, 0); PG8_LDB(B1, 1, 1); PG8_SCHED; PG8_LDA(At, 1, 0); PG8_STAGE(PG8_SA(0, 1), a2 + hstep, voffA);
            PG8_WAIT_V(8); PG8_WAIT_L(0); PG8_BAR; PG8_MMA(0, 0, At, B0); PG8_MMA(0, 1, At, B1); PG8_BAR; PG8_SCHED;
            PG8_LDA(At, 1, 1); PG8_STAGE(PG8_SB(1, 0), b3, voffB); PG8_STAGE(PG8_SB(1, 1), b3 + hstep, voffB); PG8_STAGE(PG8_SA(1, 0), a3, voffA);
            PG8_WAIT_V(8); PG8_WAIT_L(0); PG8_BAR; PG8_MMA(1, 0, At, B0); PG8_MMA(1, 1, At, B1); PG8_BAR; PG8_SCHED;
            } else {
            PG8_LDB(B0, 0, 0); PG8_SCHED; PG8_LDA(At, 0, 0); PG8_STAGE(PG8_SA(1, 1), a1 + hstep, voffA);
            PG8_WAIT_L(8); PG8_BAR; PG8_WAIT_L(0); PG8_MMA(0, 0, At, B0); PG8_BAR; PG8_SCHED;
            PG8_LDB(B1, 0, 1); PG8_STAGE(PG8_SB(0, 0), b2, voffB);
            PG8_BAR; PG8_WAIT_L(0); PG8_MMA(0, 1, At, B1); PG8_BAR;
            PG8_LDA(At, 0, 1); PG8_STAGE(PG8_SA(0, 0), a2, voffA);
            PG8_BAR; PG8_WAIT_L(0); PG8_MMA(1, 0, At, B0); PG8_BAR; PG8_SCHED;
            PG8_STAGE(PG8_SB(0, 1), b2 + hstep, voffB);
            PG8_WAIT_V(6); PG8_BAR; PG8_MMA(1, 1, At, B1); PG8_BAR;
            PG8_LDB(B0, 1, 0); PG8_SCHED; PG8_LDA(At, 1, 0); PG8_STAGE(PG8_SA(0, 1), a2 + hstep, voffA);
            PG8_WAIT_L(8); PG8_BAR; PG8_WAIT_L(0); PG8_MMA(0, 0, At, B0); PG8_BAR; PG8_SCHED;
            PG8_LDB(B1, 1, 1); PG8_STAGE(PG8_SB(1, 0), b3, voffB);
            PG8_BAR; PG8_WAIT_L(0); PG8_MMA(0, 1, At, B1); PG8_BAR;
            PG8_LDA(At, 1, 1); PG8_STAGE(PG8_SA(1, 0), a3, voffA);
            PG8_BAR; PG8_WAIT_L(0); PG8_MMA(1, 0, At, B0); PG8_BAR; PG8_SCHED;
            PG8_STAGE(PG8_SB(1, 1), b3 + hstep, voffB);
            PG8_WAIT_V(6); PG8_BAR; PG8_MMA(1, 1, At, B1); PG8_BAR;
            }
        }
        if constexpr (ALIGN_EPI) { if (wr == 0) PG8_BAR; }
        if constexpr (!Epi::AFTER_DRAIN) { E(acc, cur, wr, wc, fr, fq); S.done(cur); }
        if (!has_next) break;
#pragma unroll
        for (int a = 0; a < 2; ++a)
#pragma unroll
            for (int b = 0; b < 2; ++b)
#pragma unroll
                for (int m = 0; m < 4; ++m)
#pragma unroll
                    for (int n = 0; n < 2; ++n) acc[a][b][m][n] = (f32x4){0.f, 0.f, 0.f, 0.f};
        cur = nxt; cA = nA; cB = nB; ++ui;
        if constexpr (ALIGN_EPI) { if (wr == 1) PG8_BAR; }
    }
    PG8_WAIT_V(0);
    if constexpr (!ALIGN_EPI) { if (wr == 0) PG8_BAR; }
    PG8_BAR;
    if constexpr (Epi::AFTER_DRAIN) { E.fused(acc, cur, wr, wc, fr, fq, lds, wid, lane); S.done(cur); }
#undef PG8_SA
#undef PG8_SB
#undef PG8_STAGE
#undef PG8_LDA
#undef PG8_LDB
#undef PG8_MMA
#undef PG8_WAIT_V
#undef PG8_WAIT_L
#undef PG8_BAR
#undef PG8_SCHED
}
}

#define LAS __attribute__((address_space(3)))
typedef unsigned short bf16;
typedef float f32x4 __attribute__((ext_vector_type(4)));
typedef float f32x2 __attribute__((ext_vector_type(2)));
typedef short bf16x8 __attribute__((ext_vector_type(8)));
typedef unsigned u32x4 __attribute__((ext_vector_type(4)));
typedef unsigned u32x2 __attribute__((ext_vector_type(2)));

constexpr int NWAVES = 8, NTHR = 512;
constexpr int DM = 1024, MP = 16384, MS = 1024, M = MP + MS, DIN = 2576, NZ = 2560, FF = 4096;
constexpr float EPS = 1e-6f;
constexpr size_t MiB = 1u << 20;
constexpr size_t W_IN = 0, W_OUT = W_IN + (size_t)NZ * DM * 2, W_FF1 = W_OUT + (size_t)DM * DM * 2, W_FF2 = W_FF1 + (size_t)FF * DM * 2,
                 W_LR = W_FF2 + (size_t)FF * DM * 2, W_RG = W_LR + 16 * DM * 2, LAYER_W = W_RG + 8 * 128 * 64 * 2;
constexpr size_t WS_W = 1 * MiB, WS_H = 49 * MiB, WS_GO = 83 * MiB, WS_BIG = 117 * MiB, WS_Z = WS_BIG, WS_MIX = WS_BIG + 85 * MiB, WS_DS = WS_BIG + 119 * MiB, WS_DEC = WS_BIG + 135 * MiB, WS_LR = 253 * MiB, WS_CA = 254 * MiB + 256 * 1024, WS_HIN = 255 * MiB + 256 * 1024, WS_END = 256 * MiB;
static_assert(WS_W + 2 * LAYER_W <= WS_H, "weights fit");
static_assert((size_t)M * DM * 2 == 34 * MiB && (size_t)M * NZ * 2 == 85 * MiB && (size_t)M * FF * 2 == 136 * MiB, "sizes");
constexpr size_t OUT_GLA_P = 17825792, OUT_RG_P = 18350080, OUT_CV_P = 18358272, OUT_GLA_S = 18382848, OUT_RG_S = 20480000, OUT_CV_S = 20512768, OUT_TOTAL = 20611072;
constexpr int LDS_BYTES = 147456 + 256, LDS_BARW = 147456;

struct Args { const float* in[23]; float* out; unsigned char* ws; };
enum { I_XP = 0, I_XS, I_SGLA, I_SRG, I_SCV, I_GPRE, I_WIN, I_WLR2, I_BLR, I_GNORM, I_CW, I_CB, I_WA, I_BA, I_WX, I_BX, I_LAM, I_WOUT, I_GPOST, I_GPREFF, I_WFF1, I_WFF2, I_GPOSTFF };

#define LDS_BAR() do { asm volatile("s_waitcnt lgkmcnt(0)" ::: "memory"); __builtin_amdgcn_s_barrier(); asm volatile("" ::: "memory"); } while (0)
#define LDS_WAIT() asm volatile("s_waitcnt lgkmcnt(0)" ::: "memory")

__device__ __forceinline__ unsigned pk2(float lo, float hi) { return pg8::cvt_pk_bf16(lo, hi); }
__device__ __forceinline__ unsigned short f2bf(float f) { return (unsigned short)(pk2(f, 0.f) & 0xffffu); }
__device__ __forceinline__ float bf2f(unsigned short u) { return __uint_as_float(((unsigned)u) << 16); }
__device__ __forceinline__ float blo(unsigned w) { return __uint_as_float(w << 16); }
__device__ __forceinline__ float bhi(unsigned w) { return __uint_as_float(w & 0xffff0000u); }
__device__ __forceinline__ void unpack8(u32x4 v, float (&f)[8]) { f[0] = blo(v.x); f[1] = bhi(v.x); f[2] = blo(v.y); f[3] = bhi(v.y); f[4] = blo(v.z); f[5] = bhi(v.z); f[6] = blo(v.w); f[7] = bhi(v.w); }
__device__ __forceinline__ u32x4 pack8(const float (&f)[8]) { u32x4 o; o.x = pk2(f[0], f[1]); o.y = pk2(f[2], f[3]); o.z = pk2(f[4], f[5]); o.w = pk2(f[6], f[7]); return o; }
__device__ __forceinline__ float wave_sum(float v) {
#pragma unroll
    for (int o = 1; o < 64; o <<= 1) v += __shfl_xor(v, o);
    return v;
}
__device__ __forceinline__ float sigm(float x) { return __builtin_amdgcn_rcpf(1.f + __expf(-x)); }
__device__ __forceinline__ float gelu_tanh(float x) { const float u = 0.7978845608028654f * (x + 0.044715f * x * x * x); const float e = __expf(-2.f * fabsf(u)); float th = (1.f - e) * __builtin_amdgcn_rcpf(1.f + e); th = u < 0.f ? -th : th; return 0.5f * x * (1.f + th); }
__device__ __forceinline__ const float* xrow_in(const Args& A, int m) { return m < MP ? A.in[I_XP] + (size_t)m * DM : A.in[I_XS] + (size_t)(m - MP) * DM; }

__device__ __forceinline__ void p0_transpose_item(const float* W, int ldw, int col0, int K, bf16* WT, int row_off, LAS float* scr, int kb, int nb, int lane) {
    const int k0 = 64 * kb, n0 = 64 * nb;
    f32x4 v[16];
#pragma unroll
    for (int i = 0; i < 16; ++i) v[i] = *(const f32x4*)(W + (size_t)(k0 + 4 * i + (lane >> 4)) * ldw + col0 + n0 + (lane & 15) * 4);
#pragma unroll
    for (int i = 0; i < 16; ++i) { LAS float* d = scr + (4 * i + (lane >> 4)) * 65 + (lane & 15) * 4; d[0] = v[i].x; d[1] = v[i].y; d[2] = v[i].z; d[3] = v[i].w; }
    LDS_WAIT(); asm volatile("" ::: "memory");
    const int c = lane & 7;
#pragma unroll
    for (int j = 0; j < 8; ++j) { const int n = (lane >> 3) + 8 * j; const LAS float* s = scr + (8 * c) * 65 + n;
        u32x4 o; o.x = pk2(s[0 * 65], s[1 * 65]); o.y = pk2(s[2 * 65], s[3 * 65]); o.z = pk2(s[4 * 65], s[5 * 65]); o.w = pk2(s[6 * 65], s[7 * 65]);
        *(u32x4*)(WT + (size_t)(row_off + n0 + n) * K + k0 + 8 * c) = o; }
    LDS_WAIT(); asm volatile("" ::: "memory");
}

__device__ __forceinline__ void convert_layer_weights(LAS unsigned char* L, const Args& A, int l, int w0, int nw, int wave, int lane, int r_begin = 0, int r_end = 2944) {
    LAS float* scr = (LAS float*)(L + wave * 16640);
    bf16* wl = (bf16*)(A.ws + WS_W + (size_t)l * LAYER_W);
    const float* win = A.in[I_WIN] + (size_t)l * DM * DIN;
    for (int it = r_begin + w0; it < r_end; it += nw) { int r = it;
        if (r < 384) { p0_transpose_item(win, DIN, 0, DM, wl + W_IN / 2, 0, scr, r / 24, r % 24, lane); }
        else if (r < 640) { r -= 384; p0_transpose_item(win, DIN, 1552, DM, wl + W_IN / 2, 1536, scr, r / 16, r % 16, lane); }
        else if (r < 896) { r -= 640; p0_transpose_item(A.in[I_WOUT] + (size_t)l * DM * DM, DM, 0, DM, wl + W_OUT / 2, 0, scr, r / 16, r % 16, lane); }
        else if (r < 1920) { r -= 896; p0_transpose_item(A.in[I_WFF1] + (size_t)l * DM * FF, FF, 0, DM, wl + W_FF1 / 2, 0, scr, r / 64, r % 64, lane); }
        else { r -= 1920; p0_transpose_item(A.in[I_WFF2] + (size_t)l * FF * DM, DM, 0, FF, wl + W_FF2 / 2, 0, scr, r / 16, r % 16, lane); }
    }
}

template <bool HAS_GO, bool HAS_H>
__device__ __forceinline__ void row_op(const float* xs, const bf16* go, const float* part, const f32x4 (&ga)[4], float* xo, const f32x4 (&gb)[4], bf16* hb, int lane) {
    f32x4 x[4];
#pragma unroll
    for (int j = 0; j < 4; ++j) x[j] = *(const f32x4*)(xs + 4 * lane + 256 * j);
    if (HAS_GO) {
        f32x4 f[4]; float ss = 0.f;
#pragma unroll
        for (int j = 0; j < 4; ++j) {
            if (part) { const bf16* pb = (const bf16*)part; f[j] = (f32x4){0.f, 0.f, 0.f, 0.f};
#pragma unroll
                for (int ks = 0; ks < 8; ++ks) { const u32x2 wv = *(const u32x2*)(pb + ((size_t)ks << 20) + 4 * lane + 256 * j); f[j] = f[j] + (f32x4){blo(wv.x), bhi(wv.x), blo(wv.y), bhi(wv.y)}; } }
            else { const u32x2 wv = *(const u32x2*)(go + 4 * lane + 256 * j); f[j] = (f32x4){blo(wv.x), bhi(wv.x), blo(wv.y), bhi(wv.y)}; }
            ss += (f[j].x * f[j].x + f[j].y * f[j].y) + (f[j].z * f[j].z + f[j].w * f[j].w); }
        const float rstd = rsqrtf(wave_sum(ss) * (1.f / DM) + EPS);
#pragma unroll
        for (int j = 0; j < 4; ++j) { x[j] = x[j] + f[j] * rstd * ga[j]; *(f32x4*)(xo + 4 * lane + 256 * j) = x[j]; }
    }
    if (HAS_H) {
        float s2 = 0.f;
#pragma unroll
        for (int j = 0; j < 4; ++j) s2 += (x[j].x * x[j].x + x[j].y * x[j].y) + (x[j].z * x[j].z + x[j].w * x[j].w);
        const float r2 = rsqrtf(wave_sum(s2) * (1.f / DM) + EPS);
#pragma unroll
        for (int j = 0; j < 4; ++j) { const f32x4 hv = x[j] * r2 * gb[j]; u32x2 o; o.x = pk2(hv.x, hv.y); o.y = pk2(hv.z, hv.w); *(u32x2*)(hb + 4 * lane + 256 * j) = o; }
    }
}
template <bool HAS_GO, bool HAS_H, int NR>
__device__ __forceinline__ void row_opN(const float* xs, size_t xrs, const bf16* go, const f32x4 (&ga)[4], float* xo, const f32x4 (&gb)[4], bf16* hb, size_t rs, int lane, int nv) {
    f32x4 xv[NR][4]; u32x2 gv[NR][4];
#pragma unroll
    for (int rr = 0; rr < NR; ++rr) if (rr < nv) {
#pragma unroll
        for (int j = 0; j < 4; ++j) { xv[rr][j] = __builtin_nontemporal_load((const f32x4*)(xs + rr * xrs + 4 * lane + 256 * j)); if (HAS_GO) gv[rr][j] = __builtin_nontemporal_load((const u32x2*)(go + rr * rs + 4 * lane + 256 * j)); }
    }
#pragma unroll
    for (int rr = 0; rr < NR; ++rr) if (rr < nv) {
        f32x4 x[4]; float s2 = 0.f;
        if (HAS_GO) { f32x4 f[4]; float ss = 0.f;
#pragma unroll
            for (int j = 0; j < 4; ++j) { const u32x2 wv = gv[rr][j]; f[j] = (f32x4){blo(wv.x), bhi(wv.x), blo(wv.y), bhi(wv.y)}; ss += (f[j].x * f[j].x + f[j].y * f[j].y) + (f[j].z * f[j].z + f[j].w * f[j].w); }
            const float rstd = rsqrtf(wave_sum(ss) * (1.f / DM) + EPS);
#pragma unroll
            for (int j = 0; j < 4; ++j) { x[j] = xv[rr][j] + f[j] * rstd * ga[j]; __builtin_nontemporal_store(x[j], (f32x4*)(xo + rr * rs + 4 * lane + 256 * j)); }
        } else {
#pragma unroll
            for (int j = 0; j < 4; ++j) x[j] = xv[rr][j];
        }
        if (HAS_H) {
#pragma unroll
            for (int j = 0; j < 4; ++j) s2 += (x[j].x * x[j].x + x[j].y * x[j].y) + (x[j].z * x[j].z + x[j].w * x[j].w);
            const float r2 = rsqrtf(wave_sum(s2) * (1.f / DM) + EPS);
#pragma unroll
            for (int j = 0; j < 4; ++j) { const f32x4 hv = x[j] * r2 * gb[j]; u32x2 o; o.x = pk2(hv.x, hv.y); o.y = pk2(hv.z, hv.w); *(u32x2*)(hb + rr * rs + 4 * lane + 256 * j) = o; } }
    }
}
__device__ __forceinline__ void load_g(const float* g, int lane, f32x4 (&v)[4]) {
#pragma unroll
    for (int j = 0; j < 4; ++j) v[j] = *(const f32x4*)(g + 4 * lane + 256 * j);
}

template <int MODE>
__device__ __forceinline__ void gla_item(LAS unsigned char* L, const Args& A, int l, int b, int h, int c) {
    const int tid = opaque_tid(), w = __builtin_amdgcn_readfirstlane(tid >> 6), lane = tid & 63, r = lane & 15, q = lane >> 4;
    const int t = tid >> 3, oct = tid & 7, o8 = oct * 8, tsw = t ^ (oct << 3);
    LAS bf16* QT = (LAS bf16*)(L + 0); LAS bf16* KT = (LAS bf16*)(L + 9216); LAS bf16* KHT = (LAS bf16*)(L + 18432); LAS bf16* ATT = (LAS bf16*)(L + 27648);
    LAS bf16* VT = (LAS bf16*)(L + 36864); LAS bf16* ST = (LAS bf16*)(L + 55296); LAS bf16* GS = (LAS bf16*)(L + 73728);
    LAS float* LRS = (LAS float*)(L + 91136); LAS float* WL = (LAS float*)(L + 95232); LAS float* SEG = (LAS float*)(L + 99328);
    LAS float* SSQ = (LAS float*)(L + 101376); LAS float* BL = (LAS float*)(L + 101888);
    constexpr bool SMP = (MODE == 0), DO_OUT = (MODE != 1), DO_S = (MODE != 2);
    const int ntok = SMP ? 32 : 64, row0 = SMP ? MP + b * 32 : b * 2048 + c * 64;
    const int item = (b * 4 + h) * 32 + c;
    const bf16* Z = (const bf16*)(A.ws + WS_Z); bf16* MIX = (bf16*)(A.ws + WS_MIX); const float* LR = (const float*)(A.ws + WS_LR);
    bf16* DS = (bf16*)(A.ws + WS_DS) + (size_t)item * 8192; float* DEC = (float*)(A.ws + WS_DEC) + (size_t)item * 64;
    const bool valid = t < ntok;
    const u32x4 z4 = (u32x4){0u, 0u, 0u, 0u};
    const bf16* zr = Z + (size_t)(row0 + t) * NZ;
    u32x4 rq = z4, rk, rv0, rv1, rg0 = z4, rg1 = z4; f32x2 rl;
    rk = valid ? *(const u32x4*)(zr + 256 + h * 64 + o8) : z4;
    rv0 = valid ? *(const u32x4*)(zr + 512 + h * 128 + o8) : z4; rv1 = valid ? *(const u32x4*)(zr + 512 + h * 128 + 64 + o8) : z4;
    rl = valid ? *(const f32x2*)(LR + (size_t)(row0 + t) * 16 + oct * 2) : (f32x2){0.f, 0.f};
    if (DO_OUT) { rq = valid ? *(const u32x4*)(zr + h * 64 + o8) : z4; rg0 = valid ? *(const u32x4*)(zr + 1024 + h * 128 + o8) : z4; rg1 = valid ? *(const u32x4*)(zr + 1024 + h * 128 + 64 + o8) : z4; }
    f32x4 S[4];
#pragma unroll
    for (int n = 0; n < 4; ++n) S[n] = (f32x4){0.f, 0.f, 0.f, 0.f};
    if (MODE == 0) { const float* s0 = A.in[I_SGLA] + ((size_t)(l * 32 + b) * 4 + h) * 8192;
#pragma unroll
        for (int n = 0; n < 4; ++n) S[n] = *(const f32x4*)(s0 + (16 * n + r) * 128 + 16 * w + q * 4);
#pragma unroll
        for (int n = 0; n < 4; ++n)
#pragma unroll
            for (int i = 0; i < 4; ++i) ST[(16 * w + q * 4 + i) * 72 + 16 * n + r] = f2bf(S[n][i]);
    }
    if (MODE == 2) {
#pragma unroll
        for (int k = 0; k < 2; ++k) { const int idx = tid + 512 * k, row = idx >> 3, c8 = (idx & 7) * 8; *(LAS u32x4*)(ST + row * 72 + c8) = *(const u32x4*)(DS + row * 64 + c8); }
    }
    { const int idx = tid * 2, j = idx >> 6, d = idx & 63; const float* src = A.in[I_WLR2] + (size_t)(l * 16 + j) * 256 + h * 64 + d; WL[j * 64 + d] = src[0]; WL[j * 64 + d + 1] = src[1]; }
    float blr[8];
#pragma unroll
    for (int dd = 0; dd < 8; ++dd) blr[dd] = A.in[I_BLR][l * 256 + h * 64 + o8 + dd];
    const int mi = w >> 1;
    LRS[t * 16 + oct * 2] = rl.x; LRS[t * 16 + oct * 2 + 1] = rl.y;
    LDS_BAR();
    float la[8];
    {
        float lrv[16];
#pragma unroll
        for (int j4 = 0; j4 < 4; ++j4) { const f32x4 v = *(const LAS f32x4*)(LRS + t * 16 + j4 * 4); lrv[j4 * 4] = v.x; lrv[j4 * 4 + 1] = v.y; lrv[j4 * 4 + 2] = v.z; lrv[j4 * 4 + 3] = v.w; }
#pragma unroll
        for (int dd = 0; dd < 8; ++dd) la[dd] = blr[dd];
#pragma unroll
        for (int j = 0; j < 16; ++j) { const f32x4 w0 = *(const LAS f32x4*)(WL + j * 64 + o8), w1 = *(const LAS f32x4*)(WL + j * 64 + o8 + 4);
            la[0] += lrv[j] * w0.x; la[1] += lrv[j] * w0.y; la[2] += lrv[j] * w0.z; la[3] += lrv[j] * w0.w;
            la[4] += lrv[j] * w1.x; la[5] += lrv[j] * w1.y; la[6] += lrv[j] * w1.z; la[7] += lrv[j] * w1.w; }
#pragma unroll
        for (int dd = 0; dd < 8; ++dd) { const float x = la[dd]; const float ls = fminf(x, 0.f) - __logf(1.f + __expf(-fabsf(x))); la[dd] = valid ? ls * (1.f / 16.f) : 0.f; }
#pragma unroll
        for (int dd = 0; dd < 8; ++dd) { float v = la[dd]; float u = __shfl_up(v, 8); if (lane >= 8) v += u; u = __shfl_up(v, 16); if (lane >= 16) v += u; u = __shfl_up(v, 32); if (lane >= 32) v += u; la[dd] = v; }
        if ((lane >> 3) == 7) { *(LAS f32x4*)(SEG + w * 64 + o8) = (f32x4){la[0], la[1], la[2], la[3]}; *(LAS f32x4*)(SEG + w * 64 + o8 + 4) = (f32x4){la[4], la[5], la[6], la[7]}; }
    }
    LDS_BAR();
    float bl[8];
    {
        float pre[8];
#pragma unroll
        for (int dd = 0; dd < 8; ++dd) { pre[dd] = 0.f; bl[dd] = 0.f; }
#pragma unroll
        for (int ww = 0; ww < 8; ++ww) { const f32x4 s0 = *(const LAS f32x4*)(SEG + ww * 64 + o8), s1 = *(const LAS f32x4*)(SEG + ww * 64 + o8 + 4);
            const float m = ww < w ? 1.f : 0.f;
            pre[0] += m * s0.x; pre[1] += m * s0.y; pre[2] += m * s0.z; pre[3] += m * s0.w; pre[4] += m * s1.x; pre[5] += m * s1.y; pre[6] += m * s1.z; pre[7] += m * s1.w;
            bl[0] += s0.x; bl[1] += s0.y; bl[2] += s0.z; bl[3] += s0.w; bl[4] += s1.x; bl[5] += s1.y; bl[6] += s1.z; bl[7] += s1.w; }
#pragma unroll
        for (int dd = 0; dd < 8; ++dd) la[dd] += pre[dd];
    }
    {
        float kf[8]; unpack8(rk, kf);
        if (DO_OUT) { float qf[8], qt[8], kt[8]; unpack8(rq, qf);
#pragma unroll
            for (int dd = 0; dd < 8; ++dd) { qt[dd] = qf[dd] * 0.125f * __expf(la[dd]); kt[dd] = kf[dd] * __expf(-la[dd]); }
            *(LAS u32x4*)(QT + t * 72 + o8) = pack8(qt); *(LAS u32x4*)(KT + t * 72 + o8) = pack8(kt);
            *(LAS u32x4*)(GS + t * 136 + o8) = rg0; *(LAS u32x4*)(GS + t * 136 + 64 + o8) = rg1; }
        if (DO_S) {
#pragma unroll
            for (int dd = 0; dd < 8; ++dd) KHT[(o8 + dd) * 72 + tsw] = f2bf(kf[dd] * __expf(bl[dd] - la[dd]));
            if (t == 0) {
#pragma unroll
                for (int dd = 0; dd < 8; ++dd) BL[o8 + dd] = __expf(bl[dd]);
            } }
        const unsigned vw[8] = {rv0.x, rv0.y, rv0.z, rv0.w, rv1.x, rv1.y, rv1.z, rv1.w};
#pragma unroll
        for (int e2 = 0; e2 < 8; ++e2) { const int e = (e2 < 4 ? 0 : 64) + o8 + (e2 & 3) * 2; VT[e * 72 + tsw] = (bf16)(vw[e2] & 0xffffu); VT[(e + 1) * 72 + tsw] = (bf16)(vw[e2] >> 16); }
    }
    LDS_BAR();
    const int swr = (r >> 3);
    f32x4 O[4];
    if (DO_OUT) {
#pragma unroll
        for (int jj = 0; jj < 2; ++jj) { const int nj = 2 * (w & 1) + jj; f32x4 acc = (f32x4){0.f, 0.f, 0.f, 0.f};
#pragma unroll
            for (int ks = 0; ks < 2; ++ks) { const bf16x8 a = *(const LAS bf16x8*)(QT + (16 * mi + r) * 72 + ks * 32 + q * 8), bb = *(const LAS bf16x8*)(KT + (16 * nj + r) * 72 + ks * 32 + q * 8);
                acc = __builtin_amdgcn_mfma_f32_16x16x32_bf16(a, bb, acc, 0, 0, 0); }
#pragma unroll
            for (int i = 0; i < 4; ++i) { const int row = 16 * mi + q * 4 + i, col = 16 * nj + r; ATT[row * 72 + col] = f2bf(col <= row ? acc[i] : 0.f); } }
        LDS_BAR();
#pragma unroll
        for (int n = 0; n < 4; ++n) O[n] = (f32x4){0.f, 0.f, 0.f, 0.f};
#pragma unroll
        for (int ks = 0; ks < 2; ++ks) { const bf16x8 a = *(const LAS bf16x8*)(QT + (16 * mi + r) * 72 + ks * 32 + q * 8);
#pragma unroll
            for (int n = 0; n < 4; ++n) { const bf16x8 bb = *(const LAS bf16x8*)(ST + (16 * (4 * (w & 1) + n) + r) * 72 + ks * 32 + q * 8); O[n] = __builtin_amdgcn_mfma_f32_16x16x32_bf16(a, bb, O[n], 0, 0, 0); } }
#pragma unroll
        for (int ks = 0; ks < 2; ++ks) { const bf16x8 a = *(const LAS bf16x8*)(ATT + (16 * mi + r) * 72 + ks * 32 + q * 8);
#pragma unroll
            for (int n = 0; n < 4; ++n) { const int sw = ((2 * n + swr) & 7) << 3; const bf16x8 bb = *(const LAS bf16x8*)(VT + (16 * (4 * (w & 1) + n) + r) * 72 + ((ks * 32 + q * 8) ^ sw)); O[n] = __builtin_amdgcn_mfma_f32_16x16x32_bf16(a, bb, O[n], 0, 0, 0); } }
    }
    if (DO_S) {
#pragma unroll
        for (int n = 0; n < 4; ++n) { const float dec = BL[16 * n + r]; S[n] = S[n] * dec; }
#pragma unroll
        for (int ks = 0; ks < 2; ++ks) { const int swa = ((2 * w + swr) & 7) << 3; const bf16x8 a = *(const LAS bf16x8*)(VT + (16 * w + r) * 72 + ((ks * 32 + q * 8) ^ swa));
#pragma unroll
            for (int n = 0; n < 4; ++n) { const int sw = ((2 * n + swr) & 7) << 3; const bf16x8 bb = *(const LAS bf16x8*)(KHT + (16 * n + r) * 72 + ((ks * 32 + q * 8) ^ sw)); S[n] = __builtin_amdgcn_mfma_f32_16x16x32_bf16(a, bb, S[n], 0, 0, 0); } }
    }
    if (DO_OUT) {
#pragma unroll
        for (int i = 0; i < 4; ++i) { float s = 0.f;
#pragma unroll
            for (int n = 0; n < 4; ++n) s += O[n][i] * O[n][i];
            s += __shfl_xor(s, 1); s += __shfl_xor(s, 2); s += __shfl_xor(s, 4); s += __shfl_xor(s, 8);
            if (r == 0) SSQ[(16 * mi + q * 4 + i) * 2 + (w & 1)] = s; }
    }
    LDS_BAR();
    if (MODE == 1) {
#pragma unroll
        for (int n = 0; n < 4; ++n)
#pragma unroll
            for (int i = 0; i < 4; ++i) ST[(16 * w + q * 4 + i) * 72 + 16 * n + r] = f2bf(S[n][i]);
        if (tid < 64) DEC[tid] = BL[tid];
    }
    if (DO_OUT) {
        float gn[4];
#pragma unroll
        for (int n = 0; n < 4; ++n) gn[n] = A.in[I_GNORM][l * 128 + 16 * (4 * (w & 1) + n) + r];
#pragma unroll
        for (int i = 0; i < 4; ++i) { const int row = 16 * mi + q * 4 + i; const float rstd = __builtin_amdgcn_rsqf((SSQ[row * 2] + SSQ[row * 2 + 1]) * (1.f / 128.f) + EPS);
#pragma unroll
            for (int n = 0; n < 4; ++n) { const int e = 16 * (4 * (w & 1) + n) + r; const float gv = bf2f(GS[row * 136 + e]); GS[row * 136 + e] = f2bf(O[n][i] * rstd * gn[n] * gv * sigm(gv)); } }
    }
    LDS_BAR();
    if (DO_OUT) { if (valid) { bf16* mr = MIX + (size_t)(row0 + t) * DM + h * 128 + o8;
        *(u32x4*)(mr) = *(const LAS u32x4*)(GS + t * 136 + o8); *(u32x4*)(mr + 64) = *(const LAS u32x4*)(GS + t * 136 + 64 + o8); } }
    if (MODE == 1) {
#pragma unroll
        for (int k = 0; k < 2; ++k) { const int idx = tid + 512 * k, row = idx >> 3, c8 = (idx & 7) * 8; *(u32x4*)(DS + row * 64 + c8) = *(const LAS u32x4*)(ST + row * 72 + c8); }
    }
    if (MODE == 0) { float* so = A.out + OUT_GLA_S + ((size_t)(l * 32 + b) * 4 + h) * 8192;
#pragma unroll
        for (int n = 0; n < 4; ++n) *(f32x4*)(so + (16 * n + r) * 128 + 16 * w + q * 4) = S[n]; }
    LDS_BAR();
}

template <int MODE>
__device__ __forceinline__ void gla_loop(LAS unsigned char* L, const Args& A, int l, int j0, int jstride, int jend) {
    if (j0 >= jend) return;
    const int tid = opaque_tid(), w = __builtin_amdgcn_readfirstlane(tid >> 6), lane = tid & 63, r = lane & 15, q = lane >> 4;
    const int t2 = tid >> 3, c8 = (tid & 7) * 8;
    const int o8 = w * 8;
    LAS bf16* QT = (LAS bf16*)(L + 0); LAS bf16* KT = (LAS bf16*)(L + 9216); LAS bf16* KHT = (LAS bf16*)(L + 18432); LAS bf16* ATT = (LAS bf16*)(L + 27648);
    LAS bf16* VT = (LAS bf16*)(L + 36864); LAS bf16* ST = (LAS bf16*)(L + 55296); LAS bf16* GS = (LAS bf16*)(L + 73728);
    LAS float* LRS = (LAS float*)(L + 91136); LAS bf16* VRAW = (LAS bf16*)(L + 102144); LAS float* WL = (LAS float*)(L + 95232); LAS float* SSQ = (LAS float*)(L + 101376); LAS float* BL = (LAS float*)(L + 101888);
    constexpr bool SMP = (MODE == 0), DO_OUT = (MODE != 1), DO_S = (MODE != 2);
    constexpr int ntok = SMP ? 32 : 64;
    const bf16* Z = (const bf16*)(A.ws + WS_Z); bf16* MIX = (bf16*)(A.ws + WS_MIX); const float* LR = (const float*)(A.ws + WS_LR);
    const bool valid = lane < ntok;
    const u32x4 z4 = (u32x4){0u, 0u, 0u, 0u};
    const int mi = w >> 1, swr = r >> 3; (void)swr;
    u32x4 rq = z4, rk = z4, rv0 = z4, rv1 = z4, rg0 = z4, rg1 = z4, sd0 = z4, sd1 = z4;
#define GLA_ROW0(j) (SMP ? MP + ((j) >> 2) * 32 : ((j) >> 7) * 2048 + ((j) & 31) * 64)
#define GLA_HEAD(j) (SMP ? ((j) & 3) : (((j) >> 5) & 3))
#define GLA_LOAD(j) do { const int h_ = GLA_HEAD(j); const bf16* zr = Z + (size_t)(GLA_ROW0(j) + t2) * NZ; \
        if (t2 < ntok) { rk = *(const u32x4*)(zr + 256 + h_ * 64 + c8); rv0 = *(const u32x4*)(zr + 512 + h_ * 128 + c8); rv1 = *(const u32x4*)(zr + 512 + h_ * 128 + 64 + c8); \
            rl2 = *(const f32x2*)(LR + (size_t)(GLA_ROW0(j) + t2) * 16 + (tid & 7) * 2); \
            if (DO_OUT) { rq = *(const u32x4*)(zr + h_ * 64 + c8); rg0 = *(const u32x4*)(zr + 1024 + h_ * 128 + c8); rg1 = *(const u32x4*)(zr + 1024 + h_ * 128 + 64 + c8); } } \
        if (MODE == 2) { const bf16* ds_ = (const bf16*)(A.ws + WS_DS) + (size_t)(j) * 8192; sd0 = *(const u32x4*)(ds_ + t2 * 64 + c8); sd1 = *(const u32x4*)(ds_ + (64 + t2) * 64 + c8); } } while (0)
    f32x2 rl2 = (f32x2){0.f, 0.f};
    GLA_LOAD(j0);
    int hprev = -1;
    float blr[8], gn[4];
#pragma unroll
    for (int dd = 0; dd < 8; ++dd) blr[dd] = 0.f;
#pragma unroll
    for (int n = 0; n < 4; ++n) gn[n] = A.in[I_GNORM][l * 128 + 16 * (4 * (w & 1) + n) + r];
    for (int j = j0; j < jend; j += jstride) {
        SEC_BEGIN(21); SEC_MARK(21);
        const int h = GLA_HEAD(j), row0 = GLA_ROW0(j), b = SMP ? (j >> 2) : (j >> 7);
        if (h != hprev) { hprev = h;
#pragma unroll
            for (int dd = 0; dd < 8; ++dd) blr[dd] = A.in[I_BLR][l * 256 + h * 64 + o8 + dd];
            { const int idx = tid * 2, jj = idx >> 6, d = idx & 63; const float* src = A.in[I_WLR2] + (size_t)(l * 16 + jj) * 256 + h * 64 + d; WL[jj * 64 + d] = src[0]; WL[jj * 64 + d + 1] = src[1]; }
            LDS_BAR(); }
        f32x4 S[4];
#pragma unroll
        for (int n = 0; n < 4; ++n) S[n] = (f32x4){0.f, 0.f, 0.f, 0.f};
        if (MODE == 0) { const float* s0 = A.in[I_SGLA] + ((size_t)(l * 32 + b) * 4 + h) * 8192;
#pragma unroll
            for (int n = 0; n < 4; ++n) S[n] = *(const f32x4*)(s0 + (16 * n + r) * 128 + 16 * w + q * 4);
#pragma unroll
            for (int n = 0; n < 4; ++n)
#pragma unroll
                for (int i = 0; i < 4; ++i) ST[(16 * w + q * 4 + i) * 72 + 16 * n + r] = f2bf(S[n][i]);
        }
        if (MODE == 2) { *(LAS u32x4*)(ST + t2 * 72 + c8) = sd0; *(LAS u32x4*)(ST + (64 + t2) * 72 + c8) = sd1; }
        *(LAS u32x4*)(KT + t2 * 72 + c8) = rk; *(LAS u32x4*)(VRAW + t2 * 136 + c8) = rv0; *(LAS u32x4*)(VRAW + t2 * 136 + 64 + c8) = rv1; *(LAS f32x2*)(LRS + t2 * 16 + (tid & 7) * 2) = rl2;
        if (DO_OUT) { *(LAS u32x4*)(QT + t2 * 72 + c8) = rq; *(LAS u32x4*)(GS + t2 * 136 + c8) = rg0; *(LAS u32x4*)(GS + t2 * 136 + 64 + c8) = rg1; }
        if (j + jstride < jend) GLA_LOAD(j + jstride);
        LDS_BAR();
        f32x4 rl[4];
#pragma unroll
        for (int k = 0; k < 4; ++k) rl[k] = *(const LAS f32x4*)(LRS + lane * 16 + 4 * k);
        const u32x4 kx = *(const LAS u32x4*)(KT + lane * 72 + o8), v0 = *(const LAS u32x4*)(VRAW + lane * 136 + o8), v1 = *(const LAS u32x4*)(VRAW + lane * 136 + 64 + o8);
        u32x4 qx = z4; if (DO_OUT) qx = *(const LAS u32x4*)(QT + lane * 72 + o8);
        float la[8], bl[8];
        {
            const float lrv[16] = {rl[0].x, rl[0].y, rl[0].z, rl[0].w, rl[1].x, rl[1].y, rl[1].z, rl[1].w, rl[2].x, rl[2].y, rl[2].z, rl[2].w, rl[3].x, rl[3].y, rl[3].z, rl[3].w};
#pragma unroll
            for (int dd = 0; dd < 8; ++dd) la[dd] = blr[dd];
#pragma unroll
            for (int jj = 0; jj < 16; ++jj) { const f32x4 w0 = *(const LAS f32x4*)(WL + jj * 64 + o8), w1 = *(const LAS f32x4*)(WL + jj * 64 + o8 + 4);
                la[0] += lrv[jj] * w0.x; la[1] += lrv[jj] * w0.y; la[2] += lrv[jj] * w0.z; la[3] += lrv[jj] * w0.w;
                la[4] += lrv[jj] * w1.x; la[5] += lrv[jj] * w1.y; la[6] += lrv[jj] * w1.z; la[7] += lrv[jj] * w1.w; }
#pragma unroll
            for (int dd = 0; dd < 8; ++dd) { const float x = la[dd]; const float ls = fminf(x, 0.f) - __logf(1.f + __expf(-fabsf(x))); la[dd] = valid ? ls * (1.f / 16.f) : 0.f; }
#pragma unroll
            for (int dd = 0; dd < 8; ++dd) { float v = la[dd];
#pragma unroll
                for (int o = 1; o < 64; o <<= 1) { const float u = __shfl_up(v, o); if (lane >= o) v += u; }
                la[dd] = v; bl[dd] = __shfl(v, 63); }
        }
        {
            float kf[8]; unpack8(kx, kf);
            if (DO_OUT) { float qf[8], qt[8], kt[8]; unpack8(qx, qf);
#pragma unroll
                for (int dd = 0; dd < 8; ++dd) { qt[dd] = qf[dd] * 0.125f * __expf(la[dd]); kt[dd] = kf[dd] * __expf(-la[dd]); }
                *(LAS u32x4*)(QT + lane * 72 + o8) = pack8(qt); *(LAS u32x4*)(KT + lane * 72 + o8) = pack8(kt);
}
            if (DO_S) {
#pragma unroll
                for (int dd = 0; dd < 8; ++dd) KHT[(o8 + dd) * 72 + lane] = f2bf(kf[dd] * __expf(bl[dd] - la[dd]));
                if (lane == 0) {
#pragma unroll
                    for (int dd = 0; dd < 8; ++dd) BL[o8 + dd] = __expf(bl[dd]);
                } }
            const unsigned vw[8] = {v0.x, v0.y, v0.z, v0.w, v1.x, v1.y, v1.z, v1.w};
#pragma unroll
            for (int e2 = 0; e2 < 8; ++e2) { const int e = (e2 < 4 ? 0 : 64) + o8 + (e2 & 3) * 2; VT[e * 72 + lane] = (bf16)(vw[e2] & 0xffffu); VT[(e + 1) * 72 + lane] = (bf16)(vw[e2] >> 16); }
        }
        SEC_END(21); SEC_MARK(22);
        LDS_BAR();
        f32x4 O[4];
        if (DO_OUT) {
#pragma unroll
            for (int jj = 0; jj < 2; ++jj) { const int nj = 2 * (w & 1) + jj; f32x4 acc = (f32x4){0.f, 0.f, 0.f, 0.f};
#pragma unroll
                for (int ks = 0; ks < 2; ++ks) { const bf16x8 a = *(const LAS bf16x8*)(QT + (16 * mi + r) * 72 + ks * 32 + q * 8), bb = *(const LAS bf16x8*)(KT + (16 * nj + r) * 72 + ks * 32 + q * 8);
                    acc = __builtin_amdgcn_mfma_f32_16x16x32_bf16(a, bb, acc, 0, 0, 0); }
#pragma unroll
                for (int i = 0; i < 4; ++i) { const int row = 16 * mi + q * 4 + i, col = 16 * nj + r; ATT[row * 72 + col] = f2bf(col <= row ? acc[i] : 0.f); } }
            LDS_BAR();
#pragma unroll
            for (int n = 0; n < 4; ++n) O[n] = (f32x4){0.f, 0.f, 0.f, 0.f};
#pragma unroll
            for (int ks = 0; ks < 2; ++ks) { const bf16x8 a = *(const LAS bf16x8*)(QT + (16 * mi + r) * 72 + ks * 32 + q * 8);
#pragma unroll
                for (int n = 0; n < 4; ++n) { const bf16x8 bb = *(const LAS bf16x8*)(ST + (16 * (4 * (w & 1) + n) + r) * 72 + ks * 32 + q * 8); O[n] = __builtin_amdgcn_mfma_f32_16x16x32_bf16(a, bb, O[n], 0, 0, 0); } }
#pragma unroll
            for (int ks = 0; ks < 2; ++ks) { const bf16x8 a = *(const LAS bf16x8*)(ATT + (16 * mi + r) * 72 + ks * 32 + q * 8);
#pragma unroll
                for (int n = 0; n < 4; ++n) { const bf16x8 bb = *(const LAS bf16x8*)(VT + (16 * (4 * (w & 1) + n) + r) * 72 + ks * 32 + q * 8); O[n] = __builtin_amdgcn_mfma_f32_16x16x32_bf16(a, bb, O[n], 0, 0, 0); } }
        }
        if (DO_S) {
#pragma unroll
            for (int n = 0; n < 4; ++n) { const float dec = BL[16 * n + r]; S[n] = S[n] * dec; }
#pragma unroll
            for (int ks = 0; ks < 2; ++ks) { const bf16x8 a = *(const LAS bf16x8*)(VT + (16 * w + r) * 72 + ks * 32 + q * 8);
#pragma unroll
                for (int n = 0; n < 4; ++n) { const bf16x8 bb = *(const LAS bf16x8*)(KHT + (16 * n + r) * 72 + ks * 32 + q * 8); S[n] = __builtin_amdgcn_mfma_f32_16x16x32_bf16(a, bb, S[n], 0, 0, 0); } }
        }
        if (DO_OUT) {
#pragma unroll
            for (int i = 0; i < 4; ++i) { float s = 0.f;
#pragma unroll
                for (int n = 0; n < 4; ++n) s += O[n][i] * O[n][i];
                s += __shfl_xor(s, 1); s += __shfl_xor(s, 2); s += __shfl_xor(s, 4); s += __shfl_xor(s, 8);
                if (r == 0) SSQ[(16 * mi + q * 4 + i) * 2 + (w & 1)] = s; }
        }
        LDS_BAR();
        SEC_END(22); SEC_MARK(23);
        if (MODE == 1) {
#pragma unroll
            for (int n = 0; n < 4; ++n)
#pragma unroll
                for (int i = 0; i < 4; ++i) ST[(16 * w + q * 4 + i) * 72 + 16 * n + r] = f2bf(S[n][i]);
            if (tid < 64) ((float*)(A.ws + WS_DEC))[(size_t)j * 64 + tid] = BL[tid];
        }
        if (DO_OUT) {
#pragma unroll
            for (int i = 0; i < 4; ++i) { const int row = 16 * mi + q * 4 + i; const float rstd = __builtin_amdgcn_rsqf((SSQ[row * 2] + SSQ[row * 2 + 1]) * (1.f / 128.f) + EPS);
#pragma unroll
                for (int n = 0; n < 4; ++n) { const int e = 16 * (4 * (w & 1) + n) + r; const float gv = bf2f(GS[row * 136 + e]); GS[row * 136 + e] = f2bf(O[n][i] * rstd * gn[n] * gv * sigm(gv)); } }
        }
        LDS_BAR();
        if (DO_OUT) { if (t2 < ntok) { bf16* mr = MIX + (size_t)(row0 + t2) * DM + h * 128 + c8;
            *(u32x4*)(mr) = *(const LAS u32x4*)(GS + t2 * 136 + c8); *(u32x4*)(mr + 64) = *(const LAS u32x4*)(GS + t2 * 136 + 64 + c8); } }
        if (MODE == 1) { bf16* DS = (bf16*)(A.ws + WS_DS) + (size_t)j * 8192;
            *(u32x4*)(DS + t2 * 64 + c8) = *(const LAS u32x4*)(ST + t2 * 72 + c8); *(u32x4*)(DS + (64 + t2) * 64 + c8) = *(const LAS u32x4*)(ST + (64 + t2) * 72 + c8); }
        if (MODE == 0) { float* so = A.out + OUT_GLA_S + ((size_t)(l * 32 + b) * 4 + h) * 8192;
#pragma unroll
            for (int n = 0; n < 4; ++n) *(f32x4*)(so + (16 * n + r) * 128 + 16 * w + q * 4) = S[n]; }
        LDS_BAR();
        SEC_END(23);
    }
#undef GLA_LOAD
#undef GLA_ROW0
#undef GLA_HEAD
}

__device__ __forceinline__ void gla_scan(const Args& A, int l, int gt, int NGT) {
    unsigned* DS32 = (unsigned*)(A.ws + WS_DS); const float* DEC = (const float*)(A.ws + WS_DEC);
    for (int e = gt; e < 32 * 4096; e += NGT) {
        const int bh = e >> 12, p = e & 4095, dk0 = (2 * p) & 63, dv = p >> 5;
        float s0 = 0.f, s1 = 0.f;
        unsigned* dp = DS32 + (size_t)bh * 32 * 4096 + p; const float* dc = DEC + (size_t)bh * 32 * 64 + dk0;
        unsigned wv[32]; f32x2 dd[32];
#pragma unroll
        for (int c = 0; c < 32; ++c) { wv[c] = dp[(size_t)c * 4096]; dd[c] = *(const f32x2*)(dc + c * 64); }
#pragma unroll
        for (int c = 0; c < 32; ++c) { dp[(size_t)c * 4096] = pk2(s0, s1); s0 = dd[c].x * s0 + blo(wv[c]); s1 = dd[c].y * s1 + bhi(wv[c]); }
        float* so = A.out + OUT_GLA_P + ((size_t)(l * 8) * 4 + bh) * 8192;
        so[dk0 * 128 + dv] = s0; so[(dk0 + 1) * 128 + dv] = s1;
    }
}

__device__ __forceinline__ void rg_prefix(const Args& A, int l, int gt, int NGT) {
    const float* CA = (const float*)(A.ws + WS_CA); const float* CU = CA + 8 * 32 * 512; float* HIN = (float*)(A.ws + WS_HIN);
    for (int e = gt; e < 8 * 512; e += NGT) { const int b = e >> 9, ch = e & 511; float ca[32], cu[32];
#pragma unroll
        for (int c = 0; c < 32; ++c) { ca[c] = CA[(b * 32 + c) * 512 + ch]; cu[c] = CU[(b * 32 + c) * 512 + ch]; }
        float h = 0.f;
#pragma unroll
        for (int c = 0; c < 32; ++c) { HIN[(b * 32 + c) * 512 + ch] = h; h = ca[c] * h + cu[c]; }
        A.out[OUT_RG_P + (size_t)(l * 8 + b) * 512 + ch] = h; }
}

__device__ __forceinline__ void rg_item(LAS unsigned char* L, const Args& A, int l, int smp, int b, int c) {
    const int tid = opaque_tid(), w = __builtin_amdgcn_readfirstlane(tid >> 6), lane = tid & 63, r = lane & 15, q = lane >> 4, tl = lane >> 3, oct = lane & 7;
    const int ch0 = w * 64;
    LAS bf16* XR = (LAS bf16*)(L + w * 18432);
    LAS bf16* XCB = XR + 67 * 64;
    const int ntok = smp ? 32 : 64, row0 = smp ? MP + b * 32 : b * 2048 + c * 64, nbt = smp ? 32 : 8;
    const bf16* Z = (const bf16*)(A.ws + WS_Z);
    bf16* LG = (bf16*)(A.ws + WS_H); bf16* UG = LG + (size_t)M * 512;
    float* CA = (float*)(A.ws + WS_CA); float* CU = CA + 8 * 32 * 512;
    const u32x4 z4 = (u32x4){0u, 0u, 0u, 0u};
    u32x4 xh = z4, xv[8];
    if (lane < 24) { const int j = lane >> 3;
        if (c > 0) xh = *(const u32x4*)(Z + (size_t)(row0 - 3 + j) * NZ + 1536 + ch0 + oct * 8);
        else if (smp) { const float* sp = A.in[I_SCV] + ((size_t)(l * 32 + b) * 3 + j) * 512 + ch0 + oct * 8; const f32x4 a0 = *(const f32x4*)sp, a1 = *(const f32x4*)(sp + 4);
            xh.x = pk2(a0.x, a0.y); xh.y = pk2(a0.z, a0.w); xh.z = pk2(a1.x, a1.y); xh.w = pk2(a1.z, a1.w); } }
#pragma unroll
    for (int s = 0; s < 8; ++s) { const int t = s * 8 + tl; xv[s] = (t < ntok) ? *(const u32x4*)(Z + (size_t)(row0 + t) * NZ + 1536 + ch0 + oct * 8) : z4; }
    f32x4 cwv[4][2], cbv[2];
#pragma unroll
    for (int hh = 0; hh < 2; ++hh) { cbv[hh] = *(const f32x4*)(A.in[I_CB] + l * 512 + ch0 + oct * 8 + 4 * hh);
#pragma unroll
        for (int j = 0; j < 4; ++j) cwv[j][hh] = *(const f32x4*)(A.in[I_CW] + (l * 4 + j) * 512 + ch0 + oct * 8 + 4 * hh); }
    const bf16* wrg = (const bf16*)(A.ws + WS_W + (size_t)l * LAYER_W + W_RG) + (size_t)w * 128 * 64;
    bf16x8 Bf[8][2];
#pragma unroll
    for (int n = 0; n < 8; ++n)
#pragma unroll
        for (int ks = 0; ks < 2; ++ks) Bf[n][ks] = *(const bf16x8*)(wrg + (16 * n + r) * 64 + ks * 32 + q * 8);
    float ba_[4], bx_[4], sp_[4], At[4], Ut[4];
#pragma unroll
    for (int n = 0; n < 4; ++n) { const int ch = l * 512 + ch0 + 16 * n + r; ba_[n] = A.in[I_BA][ch]; bx_[n] = A.in[I_BX][ch]; sp_[n] = A.in[I_LAM][ch]; At[n] = 1.f; Ut[n] = 0.f; }
    LDS_BAR();
    if (lane < 24) *(LAS u32x4*)(XR + (lane >> 3) * 64 + oct * 8) = xh;
#pragma unroll
    for (int s = 0; s < 8; ++s) *(LAS u32x4*)(XR + (3 + s * 8 + tl) * 64 + oct * 8) = xv[s];
    LDS_WAIT(); asm volatile("" ::: "memory");
#pragma unroll
    for (int s = 0; s < 8; ++s) { const int t = s * 8 + tl; float xc[8] = {cbv[0].x, cbv[0].y, cbv[0].z, cbv[0].w, cbv[1].x, cbv[1].y, cbv[1].z, cbv[1].w};
#pragma unroll
        for (int j = 0; j < 4; ++j) { float xf[8]; unpack8(*(const LAS u32x4*)(XR + (t + j) * 64 + oct * 8), xf);
            xc[0] += cwv[j][0].x * xf[0]; xc[1] += cwv[j][0].y * xf[1]; xc[2] += cwv[j][0].z * xf[2]; xc[3] += cwv[j][0].w * xf[3];
            xc[4] += cwv[j][1].x * xf[4]; xc[5] += cwv[j][1].y * xf[5]; xc[6] += cwv[j][1].z * xf[6]; xc[7] += cwv[j][1].w * xf[7]; }
        *(LAS u32x4*)(XCB + t * 72 + oct * 8) = pack8(xc); }
    if (smp || c == 31) {
#pragma unroll
        for (int j = 0; j < 3; ++j) A.out[(smp ? OUT_CV_S : OUT_CV_P) + ((size_t)(l * nbt + b) * 3 + j) * 512 + ch0 + lane] = bf2f(XR[(ntok + j) * 64 + lane]);
    }
    LDS_WAIT(); asm volatile("" ::: "memory");
#pragma unroll
    for (int n = 0; n < 4; ++n) { const float lam = sp_[n]; sp_[n] = 8.f * (fmaxf(-lam, 0.f) + __logf(1.f + __expf(-fabsf(lam)))); }
    const int nm = ntok >> 4;
    unsigned upk[4][4][2];
#pragma unroll
    for (int m = 0; m < 4; ++m) {
#pragma unroll
        for (int n = 0; n < 4; ++n) { upk[m][n][0] = 0u; upk[m][n][1] = 0u; }
        if (m < nm) {
            f32x4 acc[8];
#pragma unroll
            for (int k = 0; k < 8; ++k) acc[k] = (f32x4){0.f, 0.f, 0.f, 0.f};
#pragma unroll
            for (int ks = 0; ks < 2; ++ks) { const bf16x8 a = *(const LAS bf16x8*)(XCB + (16 * m + r) * 72 + ks * 32 + q * 8);
#pragma unroll
                for (int k = 0; k < 8; ++k) acc[k] = __builtin_amdgcn_mfma_f32_16x16x32_bf16(a, Bf[k][ks], acc[k], 0, 0, 0); }
#pragma unroll
            for (int n = 0; n < 4; ++n) {
                float uv[4]; float Aq = 1.f, Uq = 0.f;
#pragma unroll
                for (int i = 0; i < 4; ++i) { const float p1 = 1.f + __expf(-(acc[n][i] + ba_[n])), p2 = 1.f + __expf(-(acc[4 + n][i] + bx_[n])), pinv = __builtin_amdgcn_rcpf(p1 * p2);
                    const float rr = p2 * pinv, ii = p1 * pinv;
                    const unsigned short lgb = f2bf(-rr * sp_[n]); const float lg = bf2f(lgb);
                    const float a = __expf(lg); const float xcv = bf2f(XCB[(16 * m + 4 * q + i) * 72 + 16 * n + r]);
                    const float u = bf2f(f2bf(__builtin_amdgcn_sqrtf(fmaxf(1.f - a * a, 0.f)) * ii * xcv));
                    XR[(16 * m + 4 * q + i) * 64 + 16 * n + r] = lgb;
                    uv[i] = u; Uq = a * Uq + u; Aq = a * Aq; }
                upk[m][n][0] = pk2(uv[0], uv[1]); upk[m][n][1] = pk2(uv[2], uv[3]);
                { const float A1 = __shfl_up(Aq, 16), U1 = __shfl_up(Uq, 16); if (q >= 1) { Uq = Aq * U1 + Uq; Aq = Aq * A1; } }
                { const float A2 = __shfl_up(Aq, 32), U2 = __shfl_up(Uq, 32); if (q >= 2) { Uq = Aq * U2 + Uq; Aq = Aq * A2; } }
                const float Am = __shfl(Aq, 48 + r), Um = __shfl(Uq, 48 + r);
                Ut[n] = Am * Ut[n] + Um; At[n] = Am * At[n];
            }
        }
    }
    if (!smp && q == 0) {
#pragma unroll
        for (int n = 0; n < 4; ++n) { const int ix = (b * 32 + c) * 512 + ch0 + 16 * n + r; CA[ix] = At[n]; CU[ix] = Ut[n]; } }
    LDS_WAIT(); asm volatile("" ::: "memory");
#pragma unroll
    for (int s = 0; s < 8; ++s) { const int t = s * 8 + tl; if (t < ntok) *(u32x4*)(LG + (size_t)(row0 + t) * 512 + ch0 + oct * 8) = *(const LAS u32x4*)(XR + t * 64 + oct * 8); }
    LDS_WAIT(); asm volatile("" ::: "memory");
#pragma unroll
    for (int m = 0; m < 4; ++m)
#pragma unroll
        for (int n = 0; n < 4; ++n) { LAS bf16* p = XR + (16 * m + 4 * q) * 64 + 16 * n + r;
            p[0] = (bf16)(upk[m][n][0] & 0xffffu); p[64] = (bf16)(upk[m][n][0] >> 16); p[128] = (bf16)(upk[m][n][1] & 0xffffu); p[192] = (bf16)(upk[m][n][1] >> 16); }
    LDS_WAIT(); asm volatile("" ::: "memory");
#pragma unroll
    for (int s = 0; s < 8; ++s) { const int t = s * 8 + tl; if (t < ntok) *(u32x4*)(UG + (size_t)(row0 + t) * 512 + ch0 + oct * 8) = *(const LAS u32x4*)(XR + t * 64 + oct * 8); }
    LDS_BAR();
}

__device__ __forceinline__ void rg_out(const Args& A, int l, int smp, int b, int c) {
    const int tid = opaque_tid(), w = __builtin_amdgcn_readfirstlane(tid >> 6), lane = tid & 63;
    const int ch = w * 64 + lane, ntok = smp ? 32 : 64, row0 = smp ? MP + b * 32 : b * 2048 + c * 64;
    const bf16* Z = (const bf16*)(A.ws + WS_Z); bf16* MIX = (bf16*)(A.ws + WS_MIX);
    const bf16* LG = (const bf16*)(A.ws + WS_H); const bf16* UG = LG + (size_t)M * 512;
    float h = smp ? A.in[I_SRG][(size_t)(l * 32 + b) * 512 + ch] : ((const float*)(A.ws + WS_HIN))[(b * 32 + c) * 512 + ch];
    for (int t0 = 0; t0 < ntok; t0 += 16) {
        bf16 lgv[16], uvv[16], grv[16];
#pragma unroll
        for (int k = 0; k < 16; ++k) { const size_t row = (size_t)(row0 + t0 + k); lgv[k] = LG[row * 512 + ch]; uvv[k] = UG[row * 512 + ch]; grv[k] = Z[row * NZ + 2048 + ch]; }
#pragma unroll
        for (int k = 0; k < 16; ++k) { h = __expf(bf2f(lgv[k])) * h + bf2f(uvv[k]); MIX[(size_t)(row0 + t0 + k) * DM + 512 + ch] = f2bf(h * gelu_tanh(bf2f(grv[k]))); }
    }
    if (smp) A.out[OUT_RG_S + (size_t)(l * 32 + b) * 512 + ch] = h;
}

#define XB_TMO      128
#define XB_XCNT(j)  (256  + 64 * (j))
#define XB_XSUB(j)  (1280 + 64 * (j))
#define XB_XGEN(j)  (2304 + 64 * (j))
#define XB_TOP      3328
#define XB_TOPGEN   3392
#define XCD_BAR_WORDS 3456
#define XB_SPIN_CAP (1u << 18)

__device__ __forceinline__ unsigned xb_ld(unsigned* p)              { return __hip_atomic_load(p, __ATOMIC_RELAXED, __HIP_MEMORY_SCOPE_AGENT); }
__device__ __forceinline__ unsigned xb_add(unsigned* p, unsigned v) { return __hip_atomic_fetch_add(p, v, __ATOMIC_RELAXED, __HIP_MEMORY_SCOPE_AGENT); }
__device__ __forceinline__ unsigned xb_xcc_id() { return (unsigned)__builtin_amdgcn_s_getreg((3 << 11) | 20) & 0xFu; }
#define XB_SPIN(cond, bar) do { unsigned _sp = 0; while (cond) { __builtin_amdgcn_s_sleep(1); \
    if ((++_sp & 255u) == 0u) { if (xb_ld(&(bar)[XB_TMO])) break; if (_sp > XB_SPIN_CAP) { atomicAdd(&(bar)[XB_TMO], 1u); break; } } } } while (0)

struct XcdBarrier {
    unsigned* bar; unsigned x;
    volatile LAS unsigned* st;
};

__device__ __forceinline__ XcdBarrier xcd_barrier_post(unsigned* bar, volatile LAS unsigned* st) {
    XcdBarrier b; b.bar = bar; b.x = xb_xcc_id(); b.st = st;
    if (threadIdx.x == 0) (void)xb_add(&bar[XB_XCNT(b.x)], 1u);
    return b;
}
__device__ __forceinline__ void xcd_barrier_complete(unsigned* bar, unsigned x, unsigned& nloc, unsigned& nx) {
    const unsigned G = gridDim.x * gridDim.y * gridDim.z;
    unsigned sum, cnt, mine, sp = 0u;
    for (;;) {
        sum = 0u; cnt = 0u; mine = 0u;
#pragma unroll
        for (unsigned j = 0; j < 16; ++j) { const unsigned c = xb_ld(&bar[XB_XCNT(j)]); sum += c; cnt += (c > 0u) ? 1u : 0u; mine = (j == x) ? c : mine; }
        if (sum == G) break;
        __builtin_amdgcn_s_sleep(1);
        if ((++sp & 255u) == 0u) { if (xb_ld(&bar[XB_TMO])) break; if (sp > XB_SPIN_CAP) { atomicAdd(&bar[XB_TMO], 1u); break; } }
    }
    nloc = mine > 0u ? mine : 1u; nx = cnt > 0u ? cnt : 1u;
}

__device__ __forceinline__ void xcd_barrier(const XcdBarrier& b) {
    asm volatile("s_waitcnt vmcnt(0)" ::: "memory");
    __syncthreads();
    if (threadIdx.x == 0) {
        unsigned* bar = b.bar;
        __builtin_amdgcn_s_waitcnt(0);
        unsigned nloc = b.st[0], nx = b.st[1];
        if (nloc == 0u) { xcd_barrier_complete(bar, b.x, nloc, nx); b.st[0] = nloc; b.st[1] = nx; }
        const unsigned old = xb_add(&bar[XB_XSUB(b.x)], 1u);
        const unsigned gen = old / nloc;
        if (old + 1u == (gen + 1u) * nloc) {
            __builtin_amdgcn_fence(__ATOMIC_RELEASE, "agent");
            asm volatile("s_waitcnt vmcnt(0)" ::: "memory");
            const unsigned og = xb_add(&bar[XB_TOP], 1u);
            const unsigned tg = og / nx;
            if (og + 1u == (tg + 1u) * nx) xb_add(&bar[XB_TOPGEN], 1u);
            else XB_SPIN(xb_ld(&bar[XB_TOPGEN]) == tg, bar);
            __builtin_amdgcn_fence(__ATOMIC_ACQUIRE, "agent");
            xb_add(&bar[XB_XGEN(b.x)], 1u);
            asm volatile("s_waitcnt vmcnt(0)" ::: "memory");
        } else {
            XB_SPIN(xb_ld(&bar[XB_XGEN(b.x)]) == gen, bar);
            __builtin_amdgcn_fence(__ATOMIC_ACQUIRE, "agent");
            asm volatile("s_waitcnt vmcnt(0)" ::: "memory");
        }
    }
    __syncthreads();
}

__global__ void __launch_bounds__(NTHR) fwd_megakernel(Args A) {
    extern __shared__ __attribute__((aligned(16))) unsigned char lds_raw[];
    cg::grid_group grid = cg::this_grid();
    unsigned long long pb_t0 = 0; if (PROBE_K >= 0) pb_t0 = __builtin_amdgcn_s_memrealtime();
#define PB_SPIN() do { const unsigned long long dt_ = __builtin_amdgcn_s_memrealtime() - pb_t0; const unsigned long long t1_ = __builtin_amdgcn_s_memrealtime(); while (__builtin_amdgcn_s_memrealtime() - t1_ < dt_) __builtin_amdgcn_s_sleep(4); } while (0)
#define SYNC(k) do { if (PROBE_K == (k)) PB_SPIN(); xcd_barrier(xbar); if (PROBE_K >= 0) pb_t0 = __builtin_amdgcn_s_memrealtime(); } while (0)
    LAS unsigned char* L = (LAS unsigned char*)lds_raw;
    if (threadIdx.x < 2) ((volatile LAS unsigned*)(L + LDS_BARW))[threadIdx.x] = 0u;
    __syncthreads();
    if (A.ws == nullptr) grid.sync();
    const XcdBarrier xbar = xcd_barrier_post((unsigned*)A.ws, (volatile LAS unsigned*)(L + LDS_BARW));
    const int G = gridDim.x, blk = blockIdx.x, NGW = G * NWAVES;
#define ROW_LOOP(m) for (int ri_ = 0, m = 0; ri_ < (NGW == 2048 ? (gw < 1024 ? 8 : 9) : (M - gw + NGW - 1) / NGW) && ((m = (NGW == 2048 ? (gw < 1024 ? (ri_ == 0 ? MP + gw : gw * 7 + ri_ - 1) : 7168 + (gw - 1024) * 9 + ri_) : gw + ri_ * NGW)), true); ++ri_)
#define ROWS_IN_FLIGHT 4
#define ROW_PASS2(HAS_H_, XS, PT, HB) do { if (NGW != 2048) { ROW_LOOP(m) row_op<true, HAS_H_>(XS(m), GO + (size_t)m * DM, PT(m), ga, A.out + (size_t)m * DM, gb, (HB) + (size_t)m * DM, lane); } else { \
        if (gw < 1024) { const int ms_ = MP + gw; row_op<true, HAS_H_>(XS(ms_), GO + (size_t)ms_ * DM, PT(ms_), ga, A.out + (size_t)ms_ * DM, gb, (HB) + (size_t)ms_ * DM, lane); } \
        const int nr_ = gw < 1024 ? 7 : 9, r0_ = gw < 1024 ? gw * 7 : 7168 + (gw - 1024) * 9; \
        _Pragma("unroll 1") for (int i_ = 0; i_ < nr_; i_ += ROWS_IN_FLIGHT) { const size_t o_ = (size_t)(r0_ + i_) * DM; row_opN<true, HAS_H_, ROWS_IN_FLIGHT>(XS(r0_ + i_), DM, GO + o_, ga, A.out + o_, gb, (HB) + o_, DM, lane, nr_ - i_); } } } while (0)
#define PHASE_IDS() const int tid = opaque_tid(), lane = tid & 63, wave = __builtin_amdgcn_readfirstlane(tid >> 6), gw = blk * NWAVES + wave; (void)tid; (void)lane; (void)gw
    unsigned char* ws = A.ws;
    bf16* H = (bf16*)(ws + WS_H); bf16* GO = (bf16*)(ws + WS_GO); bf16* Zb = (bf16*)(ws + WS_Z); bf16* MIX = (bf16*)(ws + WS_MIX); bf16* HMID = (bf16*)(ws + WS_BIG);
    float* LR = (float*)(ws + WS_LR);

    {
        PHASE_IDS();
        convert_layer_weights(L, A, 0, gw, NGW, wave, lane, 0, (G == 256) ? 640 : 2944);
        if (G != 256) convert_layer_weights(L, A, 1, gw, NGW, wave, lane);
        const int gt = blk * NTHR + tid, NGT = G * NTHR;
        for (int idx = gt; idx < 2 * 16 * 1024; idx += NGT) { const int l = idx >> 14, j = (idx >> 10) & 15, k = idx & 1023;
            ((bf16*)(ws + WS_W + (size_t)l * LAYER_W + W_LR))[j * 1024 + k] = f2bf(A.in[I_WIN][(size_t)l * DM * DIN + (size_t)k * DIN + 1536 + j]); }
        for (int idx = gt; idx < 2 * 8 * 128 * 64; idx += NGT) { const int l = idx >> 16, g = (idx >> 13) & 7, n = (idx >> 6) & 127, k = idx & 63;
            const float v = n < 64 ? A.in[I_WA][((size_t)(l * 8 + g) * 64 + k) * 64 + n] : A.in[I_WX][((size_t)(l * 8 + g) * 64 + k) * 64 + n - 64];
            ((bf16*)(ws + WS_W + (size_t)l * LAYER_W + W_RG))[(g * 128 + n) * 64 + k] = f2bf(v); }
        f32x4 gz[4], gb[4];
#pragma unroll
        for (int j = 0; j < 4; ++j) gz[j] = (f32x4){0.f, 0.f, 0.f, 0.f};
        load_g(A.in[I_GPRE], lane, gb);
        if (NGW != 2048) { for (int m = gw; m < M; m += NGW) row_op<false, true>(xrow_in(A, m), nullptr, nullptr, gz, nullptr, gb, H + (size_t)m * DM, lane); }
        else {
            _Pragma("unroll 1") for (int k0 = 0; k0 < 8; k0 += 4) { const size_t o_ = (size_t)(gw + 2048 * k0) * DM; row_opN<false, true, 4>(A.in[I_XP] + o_, (size_t)2048 * DM, nullptr, gz, nullptr, gb, H + o_, (size_t)2048 * DM, lane, 4); }
            if (gw < 1024) row_op<false, true>(A.in[I_XS] + (size_t)gw * DM, nullptr, nullptr, gz, nullptr, gb, H + (size_t)(MP + gw) * DM, lane);
        }
    }
    SYNC(0);

#pragma unroll
    for (int l = 0; l < 2; ++l) {
        const bf16* wl = (const bf16*)(ws + WS_W + (size_t)l * LAYER_W);
        {
            const bf16* Hin = (l == 0) ? H : MIX;
            pg8::Gemm g{Hin, wl + W_IN / 2, M, NZ, DM}; pg8::StaticOrder S; S.init(M, NZ, DM, G, blk);
            pg8::EpiBf16<0> E{Zb, NZ, nullptr};
            pg8::gemm_phase<pg8::EpiBf16<0>, pg8::StaticOrder, true, true>(L, g, S, E);
            PHASE_IDS();
            const int r = lane & 15, q = lane >> 4; const bf16* wlr = wl + W_LR / 2;
            const int lr_first = (G == 256) ? 168 : 0, lr_nw = (G - lr_first) * NWAVES;
            for (int grp = (blk >= lr_first ? (blk - lr_first) * NWAVES + wave : M), cnt_ = 0; grp < M / 16 && cnt_ < 64; grp += lr_nw, ++cnt_) {
                f32x4 acc = (f32x4){0.f, 0.f, 0.f, 0.f};
                const bf16* ap = Hin + (size_t)(grp * 16 + r) * DM + q * 8; const bf16* bp = wlr + r * DM + q * 8;
#pragma unroll 8
                for (int k0 = 0; k0 < DM; k0 += 32) { const bf16x8 av = *(const bf16x8*)(ap + k0), bv = *(const bf16x8*)(bp + k0); acc = __builtin_amdgcn_mfma_f32_16x16x32_bf16(av, bv, acc, 0, 0, 0); }
#pragma unroll
                for (int i = 0; i < 4; ++i) LR[(size_t)(grp * 16 + q * 4 + i) * 16 + r] = acc[i];
            }
            if (l == 0 && G == 256 && blk >= 168) convert_layer_weights(L, A, 0, (blk - 168) * NWAVES + wave, 88 * NWAVES, wave, lane, 640, 2944);
        }
        SYNC(1);
        for (int it = blk; it < 1408; it += G) {
            if (it < 256) rg_item(L, A, l, 0, it >> 5, it & 31);
            else if (it < 1280) { const int j = it - 256; if (!(G == 256 && blk >= 128 && blk < 160 && j >= 768)) gla_item<1>(L, A, l, j >> 7, (j >> 5) & 3, j & 31); }
            else { const int j = it - 1280; gla_item<0>(L, A, l, j >> 2, j & 3, 0); }
        }
        if (G == 256 && blk >= 160 && blk < 192) { const int j = (blk - 32) + 768; gla_item<1>(L, A, l, j >> 7, (j >> 5) & 3, j & 31); }
        for (int s = blk; s < 160; s += G) if (s >= 128) rg_item(L, A, l, 1, s - 128, 0);
        SYNC(2);
        { PHASE_IDS(); gla_scan(A, l, blk * NTHR + tid, G * NTHR); rg_prefix(A, l, blk * NTHR + tid, G * NTHR); }
        SYNC(3);
        for (int it = blk; it < 256; it += G) rg_out(A, l, 0, it >> 5, it & 31);
        for (int s = blk; s < 160; s += G) if (s >= 128) rg_out(A, l, 1, s - 128, 0);
        gla_loop<2>(L, A, l, blk, G, 1024);
        SYNC(4);
        {
            pg8::Gemm g{MIX, wl + W_OUT / 2, M, DM, DM}; pg8::SplitOrder S; S.init(DM, G, blk, 8);
            pg8::EpiBf16<0> E{GO, DM, (float*)(ws + WS_Z)};
            pg8::gemm_phase<pg8::EpiBf16<0>, pg8::SplitOrder, true, true>(L, g, S, E);
        }
        SYNC(5);
        {
            PHASE_IDS();
            f32x4 ga[4], gb[4]; load_g(A.in[I_GPOST] + l * DM, lane, ga); load_g(A.in[I_GPREFF] + l * DM, lane, gb);
#define XS4(m) ((l == 0) ? xrow_in(A, (m)) : (const float*)(A.out + (size_t)(m) * DM))
#define PT4(m) ((m) >= MP ? (const float*)((const bf16*)(ws + WS_Z) + (size_t)((m) - MP) * DM) : (const float*)nullptr)
            ROW_PASS2(true, XS4, PT4, H);
        }
        SYNC(6);
        {
            pg8::Gemm g{H, wl + W_FF1 / 2, M, FF, DM}; pg8::StaticOrder S; S.init(M, FF, DM, G, blk);
            pg8::EpiBf16<2> E{HMID, FF, nullptr};
            pg8::gemm_phase<pg8::EpiBf16<2>, pg8::StaticOrder, true, true>(L, g, S, E);
            if (l == 0 && G == 256 && blk >= 64) { PHASE_IDS(); convert_layer_weights(L, A, 1, (blk - 64) * NWAVES + wave, 192 * NWAVES, wave, lane); }
        }
        SYNC(7);
        {
            pg8::Gemm g{HMID, wl + W_FF2 / 2, M, DM, FF}; pg8::SplitOrder S; S.init(FF, G, blk, 8);
            pg8::EpiBf16<0> E{GO, DM, (float*)(ws + WS_H)};
            pg8::gemm_phase<pg8::EpiBf16<0>, pg8::SplitOrder, true, true>(L, g, S, E);
        }
        SYNC(8);
        {
            PHASE_IDS();
            f32x4 ga[4], gb[4]; load_g(A.in[I_GPOSTFF] + l * DM, lane, ga); load_g(A.in[I_GPRE] + DM, lane, gb);
#define XS7(m) ((const float*)(A.out + (size_t)(m) * DM))
#define PT7(m) ((m) >= MP ? (const float*)((const bf16*)(ws + WS_H) + (size_t)((m) - MP) * DM) : (const float*)nullptr)
            if (l == 0) { ROW_PASS2(true, XS7, PT7, MIX); SYNC(9); }
            else { ROW_PASS2(false, XS7, PT7, MIX); }
        }
    }
    if (PROBE_K == 9) PB_SPIN();
    if (PROBE_K == 100) { for (int i = 0; i < 20; ++i) xcd_barrier(xbar); }
}

extern "C" void kernel_launch(void* const* d_in, const int* in_sizes, int n_in, void* d_out, int out_size, void* d_ws, size_t ws_size, hipStream_t stream) {
    static int grid_blocks = 0;
    if (grid_blocks == 0) {
        if (n_in != 23 || (size_t)out_size != OUT_TOTAL || ws_size < WS_END) { fprintf(stderr, "kernel_launch: unexpected shapes n_in=%d out=%d ws=%zu\n", n_in, out_size, ws_size); grid_blocks = -1; return; }
        int dev = 0, cus = 0, per_cu = 0;
        hipGetDevice(&dev);
        hipDeviceGetAttribute(&cus, hipDeviceAttributeMultiprocessorCount, dev);
        hipFuncSetAttribute((const void*)fwd_megakernel, hipFuncAttributeMaxDynamicSharedMemorySize, LDS_BYTES);
        hipOccupancyMaxActiveBlocksPerMultiprocessor(&per_cu, (const void*)fwd_megakernel, NTHR, LDS_BYTES);
        if (per_cu < 1) { fprintf(stderr, "kernel_launch: occupancy query says %d blocks/CU\n", per_cu); per_cu = 1; }
        (void)hipGetLastError();
        grid_blocks = cus * per_cu;
    }
    if (grid_blocks < 0) return;
    if (hipMemsetAsync(d_ws, 0, 16384, stream) != hipSuccess) { fprintf(stderr, "kernel_launch: memset failed\n"); return; }
    Args a{};
    for (int i = 0; i < 23; ++i) a.in[i] = (const float*)d_in[i];
    a.out = (float*)d_out; a.ws = (unsigned char*)d_ws;
    void* args[] = {&a};
    hipError_t e = hipLaunchCooperativeKernel((const void*)fwd_megakernel, dim3(grid_blocks), dim3(NTHR), args, LDS_BYTES, stream);
    if (e != hipSuccess) fprintf(stderr, "cooperative launch failed: %s (grid %d)\n", hipGetErrorString(e), grid_blocks);
}
```

```cpp
#include <hip/hip_runtime.h>
#include <hip/hip_cooperative_groups.h>
#include <cstdio>
#include <cstdint>
namespace cg = cooperative_groups;
#define PROBE_K (-1)
#define SEC_BEGIN(k) unsigned long long sec_t0_ = 0; if (PROBE_K == (k)) sec_t0_ = __builtin_amdgcn_s_memrealtime()
#define SEC_MARK(k) do { if (PROBE_K == (k)) sec_t0_ = __builtin_amdgcn_s_memrealtime(); } while (0)
#define SEC_END(k) do { if (PROBE_K == (k)) { const unsigned long long dt_ = __builtin_amdgcn_s_memrealtime() - sec_t0_; const unsigned long long t1_ = __builtin_amdgcn_s_memrealtime(); while (__builtin_amdgcn_s_memrealtime() - t1_ < dt_) __builtin_amdgcn_s_sleep(2); } } while (0)
__device__ __forceinline__ int opaque_tid() { int t = threadIdx.x; asm volatile("" : "+v"(t)); return t; }
namespace pg8 {
#define PG8_LAS __attribute__((address_space(3)))
typedef unsigned short bf16_t;
typedef short bf16x8 __attribute__((ext_vector_type(8)));
typedef float f32x4 __attribute__((ext_vector_type(4)));
typedef unsigned u32x4 __attribute__((ext_vector_type(4)));
constexpr int BM = 256, BK = 64, HALF = 128, HTB = HALF * BK * 2  , STAGE_BYTES = 8 * HTB, NXCD = 8, WGM = 8;

__host__ __device__ __forceinline__ int lds_byte(int r, int c) { const int st = (r >> 4) * 2 + (c >> 5), rr = r & 15, cc = c & 31, ob = rr * 64 + cc * 2; return st * 1024 + (ob ^ (((ob >> 9) & 1) << 5)); }
__host__ __device__ __forceinline__ void stage_rc(int b, int& R, int& C) { const int st = b / 1024, sb = b % 1024, swz = sb ^ (((sb >> 9) & 1) << 5); R = (st >> 1) * 16 + swz / 64; C = (st & 1) * 32 + (swz % 64) / 2; }
__host__ __device__ __forceinline__ int perm32(int rho) { const int n = rho >> 4, i = rho & 15; return 8 * (i >> 2) + 4 * n + (i & 3); }

struct Unit { int pm, pn, k0, nt, ks; };
struct Gemm { const bf16_t* A; const bf16_t* Bt; int M, N, K; };

struct StaticOrder {
    int nM, nN, nwg, G, c, ntf;
    __host__ __device__ void init(int M, int N, int K, int G_, int c_) { nM = M / BM; nN = N / BM; nwg = nM * nN; G = G_; c = c_; ntf = K / BK; }
    __host__ __device__ void map(int wgid, Unit& u) const { { const int q = nwg / NXCD, r = nwg % NXCD, xcd = wgid % NXCD, off = wgid / NXCD; wgid = (xcd < r ? xcd * (q + 1) : r * (q + 1) + (xcd - r) * q) + off; }
        const int nig = WGM * nN, gid = wgid / nig, fm = gid * WGM, gsz = (nM - fm) < WGM ? (nM - fm) : WGM;
        u.pm = fm + ((wgid % nig) % gsz); u.pn = (wgid % nig) / gsz; u.k0 = 0; u.nt = ntf; u.ks = -1; }
    __host__ __device__ bool next(int i, Unit& u) const { const long L = (long)i * G + c; if (L >= nwg) return false; map((int)L, u); return true; }
    __device__ __forceinline__ void a_ready(const Unit&) const {}
    __device__ __forceinline__ void done(const Unit&) const {}
};
struct SplitOrder {
    StaticOrder P; int nsplit, ntsub;
    __host__ __device__ void init(int K, int G_, int c_, int nsplit_) { P.init(16384, 1024, K, G_, c_); nsplit = nsplit_; ntsub = K / BK / nsplit_; }
    __host__ __device__ bool next(int i, Unit& u) const { const long L = (long)i * P.G + P.c; if (L < 256) { P.map((int)L, u); return true; }
        const int s = (int)(L - 256); if (s >= 16 * nsplit) return false; const int su = s / nsplit, ks = s % nsplit; u.pm = 64 + (su >> 2); u.pn = su & 3; u.k0 = ks * ntsub * BK; u.nt = ntsub; u.ks = ks; return true; }
    __device__ __forceinline__ void a_ready(const Unit&) const {}
    __device__ __forceinline__ void done(const Unit&) const {}
};


__device__ __forceinline__ unsigned cvt_pk_bf16(float lo, float hi) { unsigned r; asm volatile("v_cvt_pk_bf16_f32 %0, %1, %2" : "=v"(r) : "v"(lo), "v"(hi)); return r; }
template <int ACT> struct EpiBf16 {
    static constexpr bool PERM = true, AFTER_DRAIN = false;
    bf16_t* O; int ldc; float* part;
    __device__ __forceinline__ void operator()(const f32x4 (&acc)[2][2][4][2], const Unit& u, int wr, int wc, int fr, int fq) const {
        const int row0 = u.pm * BM + wr * 64 + fr; const int col0 = u.pn * BM + wc * 32 + 8 * fq;
        if (u.ks >= 0) {
#pragma unroll
            for (int ai = 0; ai < 2; ++ai)
#pragma unroll
                for (int m = 0; m < 4; ++m) { bf16_t* rowp = (bf16_t*)part + ((size_t)u.ks << 20) + (size_t)(row0 - 16384 + ai * HALF + m * 16) * 1024 + col0;
#pragma unroll
                    for (int bj = 0; bj < 2; ++bj) { const f32x4 v0 = acc[ai][bj][m][0], v1 = acc[ai][bj][m][1]; u32x4 w; w.x = cvt_pk_bf16(v0[0], v0[1]); w.y = cvt_pk_bf16(v0[2], v0[3]); w.z = cvt_pk_bf16(v1[0], v1[1]); w.w = cvt_pk_bf16(v1[2], v1[3]); *(u32x4*)(rowp + bj * HALF) = w; } }
            return;
        }
#pragma unroll
        for (int ai = 0; ai < 2; ++ai)
#pragma unroll
            for (int m = 0; m < 4; ++m) { bf16_t* rowp = O + (size_t)(row0 + ai * HALF + m * 16) * ldc + col0;
#pragma unroll
                for (int bj = 0; bj < 2; ++bj) { f32x4 v0 = acc[ai][bj][m][0], v1 = acc[ai][bj][m][1];
                    if (ACT == 2) {
#pragma unroll
                        for (int e = 0; e < 4; ++e) { float a = fmaxf(v0[e], 0.f), b = fmaxf(v1[e], 0.f); v0[e] = a * a; v1[e] = b * b; }
                    }
                    u32x4 w; w.x = cvt_pk_bf16(v0[0], v0[1]); w.y = cvt_pk_bf16(v0[2], v0[3]); w.z = cvt_pk_bf16(v1[0], v1[1]); w.w = cvt_pk_bf16(v1[2], v1[3]);
                    *(u32x4*)(rowp + bj * HALF) = w; } }
    }
};

template <class Epi, class Sched, bool ALIGN_EPI = false, bool SP2 = false>
__device__ __forceinline__ void gemm_phase(PG8_LAS unsigned char* lds, const Gemm g, const Sched& S, const Epi& E) {
    const int tid = opaque_tid(), wid = __builtin_amdgcn_readfirstlane(tid >> 6), lane = tid & 63, wr = wid >> 2, wc = wid & 3, fr = lane & 15, fq = lane >> 4;
    const int K = g.K;
    unsigned voffA[2], voffB[2];
#pragma unroll
    for (int i = 0; i < 2; ++i) { int R, C; stage_rc(tid * 16 + i * 8192, R, C); const int Rb = Epi::PERM ? ((R & ~31) + perm32(R & 31)) : R;
        voffA[i] = (unsigned)(R * K + C) * 2u; voffB[i] = (unsigned)(Rb * K + C) * 2u; }
    const size_t kstep = (size_t)(BK * 2);
    const size_t hstep = (size_t)HALF * K * 2;
    const size_t tstep = 2 * hstep;
    const unsigned ldsw = (unsigned)wid * 1024u;
    const int aoff = lds_byte(wr * 64 + fr, fq * 8), boff = lds_byte(wc * 32 + fr, fq * 8);
#define PG8_SA(b, h) (((b) * 2 + (h)) * HTB)
#define PG8_SB(b, h) ((4 + (b) * 2 + (h)) * HTB)
#define PG8_STAGE(bufoff, gbase, voff) do { _Pragma("unroll") for (int _i = 0; _i < 2; ++_i) \
        __builtin_amdgcn_global_load_lds((const unsigned*)((const char*)(gbase) + (voff)[_i]), (PG8_LAS unsigned*)(lds + (bufoff) + ldsw + _i * 8192), 16, 0, 0); } while (0)
#define PG8_LDA(dst, b, h) do { _Pragma("unroll") for (int m = 0; m < 4; ++m) _Pragma("unroll") for (int k = 0; k < 2; ++k) dst[m][k] = *(const PG8_LAS bf16x8*)(lds + PG8_SA(b, h) + aoff + m * 2048 + k * 1024); } while (0)
#define PG8_LDB(dst, b, h) do { _Pragma("unroll") for (int n = 0; n < 2; ++n) _Pragma("unroll") for (int k = 0; k < 2; ++k) dst[n][k] = *(const PG8_LAS bf16x8*)(lds + PG8_SB(b, h) + boff + n * 2048 + k * 1024); } while (0)
#define PG8_MMA(ai, bj, At, Bt) do { __builtin_amdgcn_s_setprio(1); _Pragma("unroll") for (int m = 0; m < 4; ++m) _Pragma("unroll") for (int n = 0; n < 2; ++n) _Pragma("unroll") for (int k = 0; k < 2; ++k) \
        acc[ai][bj][m][n] = __builtin_amdgcn_mfma_f32_16x16x32_bf16(Bt[n][k], At[m][k], acc[ai][bj][m][n], 0, 0, 0); __builtin_amdgcn_s_setprio(0); } while (0)
#define PG8_WAIT_V(n) asm volatile("s_waitcnt vmcnt(" #n ")" ::: "memory")
#define PG8_WAIT_L(n) asm volatile("s_waitcnt lgkmcnt(" #n ")" ::: "memory")
#define PG8_BAR __builtin_amdgcn_s_barrier()
#define PG8_SCHED __builtin_amdgcn_sched_barrier(0)
    Unit cur, nxt; int ui = 0;
    if (!S.next(0, cur)) return;
    f32x4 acc[2][2][4][2];
#pragma unroll
    for (int a = 0; a < 2; ++a)
#pragma unroll
        for (int b = 0; b < 2; ++b)
#pragma unroll
            for (int m = 0; m < 4; ++m)
#pragma unroll
                for (int n = 0; n < 2; ++n) acc[a][b][m][n] = (f32x4){0.f, 0.f, 0.f, 0.f};
    bf16x8 At[4][2], B0[2][2], B1[2][2];
    const char* cA = (const char*)g.A + (size_t)cur.pm * tstep + (size_t)cur.k0 * 2; const char* cB = (const char*)g.Bt + (size_t)cur.pn * tstep + (size_t)cur.k0 * 2;
    S.a_ready(cur);
    if constexpr (SP2) {
        PG8_STAGE(PG8_SB(0, 0), cB, voffB); PG8_STAGE(PG8_SB(0, 1), cB + hstep, voffB); PG8_STAGE(PG8_SA(0, 0), cA, voffA); PG8_STAGE(PG8_SA(0, 1), cA + hstep, voffA);
        if (wr == 1) PG8_BAR;
        PG8_WAIT_V(2); PG8_BAR;
        PG8_STAGE(PG8_SB(1, 0), cB + kstep, voffB); PG8_STAGE(PG8_SA(1, 0), cA + kstep, voffA); PG8_STAGE(PG8_SB(1, 1), cB + hstep + kstep, voffB);
        PG8_WAIT_V(6); PG8_BAR;
    } else {
        PG8_STAGE(PG8_SB(0, 0), cB, voffB); PG8_STAGE(PG8_SA(0, 0), cA, voffA); PG8_STAGE(PG8_SB(0, 1), cB + hstep, voffB); PG8_STAGE(PG8_SA(0, 1), cA + hstep, voffA);
        if (wr == 1) PG8_BAR;
        PG8_WAIT_V(4); PG8_BAR;
        PG8_STAGE(PG8_SB(1, 0), cB + kstep, voffB); PG8_STAGE(PG8_SA(1, 0), cA + kstep, voffA); PG8_STAGE(PG8_SB(1, 1), cB + hstep + kstep, voffB);
        PG8_WAIT_V(6); PG8_BAR;
    }
    for (;;) {
        const bool has_next = S.next(ui + 1, nxt);
        const char* nA = has_next ? (const char*)g.A + (size_t)nxt.pm * tstep + (size_t)nxt.k0 * 2 : cA; const char* nB = has_next ? (const char*)g.Bt + (size_t)nxt.pn * tstep + (size_t)nxt.k0 * 2 : cB;
        const int nt = cur.nt;
        for (int t = 0; t < nt; t += 2) {
            const bool last = (t == nt - 2);
            const char* a1 = cA + (size_t)(t + 1) * kstep;
            const char* a2 = last ? nA : cA + (size_t)(t + 2) * kstep; const char* b2 = last ? nB : cB + (size_t)(t + 2) * kstep;
            const char* a3 = a2 + kstep; const char* b3 = b2 + kstep;
            if (last && has_next) S.a_ready(nxt);
            if constexpr (SP2) {
            PG8_LDB(B0, 0, 0); PG8_LDB(B1, 0, 1); PG8_SCHED; PG8_LDA(At, 0, 0); PG8_STAGE(PG8_SA(1, 1), a1 + hstep, voffA);
            PG8_WAIT_V(8); PG8_WAIT_L(0); PG8_BAR; PG8_MMA(0, 0, At, B0); PG8_MMA(0, 1, At, B1); PG8_BAR; PG8_SCHED;
            PG8_LDA(At, 0, 1); PG8_STAGE(PG8_SB(0, 0), b2, voffB); PG8_STAGE(PG8_SB(0, 1), b2 + hstep, voffB); PG8_STAGE(PG8_SA(0, 0), a2, voffA);
            PG8_WAIT_V(8); PG8_WAIT_L(0); PG8_BAR; PG8_MMA(1, 0, At, B0); PG8_MMA(1, 1, At, B1); PG8_BAR; PG8_SCHED;
            PG8_LDB(B0, 1, 0); PG8_LDB(B1, 1, 1); PG8_SCHED; PG8_LDA(At, 1, 0); PG8_STAGE(PG8_SA(0, 1), a2 + hstep, voffA);
            PG8_WAIT_V(8); PG8_WAIT_L(0); PG8_BAR; PG8_MMA(0, 0, At, B0); PG8_MMA(0, 1, At, B1); PG8_BAR; PG8_SCHED;
            PG8_LDA(At, 1, 1); PG8_STAGE(PG8_SB(1, 0), b3, voffB); PG8_STAGE(PG8_SB(1, 1), b3 + hstep, voffB); PG8_STAGE(PG8_SA(1, 0), a3, voffA);
            PG8_WAIT_V(8); PG8_WAIT_L(0); PG8_BAR; PG8_MMA(1, 0, At, B0); PG8_MMA(1, 1, At, B1); PG8_BAR; PG8_SCHED;
            } else {
            PG8_LDB(B0, 0, 0); PG8_SCHED; PG8_LDA(At, 0, 0); PG8_STAGE(PG8_SA(1, 1), a1 + hstep, voffA);
            PG8_WAIT_L(8); PG8_BAR; PG8_WAIT_L(0); PG8_MMA(0, 0, At, B0); PG8_BAR; PG8_SCHED;
            PG8_LDB(B1, 0, 1); PG8_STAGE(PG8_SB(0, 0), b2, voffB);
            PG8_BAR; PG8_WAIT_L(0); PG8_MMA(0, 1, At, B1); PG8_BAR;
            PG8_LDA(At, 0, 1); PG8_STAGE(PG8_SA(0, 0), a2, voffA);
            PG8_BAR; PG8_WAIT_L(0); PG8_MMA(1, 0, At, B0); PG8_BAR; PG8_SCHED;
            PG8_STAGE(PG8_SB(0, 1), b2 + hstep, voffB);
            PG8_WAIT_V(6); PG8_BAR; PG8_MMA(1, 1, At, B1); PG8_BAR;
            PG8_LDB(B0, 1, 0); PG8_SCHED; PG8_LDA(At, 1, 0); PG8_STAGE(PG8_SA(0, 1), a2 + hstep, voffA);
            PG8_WAIT_L(8); PG8_BAR; PG8_WAIT_L(0); PG8_MMA(0, 0, At, B0); PG8_BAR; PG8_SCHED;
            PG8_LDB(B1, 1, 1); PG8_STAGE(PG8_SB(1, 0), b3, voffB);
            PG8_BAR; PG8_WAIT_L(0); PG8_MMA(0, 1, At, B1); PG8_BAR;
            PG8_LDA(At, 1, 1); PG8_STAGE(PG8_SA(1, 0), a3, voffA);
            PG8_BAR; PG8_WAIT_L(0); PG8_MMA(1, 0, At, B0); PG8_BAR; PG8_SCHED;
            PG8_STAGE(PG8_SB(1, 1), b3 + hstep, voffB);
            PG8_WAIT_V(6); PG8_BAR; PG8_MMA(1, 1, At, B1); PG8_BAR;
            }
        }
        if constexpr (ALIGN_EPI) { if (wr == 0) PG8_BAR; }
        if constexpr (!Epi::AFTER_DRAIN) { E(acc, cur, wr, wc, fr, fq); S.done(cur); }
        if (!has_next) break;
#pragma unroll
        for (int a = 0; a < 2; ++a)
#pragma unroll
            for (int b = 0; b < 2; ++b)
#pragma unroll
                for (int m = 0; m < 4; ++m)
#pragma unroll
                    for (int n = 0; n < 2; ++n) acc[a][b][m][n] = (f32x4){0.f, 0.f, 0.f, 0.f};
        cur = nxt; cA = nA; cB = nB; ++ui;
        if constexpr (ALIGN_EPI) { if (wr == 1) PG8_BAR; }
    }
    PG8_WAIT_V(0);
    if constexpr (!ALIGN_EPI) { if (wr == 0) PG8_BAR; }
    PG8_BAR;
    if constexpr (Epi::AFTER_DRAIN) { E.fused(acc, cur, wr, wc, fr, fq, lds, wid, lane); S.done(cur); }
#undef PG8_SA
#undef PG8_SB
#undef PG8_STAGE
#undef PG8_LDA
#undef PG8_LDB
#undef PG8_MMA
#undef PG8_WAIT_V
#undef PG8_WAIT_L
#undef PG8_BAR
#undef PG8_SCHED
}
}

#define LAS __attribute__((address_space(3)))
typedef unsigned short bf16;
typedef float f32x4 __attribute__((ext_vector_type(4)));
typedef float f32x2 __attribute__((ext_vector_type(2)));
typedef short bf16x8 __attribute__((ext_vector_type(8)));
typedef unsigned u32x4 __attribute__((ext_vector_type(4)));
typedef unsigned u32x2 __attribute__((ext_vector_type(2)));

constexpr int NWAVES = 8, NTHR = 512;
constexpr int DM = 1024, MP = 16384, MS = 1024, M = MP + MS, DIN = 2576, NZ = 2560, FF = 4096;
constexpr float EPS = 1e-6f;
constexpr size_t MiB = 1u << 20;
constexpr size_t W_IN = 0, W_OUT = W_IN + (size_t)NZ * DM * 2, W_FF1 = W_OUT + (size_t)DM * DM * 2, W_FF2 = W_FF1 + (size_t)FF * DM * 2,
                 W_LR = W_FF2 + (size_t)FF * DM * 2, W_RG = W_LR + 16 * DM * 2, LAYER_W = W_RG + 8 * 128 * 64 * 2;
constexpr size_t WS_W = 1 * MiB, WS_H = 49 * MiB, WS_GO = 83 * MiB, WS_BIG = 117 * MiB, WS_Z = WS_BIG, WS_MIX = WS_BIG + 85 * MiB, WS_DS = WS_BIG + 119 * MiB, WS_DEC = WS_BIG + 135 * MiB, WS_LR = 253 * MiB, WS_CA = 254 * MiB + 256 * 1024, WS_HIN = 255 * MiB + 256 * 1024, WS_END = 256 * MiB;
static_assert(WS_W + 2 * LAYER_W <= WS_H, "weights fit");
static_assert((size_t)M * DM * 2 == 34 * MiB && (size_t)M * NZ * 2 == 85 * MiB && (size_t)M * FF * 2 == 136 * MiB, "sizes");
constexpr size_t OUT_GLA_P = 17825792, OUT_RG_P = 18350080, OUT_CV_P = 18358272, OUT_GLA_S = 18382848, OUT_RG_S = 20480000, OUT_CV_S = 20512768, OUT_TOTAL = 20611072;
constexpr int LDS_BYTES = 147456 + 256, LDS_BARW = 147456;

struct Args { const float* in[23]; float* out; unsigned char* ws; };
enum { I_XP = 0, I_XS, I_SGLA, I_SRG, I_SCV, I_GPRE, I_WIN, I_WLR2, I_BLR, I_GNORM, I_CW, I_CB, I_WA, I_BA, I_WX, I_BX, I_LAM, I_WOUT, I_GPOST, I_GPREFF, I_WFF1, I_WFF2, I_GPOSTFF };

#define LDS_BAR() do { asm volatile("s_waitcnt lgkmcnt(0)" ::: "memory"); __builtin_amdgcn_s_barrier(); asm volatile("" ::: "memory"); } while (0)
#define LDS_WAIT() asm volatile("s_waitcnt lgkmcnt(0)" ::: "memory")

__device__ __forceinline__ unsigned pk2(float lo, float hi) { return pg8::cvt_pk_bf16(lo, hi); }
__device__ __forceinline__ unsigned short f2bf(float f) { return (unsigned short)(pk2(f, 0.f) & 0xffffu); }
__device__ __forceinline__ float bf2f(unsigned short u) { return __uint_as_float(((unsigned)u) << 16); }
__device__ __forceinline__ float blo(unsigned w) { return __uint_as_float(w << 16); }
__device__ __forceinline__ float bhi(unsigned w) { return __uint_as_float(w & 0xffff0000u); }
__device__ __forceinline__ void unpack8(u32x4 v, float (&f)[8]) { f[0] = blo(v.x); f[1] = bhi(v.x); f[2] = blo(v.y); f[3] = bhi(v.y); f[4] = blo(v.z); f[5] = bhi(v.z); f[6] = blo(v.w); f[7] = bhi(v.w); }
__device__ __forceinline__ u32x4 pack8(const float (&f)[8]) { u32x4 o; o.x = pk2(f[0], f[1]); o.y = pk2(f[2], f[3]); o.z = pk2(f[4], f[5]); o.w = pk2(f[6], f[7]); return o; }
__device__ __forceinline__ float wave_sum(float v) {
#pragma unroll
    for (int o = 1; o < 64; o <<= 1) v += __shfl_xor(v, o);
    return v;
}
__device__ __forceinline__ float sigm(float x) { return __builtin_amdgcn_rcpf(1.f + __expf(-x)); }
__device__ __forceinline__ float gelu_tanh(float x) { const float u = 0.7978845608028654f * (x + 0.044715f * x * x * x); const float e = __expf(-2.f * fabsf(u)); float th = (1.f - e) * __builtin_amdgcn_rcpf(1.f + e); th = u < 0.f ? -th : th; return 0.5f * x * (1.f + th); }
__device__ __forceinline__ const float* xrow_in(const Args& A, int m) { return m < MP ? A.in[I_XP] + (size_t)m * DM : A.in[I_XS] + (size_t)(m - MP) * DM; }

__device__ __forceinline__ void p0_transpose_item(const float* W, int ldw, int col0, int K, bf16* WT, int row_off, LAS float* scr, int kb, int nb, int lane) {
    const int k0 = 64 * kb, n0 = 64 * nb;
    f32x4 v[16];
#pragma unroll
    for (int i = 0; i < 16; ++i) v[i] = __builtin_nontemporal_load((const f32x4*)(W + (size_t)(k0 + 4 * i + (lane >> 4)) * ldw + col0 + n0 + (lane & 15) * 4));
#pragma unroll
    for (int i = 0; i < 16; ++i) { LAS float* d = scr + (4 * i + (lane >> 4)) * 65 + (lane & 15) * 4; d[0] = v[i].x; d[1] = v[i].y; d[2] = v[i].z; d[3] = v[i].w; }
    LDS_WAIT(); asm volatile("" ::: "memory");
    const int c = lane & 7;
#pragma unroll
    for (int j = 0; j < 8; ++j) { const int n = (lane >> 3) + 8 * j; const LAS float* s = scr + (8 * c) * 65 + n;
        u32x4 o; o.x = pk2(s[0 * 65], s[1 * 65]); o.y = pk2(s[2 * 65], s[3 * 65]); o.z = pk2(s[4 * 65], s[5 * 65]); o.w = pk2(s[6 * 65], s[7 * 65]);
        *(u32x4*)(WT + (size_t)(row_off + n0 + n) * K + k0 + 8 * c) = o; }
    LDS_WAIT(); asm volatile("" ::: "memory");
}

__device__ __forceinline__ void convert_layer_weights(LAS unsigned char* L, const Args& A, int l, int w0, int nw, int wave, int lane, int r_begin = 0, int r_end = 2944) {
    LAS float* scr = (LAS float*)(L + wave * 16640);
    bf16* wl = (bf16*)(A.ws + WS_W + (size_t)l * LAYER_W);
    const float* win = A.in[I_WIN] + (size_t)l * DM * DIN;
    for (int it = r_begin + w0; it < r_end; it += nw) { int r = it;
        if (r < 384) { p0_transpose_item(win, DIN, 0, DM, wl + W_IN / 2, 0, scr, r / 24, r % 24, lane); }
        else if (r < 640) { r -= 384; p0_transpose_item(win, DIN, 1552, DM, wl + W_IN / 2, 1536, scr, r / 16, r % 16, lane); }
        else if (r < 896) { r -= 640; p0_transpose_item(A.in[I_WOUT] + (size_t)l * DM * DM, DM, 0, DM, wl + W_OUT / 2, 0, scr, r / 16, r % 16, lane); }
        else if (r < 1920) { r -= 896; p0_transpose_item(A.in[I_WFF1] + (size_t)l * DM * FF, FF, 0, DM, wl + W_FF1 / 2, 0, scr, r / 64, r % 64, lane); }
        else { r -= 1920; p0_transpose_item(A.in[I_WFF2] + (size_t)l * FF * DM, DM, 0, FF, wl + W_FF2 / 2, 0, scr, r / 16, r % 16, lane); }
    }
}

template <bool HAS_GO, bool HAS_H>
__device__ __forceinline__ void row_op(const float* xs, const bf16* go, const float* part, const f32x4 (&ga)[4], float* xo, const f32x4 (&gb)[4], bf16* hb, int lane) {
    f32x4 x[4];
#pragma unroll
    for (int j = 0; j < 4; ++j) x[j] = *(const f32x4*)(xs + 4 * lane + 256 * j);
    if (HAS_GO) {
        f32x4 f[4]; float ss = 0.f;
#pragma unroll
        for (int j = 0; j < 4; ++j) {
            if (part) { const bf16* pb = (const bf16*)part; f[j] = (f32x4){0.f, 0.f, 0.f, 0.f};
#pragma unroll
                for (int ks = 0; ks < 8; ++ks) { const u32x2 wv = *(const u32x2*)(pb + ((size_t)ks << 20) + 4 * lane + 256 * j); f[j] = f[j] + (f32x4){blo(wv.x), bhi(wv.x), blo(wv.y), bhi(wv.y)}; } }
            else { const u32x2 wv = *(const u32x2*)(go + 4 * lane + 256 * j); f[j] = (f32x4){blo(wv.x), bhi(wv.x), blo(wv.y), bhi(wv.y)}; }
            ss += (f[j].x * f[j].x + f[j].y * f[j].y) + (f[j].z * f[j].z + f[j].w * f[j].w); }
        const float rstd = rsqrtf(wave_sum(ss) * (1.f / DM) + EPS);
#pragma unroll
        for (int j = 0; j < 4; ++j) { x[j] = x[j] + f[j] * rstd * ga[j]; *(f32x4*)(xo + 4 * lane + 256 * j) = x[j]; }
    }
    if (HAS_H) {
        float s2 = 0.f;
#pragma unroll
        for (int j = 0; j < 4; ++j) s2 += (x[j].x * x[j].x + x[j].y * x[j].y) + (x[j].z * x[j].z + x[j].w * x[j].w);
        const float r2 = rsqrtf(wave_sum(s2) * (1.f / DM) + EPS);
#pragma unroll
        for (int j = 0; j < 4; ++j) { const f32x4 hv = x[j] * r2 * gb[j]; u32x2 o; o.x = pk2(hv.x, hv.y); o.y = pk2(hv.z, hv.w); *(u32x2*)(hb + 4 * lane + 256 * j) = o; }
    }
}
template <bool HAS_GO, bool HAS_H, int NR>
__device__ __forceinline__ void row_opN(const float* xs, size_t xrs, const bf16* go, const f32x4 (&ga)[4], float* xo, const f32x4 (&gb)[4], bf16* hb, size_t rs, int lane, int nv) {
    f32x4 xv[NR][4]; u32x2 gv[NR][4];
#pragma unroll
    for (int rr = 0; rr < NR; ++rr) if (rr < nv) {
#pragma unroll
        for (int j = 0; j < 4; ++j) { xv[rr][j] = __builtin_nontemporal_load((const f32x4*)(xs + rr * xrs + 4 * lane + 256 * j)); if (HAS_GO) gv[rr][j] = __builtin_nontemporal_load((const u32x2*)(go + rr * rs + 4 * lane + 256 * j)); }
    }
#pragma unroll
    for (int rr = 0; rr < NR; ++rr) if (rr < nv) {
        f32x4 x[4]; float s2 = 0.f;
        if (HAS_GO) { f32x4 f[4]; float ss = 0.f;
#pragma unroll
            for (int j = 0; j < 4; ++j) { const u32x2 wv = gv[rr][j]; f[j] = (f32x4){blo(wv.x), bhi(wv.x), blo(wv.y), bhi(wv.y)}; ss += (f[j].x * f[j].x + f[j].y * f[j].y) + (f[j].z * f[j].z + f[j].w * f[j].w); }
            const float rstd = rsqrtf(wave_sum(ss) * (1.f / DM) + EPS);
#pragma unroll
            for (int j = 0; j < 4; ++j) { x[j] = xv[rr][j] + f[j] * rstd * ga[j]; __builtin_nontemporal_store(x[j], (f32x4*)(xo + rr * rs + 4 * lane + 256 * j)); }
        } else {
#pragma unroll
            for (int j = 0; j < 4; ++j) x[j] = xv[rr][j];
        }
        if (HAS_H) {
#pragma unroll
            for (int j = 0; j < 4; ++j) s2 += (x[j].x * x[j].x + x[j].y * x[j].y) + (x[j].z * x[j].z + x[j].w * x[j].w);
            const float r2 = rsqrtf(wave_sum(s2) * (1.f / DM) + EPS);
#pragma unroll
            for (int j = 0; j < 4; ++j) { const f32x4 hv = x[j] * r2 * gb[j]; u32x2 o; o.x = pk2(hv.x, hv.y); o.y = pk2(hv.z, hv.w); *(u32x2*)(hb + rr * rs + 4 * lane + 256 * j) = o; } }
    }
}
__device__ __forceinline__ void load_g(const float* g, int lane, f32x4 (&v)[4]) {
#pragma unroll
    for (int j = 0; j < 4; ++j) v[j] = *(const f32x4*)(g + 4 * lane + 256 * j);
}

template <int MODE>
__device__ __forceinline__ void gla_item(LAS unsigned char* L, const Args& A, int l, int b, int h, int c) {
    const int tid = opaque_tid(), w = __builtin_amdgcn_readfirstlane(tid >> 6), lane = tid & 63, r = lane & 15, q = lane >> 4;
    const int t = tid >> 3, oct = tid & 7, o8 = oct * 8, tsw = t ^ (oct << 3);
    LAS bf16* QT = (LAS bf16*)(L + 0); LAS bf16* KT = (LAS bf16*)(L + 9216); LAS bf16* KHT = (LAS bf16*)(L + 18432); LAS bf16* ATT = (LAS bf16*)(L + 27648);
    LAS bf16* VT = (LAS bf16*)(L + 36864); LAS bf16* ST = (LAS bf16*)(L + 55296); LAS bf16* GS = (LAS bf16*)(L + 73728);
    LAS float* LRS = (LAS float*)(L + 91136); LAS float* WL = (LAS float*)(L + 95232); LAS float* SEG = (LAS float*)(L + 99328);
    LAS float* SSQ = (LAS float*)(L + 101376); LAS float* BL = (LAS float*)(L + 101888);
    constexpr bool SMP = (MODE == 0), DO_OUT = (MODE != 1), DO_S = (MODE != 2);
    const int ntok = SMP ? 32 : 64, row0 = SMP ? MP + b * 32 : b * 2048 + c * 64;
    const int item = (b * 4 + h) * 32 + c;
    const bf16* Z = (const bf16*)(A.ws + WS_Z); bf16* MIX = (bf16*)(A.ws + WS_MIX); const float* LR = (const float*)(A.ws + WS_LR);
    bf16* DS = (bf16*)(A.ws + WS_DS) + (size_t)item * 8192; float* DEC = (float*)(A.ws + WS_DEC) + (size_t)item * 64;
    const bool valid = t < ntok;
    const u32x4 z4 = (u32x4){0u, 0u, 0u, 0u};
    const bf16* zr = Z + (size_t)(row0 + t) * NZ;
    u32x4 rq = z4, rk, rv0, rv1, rg0 = z4, rg1 = z4; f32x2 rl;
    rk = valid ? *(const u32x4*)(zr + 256 + h * 64 + o8) : z4;
    rv0 = valid ? *(const u32x4*)(zr + 512 + h * 128 + o8) : z4; rv1 = valid ? *(const u32x4*)(zr + 512 + h * 128 + 64 + o8) : z4;
    rl = valid ? *(const f32x2*)(LR + (size_t)(row0 + t) * 16 + oct * 2) : (f32x2){0.f, 0.f};
    if (DO_OUT) { rq = valid ? *(const u32x4*)(zr + h * 64 + o8) : z4; rg0 = valid ? *(const u32x4*)(zr + 1024 + h * 128 + o8) : z4; rg1 = valid ? *(const u32x4*)(zr + 1024 + h * 128 + 64 + o8) : z4; }
    f32x4 S[4];
#pragma unroll
    for (int n = 0; n < 4; ++n) S[n] = (f32x4){0.f, 0.f, 0.f, 0.f};
    if (MODE == 0) { const float* s0 = A.in[I_SGLA] + ((size_t)(l * 32 + b) * 4 + h) * 8192;
#pragma unroll
        for (int n = 0; n < 4; ++n) S[n] = *(const f32x4*)(s0 + (16 * n + r) * 128 + 16 * w + q * 4);
#pragma unroll
        for (int n = 0; n < 4; ++n)
#pragma unroll
            for (int i = 0; i < 4; ++i) ST[(16 * w + q * 4 + i) * 72 + 16 * n + r] = f2bf(S[n][i]);
    }
    if (MODE == 2) {
#pragma unroll
        for (int k = 0; k < 2; ++k) { const int idx = tid + 512 * k, row = idx >> 3, c8 = (idx & 7) * 8; *(LAS u32x4*)(ST + row * 72 + c8) = *(const u32x4*)(DS + row * 64 + c8); }
    }
    { const int idx = tid * 2, j = idx >> 6, d = idx & 63; const float* src = A.in[I_WLR2] + (size_t)(l * 16 + j) * 256 + h * 64 + d; WL[j * 64 + d] = src[0]; WL[j * 64 + d + 1] = src[1]; }
    float blr[8];
#pragma unroll
    for (int dd = 0; dd < 8; ++dd) blr[dd] = A.in[I_BLR][l * 256 + h * 64 + o8 + dd];
    const int mi = w >> 1;
    LRS[t * 16 + oct * 2] = rl.x; LRS[t * 16 + oct * 2 + 1] = rl.y;
    LDS_BAR();
    float la[8];
    {
        float lrv[16];
#pragma unroll
        for (int j4 = 0; j4 < 4; ++j4) { const f32x4 v = *(const LAS f32x4*)(LRS + t * 16 + j4 * 4); lrv[j4 * 4] = v.x; lrv[j4 * 4 + 1] = v.y; lrv[j4 * 4 + 2] = v.z; lrv[j4 * 4 + 3] = v.w; }
#pragma unroll
        for (int dd = 0; dd < 8; ++dd) la[dd] = blr[dd];
#pragma unroll
        for (int j = 0; j < 16; ++j) { const f32x4 w0 = *(const LAS f32x4*)(WL + j * 64 + o8), w1 = *(const LAS f32x4*)(WL + j * 64 + o8 + 4);
            la[0] += lrv[j] * w0.x; la[1] += lrv[j] * w0.y; la[2] += lrv[j] * w0.z; la[3] += lrv[j] * w0.w;
            la[4] += lrv[j] * w1.x; la[5] += lrv[j] * w1.y; la[6] += lrv[j] * w1.z; la[7] += lrv[j] * w1.w; }
#pragma unroll
        for (int dd = 0; dd < 8; ++dd) { const float x = la[dd]; const float ls = fminf(x, 0.f) - __logf(1.f + __expf(-fabsf(x))); la[dd] = valid ? ls * (1.f / 16.f) : 0.f; }
#pragma unroll
        for (int dd = 0; dd < 8; ++dd) { float v = la[dd]; float u = __shfl_up(v, 8); if (lane >= 8) v += u; u = __shfl_up(v, 16); if (lane >= 16) v += u; u = __shfl_up(v, 32); if (lane >= 32) v += u; la[dd] = v; }
        if ((lane >> 3) == 7) { *(LAS f32x4*)(SEG + w * 64 + o8) = (f32x4){la[0], la[1], la[2], la[3]}; *(LAS f32x4*)(SEG + w * 64 + o8 + 4) = (f32x4){la[4], la[5], la[6], la[7]}; }
    }
    LDS_BAR();
    float bl[8];
    {
        float pre[8];
#pragma unroll
        for (int dd = 0; dd < 8; ++dd) { pre[dd] = 0.f; bl[dd] = 0.f; }
#pragma unroll
        for (int ww = 0; ww < 8; ++ww) { const f32x4 s0 = *(const LAS f32x4*)(SEG + ww * 64 + o8), s1 = *(const LAS f32x4*)(SEG + ww * 64 + o8 + 4);
            const float m = ww < w ? 1.f : 0.f;
            pre[0] += m * s0.x; pre[1] += m * s0.y; pre[2] += m * s0.z; pre[3] += m * s0.w; pre[4] += m * s1.x; pre[5] += m * s1.y; pre[6] += m * s1.z; pre[7] += m * s1.w;
            bl[0] += s0.x; bl[1] += s0.y; bl[2] += s0.z; bl[3] += s0.w; bl[4] += s1.x; bl[5] += s1.y; bl[6] += s1.z; bl[7] += s1.w; }
#pragma unroll
        for (int dd = 0; dd < 8; ++dd) la[dd] += pre[dd];
    }
    {
        float kf[8]; unpack8(rk, kf);
        if (DO_OUT) { float qf[8], qt[8], kt[8]; unpack8(rq, qf);
#pragma unroll
            for (int dd = 0; dd < 8; ++dd) { qt[dd] = qf[dd] * 0.125f * __expf(la[dd]); kt[dd] = kf[dd] * __expf(-la[dd]); }
            *(LAS u32x4*)(QT + t * 72 + o8) = pack8(qt); *(LAS u32x4*)(KT + t * 72 + o8) = pack8(kt);
            *(LAS u32x4*)(GS + t * 136 + o8) = rg0; *(LAS u32x4*)(GS + t * 136 + 64 + o8) = rg1; }
        if (DO_S) {
#pragma unroll
            for (int dd = 0; dd < 8; ++dd) KHT[(o8 + dd) * 72 + tsw] = f2bf(kf[dd] * __expf(bl[dd] - la[dd]));
            if (t == 0) {
#pragma unroll
                for (int dd = 0; dd < 8; ++dd) BL[o8 + dd] = __expf(bl[dd]);
            } }
        const unsigned vw[8] = {rv0.x, rv0.y, rv0.z, rv0.w, rv1.x, rv1.y, rv1.z, rv1.w};
#pragma unroll
        for (int e2 = 0; e2 < 8; ++e2) { const int e = (e2 < 4 ? 0 : 64) + o8 + (e2 & 3) * 2; VT[e * 72 + tsw] = (bf16)(vw[e2] & 0xffffu); VT[(e + 1) * 72 + tsw] = (bf16)(vw[e2] >> 16); }
    }
    LDS_BAR();
    const int swr = (r >> 3);
    f32x4 O[4];
    if (DO_OUT) {
#pragma unroll
        for (int jj = 0; jj < 2; ++jj) { const int nj = 2 * (w & 1) + jj; f32x4 acc = (f32x4){0.f, 0.f, 0.f, 0.f};
#pragma unroll
            for (int ks = 0; ks < 2; ++ks) { const bf16x8 a = *(const LAS bf16x8*)(QT + (16 * mi + r) * 72 + ks * 32 + q * 8), bb = *(const LAS bf16x8*)(KT + (16 * nj + r) * 72 + ks * 32 + q * 8);
                acc = __builtin_amdgcn_mfma_f32_16x16x32_bf16(a, bb, acc, 0, 0, 0); }
#pragma unroll
            for (int i = 0; i < 4; ++i) { const int row = 16 * mi + q * 4 + i, col = 16 * nj + r; ATT[row * 72 + col] = f2bf(col <= row ? acc[i] : 0.f); } }
        LDS_BAR();
#pragma unroll
        for (int n = 0; n < 4; ++n) O[n] = (f32x4){0.f, 0.f, 0.f, 0.f};
#pragma unroll
        for (int ks = 0; ks < 2; ++ks) { const bf16x8 a = *(const LAS bf16x8*)(QT + (16 * mi + r) * 72 + ks * 32 + q * 8);
#pragma unroll
            for (int n = 0; n < 4; ++n) { const bf16x8 bb = *(const LAS bf16x8*)(ST + (16 * (4 * (w & 1) + n) + r) * 72 + ks * 32 + q * 8); O[n] = __builtin_amdgcn_mfma_f32_16x16x32_bf16(a, bb, O[n], 0, 0, 0); } }
#pragma unroll
        for (int ks = 0; ks < 2; ++ks) { const bf16x8 a = *(const LAS bf16x8*)(ATT + (16 * mi + r) * 72 + ks * 32 + q * 8);
#pragma unroll
            for (int n = 0; n < 4; ++n) { const int sw = ((2 * n + swr) & 7) << 3; const bf16x8 bb = *(const LAS bf16x8*)(VT + (16 * (4 * (w & 1) + n) + r) * 72 + ((ks * 32 + q * 8) ^ sw)); O[n] = __builtin_amdgcn_mfma_f32_16x16x32_bf16(a, bb, O[n], 0, 0, 0); } }
    }
    if (DO_S) {
#pragma unroll
        for (int n = 0; n < 4; ++n) { const float dec = BL[16 * n + r]; S[n] = S[n] * dec; }
#pragma unroll
        for (int ks = 0; ks < 2; ++ks) { const int swa = ((2 * w + swr) & 7) << 3; const bf16x8 a = *(const LAS bf16x8*)(VT + (16 * w + r) * 72 + ((ks * 32 + q * 8) ^ swa));
#pragma unroll
            for (int n = 0; n < 4; ++n) { const int sw = ((2 * n + swr) & 7) << 3; const bf16x8 bb = *(const LAS bf16x8*)(KHT + (16 * n + r) * 72 + ((ks * 32 + q * 8) ^ sw)); S[n] = __builtin_amdgcn_mfma_f32_16x16x32_bf16(a, bb, S[n], 0, 0, 0); } }
    }
    if (DO_OUT) {
#pragma unroll
        for (int i = 0; i < 4; ++i) { float s = 0.f;
#pragma unroll
            for (int n = 0; n < 4; ++n) s += O[n][i] * O[n][i];
            s += __shfl_xor(s, 1); s += __shfl_xor(s, 2); s += __shfl_xor(s, 4); s += __shfl_xor(s, 8);
            if (r == 0) SSQ[(16 * mi + q * 4 + i) * 2 + (w & 1)] = s; }
    }
    LDS_BAR();
    if (MODE == 1) {
#pragma unroll
        for (int n = 0; n < 4; ++n)
#pragma unroll
            for (int i = 0; i < 4; ++i) ST[(16 * w + q * 4 + i) * 72 + 16 * n + r] = f2bf(S[n][i]);
        if (tid < 64) DEC[tid] = BL[tid];
    }
    if (DO_OUT) {
        float gn[4];
#pragma unroll
        for (int n = 0; n < 4; ++n) gn[n] = A.in[I_GNORM][l * 128 + 16 * (4 * (w & 1) + n) + r];
#pragma unroll
        for (int i = 0; i < 4; ++i) { const int row = 16 * mi + q * 4 + i; const float rstd = __builtin_amdgcn_rsqf((SSQ[row * 2] + SSQ[row * 2 + 1]) * (1.f / 128.f) + EPS);
#pragma unroll
            for (int n = 0; n < 4; ++n) { const int e = 16 * (4 * (w & 1) + n) + r; const float gv = bf2f(GS[row * 136 + e]); GS[row * 136 + e] = f2bf(O[n][i] * rstd * gn[n] * gv * sigm(gv)); } }
    }
    LDS_BAR();
    if (DO_OUT) { if (valid) { bf16* mr = MIX + (size_t)(row0 + t) * DM + h * 128 + o8;
        *(u32x4*)(mr) = *(const LAS u32x4*)(GS + t * 136 + o8); *(u32x4*)(mr + 64) = *(const LAS u32x4*)(GS + t * 136 + 64 + o8); } }
    if (MODE == 1) {
#pragma unroll
        for (int k = 0; k < 2; ++k) { const int idx = tid + 512 * k, row = idx >> 3, c8 = (idx & 7) * 8; *(u32x4*)(DS + row * 64 + c8) = *(const LAS u32x4*)(ST + row * 72 + c8); }
    }
    if (MODE == 0) { float* so = A.out + OUT_GLA_S + ((size_t)(l * 32 + b) * 4 + h) * 8192;
#pragma unroll
        for (int n = 0; n < 4; ++n) *(f32x4*)(so + (16 * n + r) * 128 + 16 * w + q * 4) = S[n]; }
    LDS_BAR();
}

template <int MODE>
__device__ __forceinline__ void gla_loop(LAS unsigned char* L, const Args& A, int l, int j0, int jstride, int jend) {
    if (j0 >= jend) return;
    const int tid = opaque_tid(), w = __builtin_amdgcn_readfirstlane(tid >> 6), lane = tid & 63, r = lane & 15, q = lane >> 4;
    const int t2 = tid >> 3, c8 = (tid & 7) * 8;
    const int o8 = w * 8;
    LAS bf16* QT = (LAS bf16*)(L + 0); LAS bf16* KT = (LAS bf16*)(L + 9216); LAS bf16* KHT = (LAS bf16*)(L + 18432); LAS bf16* ATT = (LAS bf16*)(L + 27648);
    LAS bf16* VT = (LAS bf16*)(L + 36864); LAS bf16* ST = (LAS bf16*)(L + 55296); LAS bf16* GS = (LAS bf16*)(L + 73728);
    LAS float* LRS = (LAS float*)(L + 91136); LAS bf16* VRAW = (LAS bf16*)(L + 102144); LAS float* WL = (LAS float*)(L + 95232); LAS float* SSQ = (LAS float*)(L + 101376); LAS float* BL = (LAS float*)(L + 101888);
    constexpr bool SMP = (MODE == 0), DO_OUT = (MODE != 1), DO_S = (MODE != 2);
    constexpr int ntok = SMP ? 32 : 64;
    const bf16* Z = (const bf16*)(A.ws + WS_Z); bf16* MIX = (bf16*)(A.ws + WS_MIX); const float* LR = (const float*)(A.ws + WS_LR);
    const bool valid = lane < ntok;
    const u32x4 z4 = (u32x4){0u, 0u, 0u, 0u};
    const int mi = w >> 1, swr = r >> 3; (void)swr;
    u32x4 rq = z4, rk = z4, rv0 = z4, rv1 = z4, rg0 = z4, rg1 = z4, sd0 = z4, sd1 = z4;
#define GLA_ROW0(j) (SMP ? MP + ((j) >> 2) * 32 : ((j) >> 7) * 2048 + ((j) & 31) * 64)
#define GLA_HEAD(j) (SMP ? ((j) & 3) : (((j) >> 5) & 3))
#define GLA_LOAD(j) do { const int h_ = GLA_HEAD(j); const bf16* zr = Z + (size_t)(GLA_ROW0(j) + t2) * NZ; \
        if (t2 < ntok) { rk = *(const u32x4*)(zr + 256 + h_ * 64 + c8); rv0 = *(const u32x4*)(zr + 512 + h_ * 128 + c8); rv1 = *(const u32x4*)(zr + 512 + h_ * 128 + 64 + c8); \
            rl2 = *(const f32x2*)(LR + (size_t)(GLA_ROW0(j) + t2) * 16 + (tid & 7) * 2); \
            if (DO_OUT) { rq = *(const u32x4*)(zr + h_ * 64 + c8); rg0 = *(const u32x4*)(zr + 1024 + h_ * 128 + c8); rg1 = *(const u32x4*)(zr + 1024 + h_ * 128 + 64 + c8); } } \
        if (MODE == 2) { const bf16* ds_ = (const bf16*)(A.ws + WS_DS) + (size_t)(j) * 8192; sd0 = *(const u32x4*)(ds_ + t2 * 64 + c8); sd1 = *(const u32x4*)(ds_ + (64 + t2) * 64 + c8); } } while (0)
    f32x2 rl2 = (f32x2){0.f, 0.f};
    GLA_LOAD(j0);
    int hprev = -1;
    float blr[8], gn[4];
#pragma unroll
    for (int dd = 0; dd < 8; ++dd) blr[dd] = 0.f;
#pragma unroll
    for (int n = 0; n < 4; ++n) gn[n] = A.in[I_GNORM][l * 128 + 16 * (4 * (w & 1) + n) + r];
    for (int j = j0; j < jend; j += jstride) {
        SEC_BEGIN(21); SEC_MARK(21);
        const int h = GLA_HEAD(j), row0 = GLA_ROW0(j), b = SMP ? (j >> 2) : (j >> 7);
        if (h != hprev) { hprev = h;
#pragma unroll
            for (int dd = 0; dd < 8; ++dd) blr[dd] = A.in[I_BLR][l * 256 + h * 64 + o8 + dd];
            { const int idx = tid * 2, jj = idx >> 6, d = idx & 63; const float* src = A.in[I_WLR2] + (size_t)(l * 16 + jj) * 256 + h * 64 + d; WL[jj * 64 + d] = src[0]; WL[jj * 64 + d + 1] = src[1]; }
            LDS_BAR(); }
        f32x4 S[4];
#pragma unroll
        for (int n = 0; n < 4; ++n) S[n] = (f32x4){0.f, 0.f, 0.f, 0.f};
        if (MODE == 0) { const float* s0 = A.in[I_SGLA] + ((size_t)(l * 32 + b) * 4 + h) * 8192;
#pragma unroll
            for (int n = 0; n < 4; ++n) S[n] = *(const f32x4*)(s0 + (16 * n + r) * 128 + 16 * w + q * 4);
#pragma unroll
            for (int n = 0; n < 4; ++n)
#pragma unroll
                for (int i = 0; i < 4; ++i) ST[(16 * w + q * 4 + i) * 72 + 16 * n + r] = f2bf(S[n][i]);
        }
        if (MODE == 2) { *(LAS u32x4*)(ST + t2 * 72 + c8) = sd0; *(LAS u32x4*)(ST + (64 + t2) * 72 + c8) = sd1; }
        *(LAS u32x4*)(KT + t2 * 72 + c8) = rk; *(LAS u32x4*)(VRAW + t2 * 136 + c8) = rv0; *(LAS u32x4*)(VRAW + t2 * 136 + 64 + c8) = rv1; *(LAS f32x2*)(LRS + t2 * 16 + (tid & 7) * 2) = rl2;
        if (DO_OUT) { *(LAS u32x4*)(QT + t2 * 72 + c8) = rq; *(LAS u32x4*)(GS + t2 * 136 + c8) = rg0; *(LAS u32x4*)(GS + t2 * 136 + 64 + c8) = rg1; }
        if (j + jstride < jend) GLA_LOAD(j + jstride);
        LDS_BAR();
        f32x4 rl[4];
#pragma unroll
        for (int k = 0; k < 4; ++k) rl[k] = *(const LAS f32x4*)(LRS + lane * 16 + 4 * k);
        const u32x4 kx = *(const LAS u32x4*)(KT + lane * 72 + o8), v0 = *(const LAS u32x4*)(VRAW + lane * 136 + o8), v1 = *(const LAS u32x4*)(VRAW + lane * 136 + 64 + o8);
        u32x4 qx = z4; if (DO_OUT) qx = *(const LAS u32x4*)(QT + lane * 72 + o8);
        float la[8], bl[8];
        {
            const float lrv[16] = {rl[0].x, rl[0].y, rl[0].z, rl[0].w, rl[1].x, rl[1].y, rl[1].z, rl[1].w, rl[2].x, rl[2].y, rl[2].z, rl[2].w, rl[3].x, rl[3].y, rl[3].z, rl[3].w};
#pragma unroll
            for (int dd = 0; dd < 8; ++dd) la[dd] = blr[dd];
#pragma unroll
            for (int jj = 0; jj < 16; ++jj) { const f32x4 w0 = *(const LAS f32x4*)(WL + jj * 64 + o8), w1 = *(const LAS f32x4*)(WL + jj * 64 + o8 + 4);
                la[0] += lrv[jj] * w0.x; la[1] += lrv[jj] * w0.y; la[2] += lrv[jj] * w0.z; la[3] += lrv[jj] * w0.w;
                la[4] += lrv[jj] * w1.x; la[5] += lrv[jj] * w1.y; la[6] += lrv[jj] * w1.z; la[7] += lrv[jj] * w1.w; }
#pragma unroll
            for (int dd = 0; dd < 8; ++dd) { const float x = la[dd]; const float ls = fminf(x, 0.f) - __logf(1.f + __expf(-fabsf(x))); la[dd] = valid ? ls * (1.f / 16.f) : 0.f; }
#pragma unroll
            for (int dd = 0; dd < 8; ++dd) { float v = la[dd];
#pragma unroll
                for (int o = 1; o < 64; o <<= 1) { const float u = __shfl_up(v, o); if (lane >= o) v += u; }
                la[dd] = v; bl[dd] = __shfl(v, 63); }
        }
        {
            float kf[8]; unpack8(kx, kf);
            if (DO_OUT) { float qf[8], qt[8], kt[8]; unpack8(qx, qf);
#pragma unroll
                for (int dd = 0; dd < 8; ++dd) { qt[dd] = qf[dd] * 0.125f * __expf(la[dd]); kt[dd] = kf[dd] * __expf(-la[dd]); }
                *(LAS u32x4*)(QT + lane * 72 + o8) = pack8(qt); *(LAS u32x4*)(KT + lane * 72 + o8) = pack8(kt);
}
            if (DO_S) {
#pragma unroll
                for (int dd = 0; dd < 8; ++dd) KHT[(o8 + dd) * 72 + lane] = f2bf(kf[dd] * __expf(bl[dd] - la[dd]));
                if (lane == 0) {
#pragma unroll
                    for (int dd = 0; dd < 8; ++dd) BL[o8 + dd] = __expf(bl[dd]);
                } }
            const unsigned vw[8] = {v0.x, v0.y, v0.z, v0.w, v1.x, v1.y, v1.z, v1.w};
#pragma unroll
            for (int e2 = 0; e2 < 8; ++e2) { const int e = (e2 < 4 ? 0 : 64) + o8 + (e2 & 3) * 2; VT[e * 72 + lane] = (bf16)(vw[e2] & 0xffffu); VT[(e + 1) * 72 + lane] = (bf16)(vw[e2] >> 16); }
        }
        SEC_END(21); SEC_MARK(22);
        LDS_BAR();
        f32x4 O[4];
        if (DO_OUT) {
#pragma unroll
            for (int jj = 0; jj < 2; ++jj) { const int nj = 2 * (w & 1) + jj; f32x4 acc = (f32x4){0.f, 0.f, 0.f, 0.f};
#pragma unroll
                for (int ks = 0; ks < 2; ++ks) { const bf16x8 a = *(const LAS bf16x8*)(QT + (16 * mi + r) * 72 + ks * 32 + q * 8), bb = *(const LAS bf16x8*)(KT + (16 * nj + r) * 72 + ks * 32 + q * 8);
                    acc = __builtin_amdgcn_mfma_f32_16x16x32_bf16(a, bb, acc, 0, 0, 0); }
#pragma unroll
                for (int i = 0; i < 4; ++i) { const int row = 16 * mi + q * 4 + i, col = 16 * nj + r; ATT[row * 72 + col] = f2bf(col <= row ? acc[i] : 0.f); } }
            LDS_BAR();
#pragma unroll
            for (int n = 0; n < 4; ++n) O[n] = (f32x4){0.f, 0.f, 0.f, 0.f};
#pragma unroll
            for (int ks = 0; ks < 2; ++ks) { const bf16x8 a = *(const LAS bf16x8*)(QT + (16 * mi + r) * 72 + ks * 32 + q * 8);
#pragma unroll
                for (int n = 0; n < 4; ++n) { const bf16x8 bb = *(const LAS bf16x8*)(ST + (16 * (4 * (w & 1) + n) + r) * 72 + ks * 32 + q * 8); O[n] = __builtin_amdgcn_mfma_f32_16x16x32_bf16(a, bb, O[n], 0, 0, 0); } }
#pragma unroll
            for (int ks = 0; ks < 2; ++ks) { const bf16x8 a = *(const LAS bf16x8*)(ATT + (16 * mi + r) * 72 + ks * 32 + q * 8);
#pragma unroll
                for (int n = 0; n < 4; ++n) { const bf16x8 bb = *(const LAS bf16x8*)(VT + (16 * (4 * (w & 1) + n) + r) * 72 + ks * 32 + q * 8); O[n] = __builtin_amdgcn_mfma_f32_16x16x32_bf16(a, bb, O[n], 0, 0, 0); } }
        }
        if (DO_S) {
#pragma unroll
            for (int n = 0; n < 4; ++n) { const float dec = BL[16 * n + r]; S[n] = S[n] * dec; }
#pragma unroll
            for (int ks = 0; ks < 2; ++ks) { const bf16x8 a = *(const LAS bf16x8*)(VT + (16 * w + r) * 72 + ks * 32 + q * 8);
#pragma unroll
                for (int n = 0; n < 4; ++n) { const bf16x8 bb = *(const LAS bf16x8*)(KHT + (16 * n + r) * 72 + ks * 32 + q * 8); S[n] = __builtin_amdgcn_mfma_f32_16x16x32_bf16(a, bb, S[n], 0, 0, 0); } }
        }
        if (DO_OUT) {
#pragma unroll
            for (int i = 0; i < 4; ++i) { float s = 0.f;
#pragma unroll
                for (int n = 0; n < 4; ++n) s += O[n][i] * O[n][i];
                s += __shfl_xor(s, 1); s += __shfl_xor(s, 2); s += __shfl_xor(s, 4); s += __shfl_xor(s, 8);
                if (r == 0) SSQ[(16 * mi + q * 4 + i) * 2 + (w & 1)] = s; }
        }
        LDS_BAR();
        SEC_END(22); SEC_MARK(23);
        if (MODE == 1) {
#pragma unroll
            for (int n = 0; n < 4; ++n)
#pragma unroll
                for (int i = 0; i < 4; ++i) ST[(16 * w + q * 4 + i) * 72 + 16 * n + r] = f2bf(S[n][i]);
            if (tid < 64) ((float*)(A.ws + WS_DEC))[(size_t)j * 64 + tid] = BL[tid];
        }
        if (DO_OUT) {
#pragma unroll
            for (int i = 0; i < 4; ++i) { const int row = 16 * mi + q * 4 + i; const float rstd = __builtin_amdgcn_rsqf((SSQ[row * 2] + SSQ[row * 2 + 1]) * (1.f / 128.f) + EPS);
#pragma unroll
                for (int n = 0; n < 4; ++n) { const int e = 16 * (4 * (w & 1) + n) + r; const float gv = bf2f(GS[row * 136 + e]); GS[row * 136 + e] = f2bf(O[n][i] * rstd * gn[n] * gv * sigm(gv)); } }
        }
        LDS_BAR();
        if (DO_OUT) { if (t2 < ntok) { bf16* mr = MIX + (size_t)(row0 + t2) * DM + h * 128 + c8;
            *(u32x4*)(mr) = *(const LAS u32x4*)(GS + t2 * 136 + c8); *(u32x4*)(mr + 64) = *(const LAS u32x4*)(GS + t2 * 136 + 64 + c8); } }
        if (MODE == 1) { bf16* DS = (bf16*)(A.ws + WS_DS) + (size_t)j * 8192;
            *(u32x4*)(DS + t2 * 64 + c8) = *(const LAS u32x4*)(ST + t2 * 72 + c8); *(u32x4*)(DS + (64 + t2) * 64 + c8) = *(const LAS u32x4*)(ST + (64 + t2) * 72 + c8); }
        if (MODE == 0) { float* so = A.out + OUT_GLA_S + ((size_t)(l * 32 + b) * 4 + h) * 8192;
#pragma unroll
            for (int n = 0; n < 4; ++n) *(f32x4*)(so + (16 * n + r) * 128 + 16 * w + q * 4) = S[n]; }
        LDS_BAR();
        SEC_END(23);
    }
#undef GLA_LOAD
#undef GLA_ROW0
#undef GLA_HEAD
}

__device__ __forceinline__ void gla_scan(const Args& A, int l, int gt, int NGT) {
    unsigned* DS32 = (unsigned*)(A.ws + WS_DS); const float* DEC = (const float*)(A.ws + WS_DEC);
    for (int e = gt; e < 32 * 4096; e += NGT) {
        const int bh = e >> 12, p = e & 4095, dk0 = (2 * p) & 63, dv = p >> 5;
        float s0 = 0.f, s1 = 0.f;
        unsigned* dp = DS32 + (size_t)bh * 32 * 4096 + p; const float* dc = DEC + (size_t)bh * 32 * 64 + dk0;
        unsigned wv[32]; f32x2 dd[32];
#pragma unroll
        for (int c = 0; c < 32; ++c) { wv[c] = dp[(size_t)c * 4096]; dd[c] = *(const f32x2*)(dc + c * 64); }
#pragma unroll
        for (int c = 0; c < 32; ++c) { dp[(size_t)c * 4096] = pk2(s0, s1); s0 = dd[c].x * s0 + blo(wv[c]); s1 = dd[c].y * s1 + bhi(wv[c]); }
        float* so = A.out + OUT_GLA_P + ((size_t)(l * 8) * 4 + bh) * 8192;
        so[dk0 * 128 + dv] = s0; so[(dk0 + 1) * 128 + dv] = s1;
    }
}

__device__ __forceinline__ void rg_prefix(const Args& A, int l, int gt, int NGT) {
    const float* CA = (const float*)(A.ws + WS_CA); const float* CU = CA + 8 * 32 * 512; float* HIN = (float*)(A.ws + WS_HIN);
    for (int e = gt; e < 8 * 512; e += NGT) { const int b = e >> 9, ch = e & 511; float ca[32], cu[32];
#pragma unroll
        for (int c = 0; c < 32; ++c) { ca[c] = CA[(b * 32 + c) * 512 + ch]; cu[c] = CU[(b * 32 + c) * 512 + ch]; }
        float h = 0.f;
#pragma unroll
        for (int c = 0; c < 32; ++c) { HIN[(b * 32 + c) * 512 + ch] = h; h = ca[c] * h + cu[c]; }
        A.out[OUT_RG_P + (size_t)(l * 8 + b) * 512 + ch] = h; }
}

__device__ __forceinline__ void rg_item(LAS unsigned char* L, const Args& A, int l, int smp, int b, int c) {
    const int tid = opaque_tid(), w = __builtin_amdgcn_readfirstlane(tid >> 6), lane = tid & 63, r = lane & 15, q = lane >> 4, tl = lane >> 3, oct = lane & 7;
    const int ch0 = w * 64;
    LAS bf16* XR = (LAS bf16*)(L + w * 18432);
    LAS bf16* XCB = XR + 67 * 64;
    const int ntok = smp ? 32 : 64, row0 = smp ? MP + b * 32 : b * 2048 + c * 64, nbt = smp ? 32 : 8;
    const bf16* Z = (const bf16*)(A.ws + WS_Z);
    bf16* LG = (bf16*)(A.ws + WS_H); bf16* UG = LG + (size_t)M * 512;
    float* CA = (float*)(A.ws + WS_CA); float* CU = CA + 8 * 32 * 512;
    const u32x4 z4 = (u32x4){0u, 0u, 0u, 0u};
    u32x4 xh = z4, xv[8];
    if (lane < 24) { const int j = lane >> 3;
        if (c > 0) xh = *(const u32x4*)(Z + (size_t)(row0 - 3 + j) * NZ + 1536 + ch0 + oct * 8);
        else if (smp) { const float* sp = A.in[I_SCV] + ((size_t)(l * 32 + b) * 3 + j) * 512 + ch0 + oct * 8; const f32x4 a0 = *(const f32x4*)sp, a1 = *(const f32x4*)(sp + 4);
            xh.x = pk2(a0.x, a0.y); xh.y = pk2(a0.z, a0.w); xh.z = pk2(a1.x, a1.y); xh.w = pk2(a1.z, a1.w); } }
#pragma unroll
    for (int s = 0; s < 8; ++s) { const int t = s * 8 + tl; xv[s] = (t < ntok) ? *(const u32x4*)(Z + (size_t)(row0 + t) * NZ + 1536 + ch0 + oct * 8) : z4; }
    f32x4 cwv[4][2], cbv[2];
#pragma unroll
    for (int hh = 0; hh < 2; ++hh) { cbv[hh] = *(const f32x4*)(A.in[I_CB] + l * 512 + ch0 + oct * 8 + 4 * hh);
#pragma unroll
        for (int j = 0; j < 4; ++j) cwv[j][hh] = *(const f32x4*)(A.in[I_CW] + (l * 4 + j) * 512 + ch0 + oct * 8 + 4 * hh); }
    const bf16* wrg = (const bf16*)(A.ws + WS_W + (size_t)l * LAYER_W + W_RG) + (size_t)w * 128 * 64;
    bf16x8 Bf[8][2];
#pragma unroll
    for (int n = 0; n < 8; ++n)
#pragma unroll
        for (int ks = 0; ks < 2; ++ks) Bf[n][ks] = *(const bf16x8*)(wrg + (16 * n + r) * 64 + ks * 32 + q * 8);
    float ba_[4], bx_[4], sp_[4], At[4], Ut[4];
#pragma unroll
    for (int n = 0; n < 4; ++n) { const int ch = l * 512 + ch0 + 16 * n + r; ba_[n] = A.in[I_BA][ch]; bx_[n] = A.in[I_BX][ch]; sp_[n] = A.in[I_LAM][ch]; At[n] = 1.f; Ut[n] = 0.f; }
    LDS_BAR();
    if (lane < 24) *(LAS u32x4*)(XR + (lane >> 3) * 64 + oct * 8) = xh;
#pragma unroll
    for (int s = 0; s < 8; ++s) *(LAS u32x4*)(XR + (3 + s * 8 + tl) * 64 + oct * 8) = xv[s];
    LDS_WAIT(); asm volatile("" ::: "memory");
#pragma unroll
    for (int s = 0; s < 8; ++s) { const int t = s * 8 + tl; float xc[8] = {cbv[0].x, cbv[0].y, cbv[0].z, cbv[0].w, cbv[1].x, cbv[1].y, cbv[1].z, cbv[1].w};
#pragma unroll
        for (int j = 0; j < 4; ++j) { float xf[8]; unpack8(*(const LAS u32x4*)(XR + (t + j) * 64 + oct * 8), xf);
            xc[0] += cwv[j][0].x * xf[0]; xc[1] += cwv[j][0].y * xf[1]; xc[2] += cwv[j][0].z * xf[2]; xc[3] += cwv[j][0].w * xf[3];
            xc[4] += cwv[j][1].x * xf[4]; xc[5] += cwv[j][1].y * xf[5]; xc[6] += cwv[j][1].z * xf[6]; xc[7] += cwv[j][1].w * xf[7]; }
        *(LAS u32x4*)(XCB + t * 72 + oct * 8) = pack8(xc); }
    if (smp || c == 31) {
#pragma unroll
        for (int j = 0; j < 3; ++j) A.out[(smp ? OUT_CV_S : OUT_CV_P) + ((size_t)(l * nbt + b) * 3 + j) * 512 + ch0 + lane] = bf2f(XR[(ntok + j) * 64 + lane]);
    }
    LDS_WAIT(); asm volatile("" ::: "memory");
#pragma unroll
    for (int n = 0; n < 4; ++n) { const float lam = sp_[n]; sp_[n] = 8.f * (fmaxf(-lam, 0.f) + __logf(1.f + __expf(-fabsf(lam)))); }
    const int nm = ntok >> 4;
    unsigned upk[4][4][2];
#pragma unroll
    for (int m = 0; m < 4; ++m) {
#pragma unroll
        for (int n = 0; n < 4; ++n) { upk[m][n][0] = 0u; upk[m][n][1] = 0u; }
        if (m < nm) {
            f32x4 acc[8];
#pragma unroll
            for (int k = 0; k < 8; ++k) acc[k] = (f32x4){0.f, 0.f, 0.f, 0.f};
#pragma unroll
            for (int ks = 0; ks < 2; ++ks) { const bf16x8 a = *(const LAS bf16x8*)(XCB + (16 * m + r) * 72 + ks * 32 + q * 8);
#pragma unroll
                for (int k = 0; k < 8; ++k) acc[k] = __builtin_amdgcn_mfma_f32_16x16x32_bf16(a, Bf[k][ks], acc[k], 0, 0, 0); }
#pragma unroll
            for (int n = 0; n < 4; ++n) {
                float uv[4]; float Aq = 1.f, Uq = 0.f;
#pragma unroll
                for (int i = 0; i < 4; ++i) { const float p1 = 1.f + __expf(-(acc[n][i] + ba_[n])), p2 = 1.f + __expf(-(acc[4 + n][i] + bx_[n])), pinv = __builtin_amdgcn_rcpf(p1 * p2);
                    const float rr = p2 * pinv, ii = p1 * pinv;
                    const unsigned short lgb = f2bf(-rr * sp_[n]); const float lg = bf2f(lgb);
                    const float a = __expf(lg); const float xcv = bf2f(XCB[(16 * m + 4 * q + i) * 72 + 16 * n + r]);
                    const float u = bf2f(f2bf(__builtin_amdgcn_sqrtf(fmaxf(1.f - a * a, 0.f)) * ii * xcv));
                    XR[(16 * m + 4 * q + i) * 64 + 16 * n + r] = lgb;
                    uv[i] = u; Uq = a * Uq + u; Aq = a * Aq; }
                upk[m][n][0] = pk2(uv[0], uv[1]); upk[m][n][1] = pk2(uv[2], uv[3]);
                { const float A1 = __shfl_up(Aq, 16), U1 = __shfl_up(Uq, 16); if (q >= 1) { Uq = Aq * U1 + Uq; Aq = Aq * A1; } }
                { const float A2 = __shfl_up(Aq, 32), U2 = __shfl_up(Uq, 32); if (q >= 2) { Uq = Aq * U2 + Uq; Aq = Aq * A2; } }
                const float Am = __shfl(Aq, 48 + r), Um = __shfl(Uq, 48 + r);
                Ut[n] = Am * Ut[n] + Um; At[n] = Am * At[n];
            }
        }
    }
    if (!smp && q == 0) {
#pragma unroll
        for (int n = 0; n < 4; ++n) { const int ix = (b * 32 + c) * 512 + ch0 + 16 * n + r; CA[ix] = At[n]; CU[ix] = Ut[n]; } }
    LDS_WAIT(); asm volatile("" ::: "memory");
#pragma unroll
    for (int s = 0; s < 8; ++s) { const int t = s * 8 + tl; if (t < ntok) *(u32x4*)(LG + (size_t)(row0 + t) * 512 + ch0 + oct * 8) = *(const LAS u32x4*)(XR + t * 64 + oct * 8); }
    LDS_WAIT(); asm volatile("" ::: "memory");
#pragma unroll
    for (int m = 0; m < 4; ++m)
#pragma unroll
        for (int n = 0; n < 4; ++n) { LAS bf16* p = XR + (16 * m + 4 * q) * 64 + 16 * n + r;
            p[0] = (bf16)(upk[m][n][0] & 0xffffu); p[64] = (bf16)(upk[m][n][0] >> 16); p[128] = (bf16)(upk[m][n][1] & 0xffffu); p[192] = (bf16)(upk[m][n][1] >> 16); }
    LDS_WAIT(); asm volatile("" ::: "memory");
#pragma unroll
    for (int s = 0; s < 8; ++s) { const int t = s * 8 + tl; if (t < ntok) *(u32x4*)(UG + (size_t)(row0 + t) * 512 + ch0 + oct * 8) = *(const LAS u32x4*)(XR + t * 64 + oct * 8); }
    LDS_BAR();
}

__device__ __forceinline__ void rg_out(const Args& A, int l, int smp, int b, int c) {
    const int tid = opaque_tid(), w = __builtin_amdgcn_readfirstlane(tid >> 6), lane = tid & 63;
    const int ch = w * 64 + lane, ntok = smp ? 32 : 64, row0 = smp ? MP + b * 32 : b * 2048 + c * 64;
    const bf16* Z = (const bf16*)(A.ws + WS_Z); bf16* MIX = (bf16*)(A.ws + WS_MIX);
    const bf16* LG = (const bf16*)(A.ws + WS_H); const bf16* UG = LG + (size_t)M * 512;
    float h = smp ? A.in[I_SRG][(size_t)(l * 32 + b) * 512 + ch] : ((const float*)(A.ws + WS_HIN))[(b * 32 + c) * 512 + ch];
    for (int t0 = 0; t0 < ntok; t0 += 16) {
        bf16 lgv[16], uvv[16], grv[16];
#pragma unroll
        for (int k = 0; k < 16; ++k) { const size_t row = (size_t)(row0 + t0 + k); lgv[k] = LG[row * 512 + ch]; uvv[k] = UG[row * 512 + ch]; grv[k] = Z[row * NZ + 2048 + ch]; }
#pragma unroll
        for (int k = 0; k < 16; ++k) { h = __expf(bf2f(lgv[k])) * h + bf2f(uvv[k]); MIX[(size_t)(row0 + t0 + k) * DM + 512 + ch] = f2bf(h * gelu_tanh(bf2f(grv[k]))); }
    }
    if (smp) A.out[OUT_RG_S + (size_t)(l * 32 + b) * 512 + ch] = h;
}

#define XB_TMO      128
#define XB_XCNT(j)  (256  + 64 * (j))
#define XB_XSUB(j)  (1280 + 64 * (j))
#define XB_XGEN(j)  (2304 + 64 * (j))
#define XB_TOP      3328
#define XB_TOPGEN   3392
#define XCD_BAR_WORDS 3456
#define XB_SPIN_CAP (1u << 18)

__device__ __forceinline__ unsigned xb_ld(unsigned* p)              { return __hip_atomic_load(p, __ATOMIC_RELAXED, __HIP_MEMORY_SCOPE_AGENT); }
__device__ __forceinline__ unsigned xb_add(unsigned* p, unsigned v) { return __hip_atomic_fetch_add(p, v, __ATOMIC_RELAXED, __HIP_MEMORY_SCOPE_AGENT); }
__device__ __forceinline__ unsigned xb_xcc_id() { return (unsigned)__builtin_amdgcn_s_getreg((3 << 11) | 20) & 0xFu; }
#define XB_SPIN(cond, bar) do { unsigned _sp = 0; while (cond) { __builtin_amdgcn_s_sleep(1); \
    if ((++_sp & 255u) == 0u) { if (xb_ld(&(bar)[XB_TMO])) break; if (_sp > XB_SPIN_CAP) { atomicAdd(&(bar)[XB_TMO], 1u); break; } } } } while (0)

struct XcdBarrier {
    unsigned* bar; unsigned x;
    volatile LAS unsigned* st;
};

__device__ __forceinline__ XcdBarrier xcd_barrier_post(unsigned* bar, volatile LAS unsigned* st) {
    XcdBarrier b; b.bar = bar; b.x = xb_xcc_id(); b.st = st;
    if (threadIdx.x == 0) (void)xb_add(&bar[XB_XCNT(b.x)], 1u);
    return b;
}
__device__ __forceinline__ void xcd_barrier_complete(unsigned* bar, unsigned x, unsigned& nloc, unsigned& nx) {
    const unsigned G = gridDim.x * gridDim.y * gridDim.z;
    unsigned sum, cnt, mine, sp = 0u;
    for (;;) {
        sum = 0u; cnt = 0u; mine = 0u;
#pragma unroll
        for (unsigned j = 0; j < 16; ++j) { const unsigned c = xb_ld(&bar[XB_XCNT(j)]); sum += c; cnt += (c > 0u) ? 1u : 0u; mine = (j == x) ? c : mine; }
        if (sum == G) break;
        __builtin_amdgcn_s_sleep(1);
        if ((++sp & 255u) == 0u) { if (xb_ld(&bar[XB_TMO])) break; if (sp > XB_SPIN_CAP) { atomicAdd(&bar[XB_TMO], 1u); break; } }
    }
    nloc = mine > 0u ? mine : 1u; nx = cnt > 0u ? cnt : 1u;
}

__device__ __forceinline__ void xcd_barrier(const XcdBarrier& b) {
    asm volatile("s_waitcnt vmcnt(0)" ::: "memory");
    __syncthreads();
    if (threadIdx.x == 0) {
        unsigned* bar = b.bar;
        __builtin_amdgcn_s_waitcnt(0);
        unsigned nloc = b.st[0], nx = b.st[1];
        if (nloc == 0u) { xcd_barrier_complete(bar, b.x, nloc, nx); b.st[0] = nloc; b.st[1] = nx; }
        const unsigned old = xb_add(&bar[XB_XSUB(b.x)], 1u);
        const unsigned gen = old / nloc;
        if (old + 1u == (gen + 1u) * nloc) {
            __builtin_amdgcn_fence(__ATOMIC_RELEASE, "agent");
            asm volatile("s_waitcnt vmcnt(0)" ::: "memory");
            const unsigned og = xb_add(&bar[XB_TOP], 1u);
            const unsigned tg = og / nx;
            if (og + 1u == (tg + 1u) * nx) xb_add(&bar[XB_TOPGEN], 1u);
            else XB_SPIN(xb_ld(&bar[XB_TOPGEN]) == tg, bar);
            __builtin_amdgcn_fence(__ATOMIC_ACQUIRE, "agent");
            xb_add(&bar[XB_XGEN(b.x)], 1u);
            asm volatile("s_waitcnt vmcnt(0)" ::: "memory");
        } else {
            XB_SPIN(xb_ld(&bar[XB_XGEN(b.x)]) == gen, bar);
            __builtin_amdgcn_fence(__ATOMIC_ACQUIRE, "agent");
            asm volatile("s_waitcnt vmcnt(0)" ::: "memory");
        }
    }
    __syncthreads();
}

__global__ void __launch_bounds__(NTHR) fwd_megakernel(Args A) {
    extern __shared__ __attribute__((aligned(16))) unsigned char lds_raw[];
    cg::grid_group grid = cg::this_grid();
    unsigned long long pb_t0 = 0; if (PROBE_K >= 0) pb_t0 = __builtin_amdgcn_s_memrealtime();
#define PB_SPIN() do { const unsigned long long dt_ = __builtin_amdgcn_s_memrealtime() - pb_t0; const unsigned long long t1_ = __builtin_amdgcn_s_memrealtime(); while (__builtin_amdgcn_s_memrealtime() - t1_ < dt_) __builtin_amdgcn_s_sleep(4); } while (0)
#define SYNC(k) do { if (PROBE_K == (k)) PB_SPIN(); xcd_barrier(xbar); if (PROBE_K >= 0) pb_t0 = __builtin_amdgcn_s_memrealtime(); } while (0)
    LAS unsigned char* L = (LAS unsigned char*)lds_raw;
    if (threadIdx.x < 2) ((volatile LAS unsigned*)(L + LDS_BARW))[threadIdx.x] = 0u;
    __syncthreads();
    if (A.ws == nullptr) grid.sync();
    const XcdBarrier xbar = xcd_barrier_post((unsigned*)A.ws, (volatile LAS unsigned*)(L + LDS_BARW));
    const int G = gridDim.x, blk = blockIdx.x, NGW = G * NWAVES;
#define ROW_LOOP(m) for (int ri_ = 0, m = 0; ri_ < (NGW == 2048 ? (gw < 1024 ? 8 : 9) : (M - gw + NGW - 1) / NGW) && ((m = (NGW == 2048 ? (gw < 1024 ? (ri_ == 0 ? MP + gw : gw * 7 + ri_ - 1) : 7168 + (gw - 1024) * 9 + ri_) : gw + ri_ * NGW)), true); ++ri_)
#define ROWS_IN_FLIGHT 4
#define ROW_PASS2(HAS_H_, XS, PT, HB) do { if (NGW != 2048) { ROW_LOOP(m) row_op<true, HAS_H_>(XS(m), GO + (size_t)m * DM, PT(m), ga, A.out + (size_t)m * DM, gb, (HB) + (size_t)m * DM, lane); } else { \
        if (gw < 1024) { const int ms_ = MP + gw; row_op<true, HAS_H_>(XS(ms_), GO + (size_t)ms_ * DM, PT(ms_), ga, A.out + (size_t)ms_ * DM, gb, (HB) + (size_t)ms_ * DM, lane); } \
        const int nr_ = gw < 1024 ? 7 : 9, r0_ = gw < 1024 ? gw * 7 : 7168 + (gw - 1024) * 9; \
        _Pragma("unroll 1") for (int i_ = 0; i_ < nr_; i_ += ROWS_IN_FLIGHT) { const size_t o_ = (size_t)(r0_ + i_) * DM; row_opN<true, HAS_H_, ROWS_IN_FLIGHT>(XS(r0_ + i_), DM, GO + o_, ga, A.out + o_, gb, (HB) + o_, DM, lane, nr_ - i_); } } } while (0)
#define PHASE_IDS() const int tid = opaque_tid(), lane = tid & 63, wave = __builtin_amdgcn_readfirstlane(tid >> 6), gw = blk * NWAVES + wave; (void)tid; (void)lane; (void)gw
    unsigned char* ws = A.ws;
    bf16* H = (bf16*)(ws + WS_H); bf16* GO = (bf16*)(ws + WS_GO); bf16* Zb = (bf16*)(ws + WS_Z); bf16* MIX = (bf16*)(ws + WS_MIX); bf16* HMID = (bf16*)(ws + WS_BIG);
    float* LR = (float*)(ws + WS_LR);

    {
        PHASE_IDS();
        convert_layer_weights(L, A, 0, gw, NGW, wave, lane, 0, (G == 256) ? 640 : 2944);
        if (G != 256) convert_layer_weights(L, A, 1, gw, NGW, wave, lane);
        const int gt = blk * NTHR + tid, NGT = G * NTHR;
        for (int idx = gt; idx < 2 * 16 * 1024; idx += NGT) { const int l = idx >> 14, j = (idx >> 10) & 15, k = idx & 1023;
            ((bf16*)(ws + WS_W + (size_t)l * LAYER_W + W_LR))[j * 1024 + k] = f2bf(A.in[I_WIN][(size_t)l * DM * DIN + (size_t)k * DIN + 1536 + j]); }
        for (int idx = gt; idx < 2 * 8 * 128 * 64; idx += NGT) { const int l = idx >> 16, g = (idx >> 13) & 7, n = (idx >> 6) & 127, k = idx & 63;
            const float v = n < 64 ? A.in[I_WA][((size_t)(l * 8 + g) * 64 + k) * 64 + n] : A.in[I_WX][((size_t)(l * 8 + g) * 64 + k) * 64 + n - 64];
            ((bf16*)(ws + WS_W + (size_t)l * LAYER_W + W_RG))[(g * 128 + n) * 64 + k] = f2bf(v); }
        f32x4 gz[4], gb[4];
#pragma unroll
        for (int j = 0; j < 4; ++j) gz[j] = (f32x4){0.f, 0.f, 0.f, 0.f};
        load_g(A.in[I_GPRE], lane, gb);
        if (NGW != 2048) { for (int m = gw; m < M; m += NGW) row_op<false, true>(xrow_in(A, m), nullptr, nullptr, gz, nullptr, gb, H + (size_t)m * DM, lane); }
        else {
            _Pragma("unroll 1") for (int k0 = 0; k0 < 8; k0 += 4) { const size_t o_ = (size_t)(gw + 2048 * k0) * DM; row_opN<false, true, 4>(A.in[I_XP] + o_, (size_t)2048 * DM, nullptr, gz, nullptr, gb, H + o_, (size_t)2048 * DM, lane, 4); }
            if (gw < 1024) row_op<false, true>(A.in[I_XS] + (size_t)gw * DM, nullptr, nullptr, gz, nullptr, gb, H + (size_t)(MP + gw) * DM, lane);
        }
    }
    SYNC(0);

#pragma unroll
    for (int l = 0; l < 2; ++l) {
        const bf16* wl = (const bf16*)(ws + WS_W + (size_t)l * LAYER_W);
        {
            const bf16* Hin = (l == 0) ? H : MIX;
            pg8::Gemm g{Hin, wl + W_IN / 2, M, NZ, DM}; pg8::StaticOrder S; S.init(M, NZ, DM, G, blk);
            pg8::EpiBf16<0> E{Zb, NZ, nullptr};
            pg8::gemm_phase<pg8::EpiBf16<0>, pg8::StaticOrder, true, true>(L, g, S, E);
            PHASE_IDS();
            const int r = lane & 15, q = lane >> 4; const bf16* wlr = wl + W_LR / 2;
            const int lr_first = (G == 256) ? 168 : 0, lr_nw = (G - lr_first) * NWAVES;
            for (int grp = (blk >= lr_first ? (blk - lr_first) * NWAVES + wave : M), cnt_ = 0; grp < M / 16 && cnt_ < 64; grp += lr_nw, ++cnt_) {
                f32x4 acc = (f32x4){0.f, 0.f, 0.f, 0.f};
                const bf16* ap = Hin + (size_t)(grp * 16 + r) * DM + q * 8; const bf16* bp = wlr + r * DM + q * 8;
#pragma unroll 8
                for (int k0 = 0; k0 < DM; k0 += 32) { const bf16x8 av = *(const bf16x8*)(ap + k0), bv = *(const bf16x8*)(bp + k0); acc = __builtin_amdgcn_mfma_f32_16x16x32_bf16(av, bv, acc, 0, 0, 0); }
#pragma unroll
                for (int i = 0; i < 4; ++i) LR[(size_t)(grp * 16 + q * 4 + i) * 16 + r] = acc[i];
            }
            if (l == 0 && G == 256 && blk >= 168) convert_layer_weights(L, A, 0, (blk - 168) * NWAVES + wave, 88 * NWAVES, wave, lane, 640, 2944);
        }
        SYNC(1);
        for (int it = blk; it < 1408; it += G) {
            if (it < 256) rg_item(L, A, l, 0, it >> 5, it & 31);
            else if (it < 1280) { const int j = it - 256; if (!(G == 256 && blk >= 128 && blk < 160 && j >= 768)) gla_item<1>(L, A, l, j >> 7, (j >> 5) & 3, j & 31); }
            else { const int j = it - 1280; gla_item<0>(L, A, l, j >> 2, j & 3, 0); }
        }
        if (G == 256 && blk >= 160 && blk < 192) { const int j = (blk - 32) + 768; gla_item<1>(L, A, l, j >> 7, (j >> 5) & 3, j & 31); }
        for (int s = blk; s < 160; s += G) if (s >= 128) rg_item(L, A, l, 1, s - 128, 0);
        SYNC(2);
        { PHASE_IDS(); gla_scan(A, l, blk * NTHR + tid, G * NTHR); rg_prefix(A, l, blk * NTHR + tid, G * NTHR); }
        SYNC(3);
        for (int it = blk; it < 256; it += G) rg_out(A, l, 0, it >> 5, it & 31);
        for (int s = blk; s < 160; s += G) if (s >= 128) rg_out(A, l, 1, s - 128, 0);
        gla_loop<2>(L, A, l, blk, G, 1024);
        SYNC(4);
        {
            pg8::Gemm g{MIX, wl + W_OUT / 2, M, DM, DM}; pg8::SplitOrder S; S.init(DM, G, blk, 8);
            pg8::EpiBf16<0> E{GO, DM, (float*)(ws + WS_Z)};
            pg8::gemm_phase<pg8::EpiBf16<0>, pg8::SplitOrder, true, true>(L, g, S, E);
        }
        SYNC(5);
        {
            PHASE_IDS();
            f32x4 ga[4], gb[4]; load_g(A.in[I_GPOST] + l * DM, lane, ga); load_g(A.in[I_GPREFF] + l * DM, lane, gb);
#define XS4(m) ((l == 0) ? xrow_in(A, (m)) : (const float*)(A.out + (size_t)(m) * DM))
#define PT4(m) ((m) >= MP ? (const float*)((const bf16*)(ws + WS_Z) + (size_t)((m) - MP) * DM) : (const float*)nullptr)
            ROW_PASS2(true, XS4, PT4, H);
        }
        SYNC(6);
        {
            pg8::Gemm g{H, wl + W_FF1 / 2, M, FF, DM}; pg8::StaticOrder S; S.init(M, FF, DM, G, blk);
            pg8::EpiBf16<2> E{HMID, FF, nullptr};
            pg8::gemm_phase<pg8::EpiBf16<2>, pg8::StaticOrder, true, true>(L, g, S, E);
            if (l == 0 && G == 256 && blk >= 64) { PHASE_IDS(); convert_layer_weights(L, A, 1, (blk - 64) * NWAVES + wave, 192 * NWAVES, wave, lane); }
        }
        SYNC(7);
        {
            pg8::Gemm g{HMID, wl + W_FF2 / 2, M, DM, FF}; pg8::SplitOrder S; S.init(FF, G, blk, 8);
            pg8::EpiBf16<0> E{GO, DM, (float*)(ws + WS_H)};
            pg8::gemm_phase<pg8::EpiBf16<0>, pg8::SplitOrder, true, true>(L, g, S, E);
        }
        SYNC(8);
        {
            PHASE_IDS();
            f32x4 ga[4], gb[4]; load_g(A.in[I_GPOSTFF] + l * DM, lane, ga); load_g(A.in[I_GPRE] + DM, lane, gb);
#define XS7(m) ((const float*)(A.out + (size_t)(m) * DM))
#define PT7(m) ((m) >= MP ? (const float*)((const bf16*)(ws + WS_H) + (size_t)((m) - MP) * DM) : (const float*)nullptr)
            if (l == 0) { ROW_PASS2(true, XS7, PT7, MIX); SYNC(9); }
            else { ROW_PASS2(false, XS7, PT7, MIX); }
        }
    }
    if (PROBE_K == 9) PB_SPIN();
    if (PROBE_K == 100) { for (int i = 0; i < 20; ++i) xcd_barrier(xbar); }
}

extern "C" void kernel_launch(void* const* d_in, const int* in_sizes, int n_in, void* d_out, int out_size, void* d_ws, size_t ws_size, hipStream_t stream) {
    static int grid_blocks = 0;
    if (grid_blocks == 0) {
        if (n_in != 23 || (size_t)out_size != OUT_TOTAL || ws_size < WS_END) { fprintf(stderr, "kernel_launch: unexpected shapes n_in=%d out=%d ws=%zu\n", n_in, out_size, ws_size); grid_blocks = -1; return; }
        int dev = 0, cus = 0, per_cu = 0;
        hipGetDevice(&dev);
        hipDeviceGetAttribute(&cus, hipDeviceAttributeMultiprocessorCount, dev);
        hipFuncSetAttribute((const void*)fwd_megakernel, hipFuncAttributeMaxDynamicSharedMemorySize, LDS_BYTES);
        hipOccupancyMaxActiveBlocksPerMultiprocessor(&per_cu, (const void*)fwd_megakernel, NTHR, LDS_BYTES);
        if (per_cu < 1) { fprintf(stderr, "kernel_launch: occupancy query says %d blocks/CU\n", per_cu); per_cu = 1; }
        (void)hipGetLastError();
        grid_blocks = cus * per_cu;
    }
    if (grid_blocks < 0) return;
    if (hipMemsetAsync(d_ws, 0, 16384, stream) != hipSuccess) { fprintf(stderr, "kernel_launch: memset failed\n"); return; }
    Args a{};
    for (int i = 0; i < 23; ++i) a.in[i] = (const float*)d_in[i];
    a.out = (float*)d_out; a.ws = (unsigned char*)d_ws;
    void* args[] = {&a};
    hipError_t e = hipLaunchCooperativeKernel((const void*)fwd_megakernel, dim3(grid_blocks), dim3(NTHR), args, LDS_BYTES, stream);
    if (e != hipSuccess) fprintf(stderr, "cooperative launch failed: %s (grid %d)\n", hipGetErrorString(e), grid_blocks);
}
```
